# Optimizing an MI355X kernel written in HIP

```python
import jax
import jax.numpy as jnp
from jax import lax
import numpy as np


D_MODEL = 2048
BATCH = 4
SEQ = 2048
DEPTH = 1

PLE_DIM = 256
MIX_W = D_MODEL
SSD_W = MIX_W // 2
ATTN_W = MIX_W - SSD_W
SSD_HEADDIM = 64
SSD_HEADS = SSD_W // SSD_HEADDIM
SSD_GROUPS = 2
SSD_STATE = 128
SSD_CHUNK = 128
CONV_W = 5
XBC_W = SSD_W + 2 * SSD_GROUPS * SSD_STATE
DIFF_HEAD_DIM = 64
DIFF_HEADS = ATTN_W // (2 * DIFF_HEAD_DIM)
ROT_DIM = DIFF_HEAD_DIM // 4
ROPE_THETA = 500000.0
Q_BLOCK = 128
IN_W = SSD_W + XBC_W + 2 * SSD_HEADS + 3 * ATTN_W
MOE_GROUPS = 8
EXPERTS_PER_GROUP = 8
N_EXPERTS = MOE_GROUPS * EXPERTS_PER_GROUP
TOP_K = 2
EXPERT_FF = D_MODEL // 4
ROW_BLOCK = 128
EPS = 1e-6

kernel_name = 'hymba_ssd_diffattn_hmoe_ple_layer'


def rms_norm(x, g):
    xf = x.astype(jnp.float32)
    y = xf * lax.rsqrt(jnp.mean(xf * xf, axis=-1, keepdims=True) + EPS)
    return (y * g.astype(jnp.float32)).astype(x.dtype)


def ssd_scan(x, dt, a, bm, cm):
    b, s, h, p = x.shape
    g, n = bm.shape[2], bm.shape[3]
    r = h // g
    c = s // SSD_CHUNK
    l = SSD_CHUNK
    xd = (x.astype(jnp.float32) * dt[..., None]).reshape(b, c, l, g, r, p)
    da = (dt * a).reshape(b, c, l, g, r).transpose(0, 3, 4, 1, 2)
    bc = bm.astype(jnp.float32).reshape(b, c, l, g, n)
    cc = cm.astype(jnp.float32).reshape(b, c, l, g, n)
    a_cs = jnp.cumsum(da, axis=-1)
    seg = a_cs[..., :, None] - a_cs[..., None, :]
    lower = jnp.tril(jnp.ones((l, l), dtype=bool))
    decay_in = jnp.exp(jnp.where(lower, seg, -jnp.inf))
    cb = jnp.einsum('bclgn,bcsgn->bcgls', cc, bc)
    y_diag = jnp.einsum('bcgls,bgrcls,bcsgrp->bclgrp', cb, decay_in, xd)
    decay_to_end = jnp.exp(a_cs[..., -1:] - a_cs)
    chunk_states = jnp.einsum('bclgn,bgrcl,bclgrp->bcgrpn', bc, decay_to_end, xd)
    chunk_decay = jnp.exp(a_cs[..., -1])

    def step(state, inp):
        st, dec = inp
        return state * dec[..., None, None] + st, state

    _, states_in = lax.scan(step, jnp.zeros_like(chunk_states[:, 0]),
                            (jnp.moveaxis(chunk_states, 1, 0), jnp.moveaxis(chunk_decay, 3, 0)))
    states_in = jnp.moveaxis(states_in, 0, 1)
    y_off = jnp.einsum('bclgn,bcgrpn,bgrcl->bclgrp', cc, states_in, jnp.exp(a_cs))
    return (y_diag + y_off).reshape(b, s, h, p).astype(x.dtype)


def ssd_mixer(z, xbc, dt_f_raw, dt_b_raw, conv_w, conv_b, dt_bias_f, dt_bias_b,
              a_log_f, a_log_b, d_skip, norm_g):
    b, s, _ = z.shape
    pad = CONV_W // 2
    xbc = lax.conv_general_dilated(xbc, conv_w[:, None, :].astype(xbc.dtype), (1,), [(pad, pad)],
                                   dimension_numbers=('NWC', 'WIO', 'NWC'),
                                   feature_group_count=XBC_W)
    xbc = jax.nn.silu(xbc + conv_b)
    xs, bm, cm = jnp.split(xbc, [SSD_W, SSD_W + SSD_GROUPS * SSD_STATE], axis=-1)
    xs = xs.reshape(b, s, SSD_HEADS, SSD_HEADDIM)
    bm = bm.reshape(b, s, SSD_GROUPS, SSD_STATE)
    cm = cm.reshape(b, s, SSD_GROUPS, SSD_STATE)
    dt_f = jax.nn.softplus((dt_f_raw + dt_bias_f).astype(jnp.float32))
    dt_b = jax.nn.softplus((dt_b_raw + dt_bias_b).astype(jnp.float32))
    a_f = -jnp.exp(a_log_f.astype(jnp.float32))
    a_b = -jnp.exp(a_log_b.astype(jnp.float32))
    y_f = ssd_scan(xs, dt_f, a_f, bm, cm)
    y_b = jnp.flip(ssd_scan(jnp.flip(xs, 1), jnp.flip(dt_b, 1), a_b,
                            jnp.flip(bm, 1), jnp.flip(cm, 1)), 1)
    y = (y_f + y_b + xs * d_skip[:, None]).reshape(b, s, SSD_W)
    return rms_norm(y * jax.nn.silu(z), norm_g)


def rope_partial(t, cos, sin):
    half = ROT_DIM // 2
    c = cos[:, :, None, None, :].astype(t.dtype)
    sn = sin[:, :, None, None, :].astype(t.dtype)
    t1 = t[..., :half]
    t2 = t[..., half:ROT_DIM]
    return jnp.concatenate([t1 * c - t2 * sn, t2 * c + t1 * sn, t[..., ROT_DIM:]], axis=-1)


def diff_attention(q, k, v, cos, sin, lam, lam_init, subln_g):
    b, s = q.shape[0], q.shape[1]
    q = rope_partial(q.reshape(b, s, DIFF_HEADS, 2, DIFF_HEAD_DIM), cos, sin) * (DIFF_HEAD_DIM ** -0.5)
    k = rope_partial(k.reshape(b, s, DIFF_HEADS, 2, DIFF_HEAD_DIM), cos, sin)
    v = v.reshape(b, s, DIFF_HEADS, 2 * DIFF_HEAD_DIM)
    nq = s // Q_BLOCK
    q_blocks = jnp.moveaxis(q.reshape(b, nq, Q_BLOCK, DIFF_HEADS, 2, DIFF_HEAD_DIM), 1, 0)

    def attend(qb):
        scores = jnp.einsum('bqhcd,bkhcd->bhcqk', qb, k).astype(jnp.float32)
        probs = jax.nn.softmax(scores, axis=-1)
        w = probs[:, :, 0] - lam * probs[:, :, 1]
        return jnp.einsum('bhqk,bkhe->bqhe', w.astype(v.dtype), v)

    o = lax.map(attend, q_blocks)
    o = jnp.moveaxis(o, 0, 1).reshape(b, s, DIFF_HEADS, 2 * DIFF_HEAD_DIM)
    o = rms_norm(o, subln_g) * (1.0 - lam_init)
    return o.reshape(b, s, ATTN_W)


def hier_moe(h, w_rg, b_rg, w_re, b_re, w_gate, w_up, w_down):
    bsz, s, d = h.shape
    t = bsz * s
    hf = h.reshape(t, d)
    g_logits = (hf @ w_rg + b_rg).astype(jnp.float32)
    g_prob = jax.nn.softmax(g_logits, axis=-1)
    g_sel = jnp.argmax(g_logits, axis=-1)
    p_g = jnp.take_along_axis(g_prob, g_sel[:, None], axis=1)[:, 0]
    e_logits = (hf @ w_re + b_re).astype(jnp.float32).reshape(t, MOE_GROUPS, EXPERTS_PER_GROUP)
    e_logits = jnp.take_along_axis(e_logits, g_sel[:, None, None], axis=1)[:, 0]
    top_w, top_i = lax.top_k(jax.nn.softmax(e_logits, axis=-1), TOP_K)
    top_w = top_w / jnp.sum(top_w, axis=-1, keepdims=True)
    gate = p_g[:, None] * top_w
    expert_id = (g_sel[:, None] * EXPERTS_PER_GROUP + top_i).astype(jnp.int32)
    e_flat = expert_id.reshape(-1)
    tok_flat = jnp.repeat(jnp.arange(t, dtype=jnp.int32), TOP_K)
    w_flat = gate.reshape(-1)
    order = jnp.argsort(e_flat)
    e_sorted = e_flat[order]
    counts = jnp.bincount(e_flat, length=N_EXPERTS).astype(jnp.int32)
    padded = ((counts + ROW_BLOCK - 1) // ROW_BLOCK) * ROW_BLOCK
    ends_pad = jnp.cumsum(padded)
    starts_pad = ends_pad - padded
    starts = jnp.cumsum(counts) - counts
    dest = starts_pad[e_sorted] + (jnp.arange(t * TOP_K, dtype=jnp.int32) - starts[e_sorted])
    n_rows = ((t * TOP_K + N_EXPERTS * (ROW_BLOCK - 1)) + ROW_BLOCK - 1) // ROW_BLOCK * ROW_BLOCK
    n_blocks = n_rows // ROW_BLOCK
    row_tok = jnp.full((n_rows,), t, dtype=jnp.int32).at[dest].set(tok_flat[order])
    row_w = jnp.zeros((n_rows,), jnp.float32).at[dest].set(w_flat[order])
    block_expert = jnp.minimum(
        jnp.searchsorted(ends_pad, jnp.arange(n_blocks, dtype=jnp.int32) * ROW_BLOCK, side='right'),
        N_EXPERTS - 1)
    x_rows = jnp.concatenate([hf, jnp.zeros((1, d), hf.dtype)], axis=0)[row_tok]
    x_rows = x_rows.reshape(n_blocks, ROW_BLOCK, d)

    def expert_block(args):
        xb, e = args
        return (jax.nn.silu(xb @ w_gate[e]) * (xb @ w_up[e])) @ w_down[e]

    y_rows = lax.map(expert_block, (x_rows, block_expert)).reshape(n_rows, d)
    y = jax.ops.segment_sum(y_rows * row_w[:, None].astype(y_rows.dtype), row_tok,
                            num_segments=t + 1)[:t]
    return y.reshape(bsz, s, d)


def setup_inputs(seed: int = 0) -> dict:
    key = jax.random.key(seed)
    ks = list(jax.random.split(key, 40))
    f32 = jnp.float32

    def nrm(k, shape, scale):
        return jax.random.normal(k, shape, f32) * scale

    def gain(k, shape):
        return 1.0 + 0.01 * jax.random.normal(k, shape, f32)

    x = jax.random.normal(ks[0], (BATCH, SEQ, D_MODEL), f32)
    p = jax.random.normal(ks[1], (DEPTH, BATCH, SEQ, PLE_DIM), f32)
    offsets = jax.random.randint(ks[2], (BATCH, 1), 0, 1024, dtype=jnp.int32)
    positions = offsets + jnp.arange(SEQ, dtype=jnp.int32)[None, :]
    dt0 = jnp.exp(jax.random.uniform(ks[7], (DEPTH, SSD_HEADS), f32, np.log(1e-3), np.log(1e-1)))
    dt1 = jnp.exp(jax.random.uniform(ks[8], (DEPTH, SSD_HEADS), f32, np.log(1e-3), np.log(1e-1)))
    inv_softplus = lambda y: y + jnp.log(-jnp.expm1(-y))
    return {
        'x': x,
        'p': p,
        'positions': positions,
        'norm_mix_g': gain(ks[3], (DEPTH, D_MODEL)),
        'w_in': nrm(ks[4], (DEPTH, D_MODEL, IN_W), D_MODEL ** -0.5),
        'conv_w': nrm(ks[5], (DEPTH, CONV_W, XBC_W), CONV_W ** -0.5),
        'conv_b': nrm(ks[6], (DEPTH, XBC_W), 0.02),
        'dt_bias_f': inv_softplus(dt0),
        'dt_bias_b': inv_softplus(dt1),
        'a_log_f': jnp.log(jax.random.uniform(ks[9], (DEPTH, SSD_HEADS), f32, 1.0, 16.0)),
        'a_log_b': jnp.log(jax.random.uniform(ks[10], (DEPTH, SSD_HEADS), f32, 1.0, 16.0)),
        'd_skip': gain(ks[11], (DEPTH, SSD_HEADS)),
        'ssd_norm_g': gain(ks[12], (DEPTH, SSD_W)),
        'lam_q1': nrm(ks[13], (DEPTH, DIFF_HEAD_DIM), 0.1),
        'lam_k1': nrm(ks[14], (DEPTH, DIFF_HEAD_DIM), 0.1),
        'lam_q2': nrm(ks[15], (DEPTH, DIFF_HEAD_DIM), 0.1),
        'lam_k2': nrm(ks[16], (DEPTH, DIFF_HEAD_DIM), 0.1),
        'subln_g': gain(ks[17], (DEPTH, 2 * DIFF_HEAD_DIM)),
        'w_out': nrm(ks[18], (DEPTH, MIX_W, D_MODEL), MIX_W ** -0.5),
        'norm_ffn_g': gain(ks[19], (DEPTH, D_MODEL)),
        'w_route_group': nrm(ks[20], (DEPTH, D_MODEL, MOE_GROUPS), D_MODEL ** -0.5),
        'b_route_group': nrm(ks[21], (DEPTH, MOE_GROUPS), 0.01),
        'w_route_expert': nrm(ks[22], (DEPTH, D_MODEL, N_EXPERTS), D_MODEL ** -0.5),
        'b_route_expert': nrm(ks[23], (DEPTH, N_EXPERTS), 0.01),
        'w_exp_gate': nrm(ks[24], (DEPTH, N_EXPERTS, D_MODEL, EXPERT_FF), D_MODEL ** -0.5),
        'w_exp_up': nrm(ks[25], (DEPTH, N_EXPERTS, D_MODEL, EXPERT_FF), D_MODEL ** -0.5),
        'w_exp_down': nrm(ks[26], (DEPTH, N_EXPERTS, EXPERT_FF, D_MODEL), EXPERT_FF ** -0.5),
        'w_ple_proj': nrm(ks[27], (DEPTH, PLE_DIM, D_MODEL), PLE_DIM ** -0.5),
        'ple_norm_g': gain(ks[28], (DEPTH, D_MODEL)),
        'w_ple_gate': nrm(ks[29], (DEPTH, D_MODEL, D_MODEL), D_MODEL ** -0.5),
        'b_ple_gate': nrm(ks[30], (DEPTH, D_MODEL), 0.02),
        'final_norm_g': gain(ks[31], (D_MODEL,)),
    }


def reference(x, p, positions, norm_mix_g, w_in, conv_w, conv_b, dt_bias_f, dt_bias_b,
              a_log_f, a_log_b, d_skip, ssd_norm_g, lam_q1, lam_k1, lam_q2, lam_k2, subln_g,
              w_out, norm_ffn_g, w_route_group, b_route_group, w_route_expert, b_route_expert,
              w_exp_gate, w_exp_up, w_exp_down, w_ple_proj, ple_norm_g, w_ple_gate, b_ple_gate,
              final_norm_g):
    inv_freq = ROPE_THETA ** (-jnp.arange(0, ROT_DIM, 2, dtype=jnp.float32) / ROT_DIM)
    angles = positions.astype(jnp.float32)[..., None] * inv_freq
    cos, sin = jnp.cos(angles), jnp.sin(angles)
    sizes = [SSD_W, XBC_W, SSD_HEADS, SSD_HEADS, ATTN_W, ATTN_W, ATTN_W]
    split_at = np.cumsum(sizes)[:-1].tolist()
    h = x
    for i in range(DEPTH):
        lam_init = 0.8 - 0.6 * float(np.exp(-0.3 * i))
        n = rms_norm(h, norm_mix_g[i])
        proj = n @ w_in[i]
        z, xbc, dt_f, dt_b, q, k, v = jnp.split(proj, split_at, axis=-1)
        y_ssd = ssd_mixer(z, xbc, dt_f, dt_b, conv_w[i], conv_b[i], dt_bias_f[i], dt_bias_b[i],
                          a_log_f[i], a_log_b[i], d_skip[i], ssd_norm_g[i])
        lam = (jnp.exp(jnp.sum(lam_q1[i] * lam_k1[i]).astype(jnp.float32))
               - jnp.exp(jnp.sum(lam_q2[i] * lam_k2[i]).astype(jnp.float32)) + lam_init)
        y_att = diff_attention(q, k, v, cos, sin, lam, lam_init, subln_g[i])
        h = h + jnp.concatenate([y_ssd, y_att], axis=-1) @ w_out[i]
        h = h + hier_moe(rms_norm(h, norm_ffn_g[i]), w_route_group[i], b_route_group[i],
                         w_route_expert[i], b_route_expert[i], w_exp_gate[i], w_exp_up[i],
                         w_exp_down[i])
        ple = rms_norm(p[i] @ w_ple_proj[i], ple_norm_g[i])
        h = h + jax.nn.sigmoid(h @ w_ple_gate[i] + b_ple_gate[i]) * ple
    return rms_norm(h, final_norm_g)
```

```cpp
#include <hip/hip_runtime.h>
#include <stdint.h>

typedef unsigned short bf16_t;
typedef short bf16x8 __attribute__((ext_vector_type(8)));
typedef float f32x4 __attribute__((ext_vector_type(4)));
typedef unsigned u32x4 __attribute__((ext_vector_type(4)));
typedef unsigned u32x2 __attribute__((ext_vector_type(2)));

#define T_TOK 8192
#define DM 2048
#define SEQ 2048
#define NB 4
#define INW 5664
#define INW_PAD 5888
#define OFF_Z 0
#define OFF_XBC 1024
#define OFF_DT 2560
#define OFF_Q 2592
#define OFF_K 3616
#define OFF_V 4640
#define XBCW 1536
#define SSDW 1024
#define NEXP 64
#define EFF 512
#define MAXROWS 24576
#define MAXBLK 192
#define EPS 1e-6f

__device__ __forceinline__ unsigned cvt_pk_bf16(float lo, float hi) { unsigned r; asm("v_cvt_pk_bf16_f32 %0, %1, %2" : "=v"(r) : "v"(lo), "v"(hi)); return r; }
__device__ __forceinline__ bf16_t f2bf(float x) { return (bf16_t)(cvt_pk_bf16(x, 0.f) & 0xffffu); }
__device__ __forceinline__ float bf2f(bf16_t b) { return __uint_as_float(((unsigned)b) << 16); }
__device__ __forceinline__ float bflo(unsigned u) { return __uint_as_float(u << 16); }
__device__ __forceinline__ float bfhi(unsigned u) { return __uint_as_float(u & 0xffff0000u); }
__device__ __forceinline__ float siluf(float x) { return x / (1.f + expf(-x)); }
__device__ __forceinline__ float wave_sum(float v) { for (int o = 32; o > 0; o >>= 1) v += __shfl_xor(v, o); return v; }
__device__ __forceinline__ float wave_max(float v) { for (int o = 32; o > 0; o >>= 1) v = fmaxf(v, __shfl_xor(v, o)); return v; }
__device__ __forceinline__ float block_sum(float v, float* red) {
    v = wave_sum(v);
    __syncthreads();
    if ((threadIdx.x & 63) == 0) red[threadIdx.x >> 6] = v;
    __syncthreads();
    float s = 0.f;
    for (int i = 0; i < (int)(blockDim.x >> 6); ++i) s += red[i];
    return s;
}

struct Params {
    const float* x; const float* p; const int* pos; const float* norm_mix_g; const float* w_in; const float* conv_w; const float* conv_b;
    const float* dt_bias_f; const float* dt_bias_b; const float* a_log_f; const float* a_log_b; const float* d_skip; const float* ssd_norm_g;
    const float* lam_q1; const float* lam_k1; const float* lam_q2; const float* lam_k2; const float* subln_g; const float* w_out; const float* norm_ffn_g;
    const float* w_rg; const float* b_rg; const float* w_re; const float* b_re; const float* w_eg; const float* w_eu; const float* w_ed;
    const float* w_pp; const float* ple_g; const float* w_pg; const float* b_pg; const float* final_g;
    float* out;
    unsigned* bar; int* counts; int* cursor; int* starts; int* nblk;
    bf16_t* w_in_t; bf16_t* w_out_t; bf16_t* w_pg_t; bf16_t* w_pp_t;
    bf16_t* nbf; bf16_t* proj; float* dtv; bf16_t* xbc; float* yf; float* yb; bf16_t* mix; float* h1; bf16_t* hn;
    int* tok_e; float* tok_w; int* row_tok; int* row_slot; float* row_w; int* blk_exp;
    bf16_t* act; bf16_t* ymoe; bf16_t* h2b; float* pp; float* prinv;
};

__global__ void __launch_bounds__(256) k_wt(const float* __restrict__ w, bf16_t* __restrict__ wt, int K, int N, int Npad) {
    __shared__ float tile[64][65];
    const int tilesK = K / 64, tilesN = Npad / 64;
    for (int tI = blockIdx.x; tI < tilesK * tilesN; tI += gridDim.x) {
        const int tk = tI % tilesK, tn = tI / tilesK, k0 = tk * 64, n0 = tn * 64;
        for (int i = threadIdx.x >> 6; i < 64; i += 4) {
            const int n = n0 + (threadIdx.x & 63);
            tile[i][threadIdx.x & 63] = (n < N) ? w[(size_t)(k0 + i) * N + n] : 0.f;
        }
        __syncthreads();
        for (int j = threadIdx.x >> 6; j < 64; j += 4)
            wt[(size_t)(n0 + j) * K + k0 + (threadIdx.x & 63)] = f2bf(tile[threadIdx.x & 63][j]);
        __syncthreads();
    }
}

__global__ void __launch_bounds__(256) k_norm_x(Params P) {
    __shared__ float red[8];
    for (int row = blockIdx.x; row < T_TOK; row += gridDim.x) {
        const float* xr = P.x + (size_t)row * DM;
        f32x4 v0 = *(const f32x4*)(xr + threadIdx.x * 8), v1 = *(const f32x4*)(xr + threadIdx.x * 8 + 4);
        float ss = v0[0] * v0[0] + v0[1] * v0[1] + v0[2] * v0[2] + v0[3] * v0[3] + v1[0] * v1[0] + v1[1] * v1[1] + v1[2] * v1[2] + v1[3] * v1[3];
        ss = block_sum(ss, red);
        const float r = rsqrtf(ss * (1.f / DM) + EPS);
        f32x4 g0 = *(const f32x4*)(P.norm_mix_g + threadIdx.x * 8), g1 = *(const f32x4*)(P.norm_mix_g + threadIdx.x * 8 + 4);
        u32x4 o;
        o[0] = cvt_pk_bf16(v0[0] * r * g0[0], v0[1] * r * g0[1]); o[1] = cvt_pk_bf16(v0[2] * r * g0[2], v0[3] * r * g0[3]);
        o[2] = cvt_pk_bf16(v1[0] * r * g1[0], v1[1] * r * g1[1]); o[3] = cvt_pk_bf16(v1[2] * r * g1[2], v1[3] * r * g1[3]);
        *(u32x4*)(P.nbf + (size_t)row * DM + threadIdx.x * 8) = o;
    }
}

struct LoadBf16 {
    const bf16_t* rp[4]; u32x4 r[4];
    __device__ __forceinline__ void init(const bf16_t* base, size_t ld, int row0, const int* gather) {
#pragma unroll
        for (int i = 0; i < 4; ++i) { const int c = threadIdx.x + i * 256, row = c >> 3, kc = c & 7;
            if (gather) { const int t = gather[row0 + row]; rp[i] = (t >= 0) ? base + (size_t)t * ld + kc * 8 : nullptr; }
            else rp[i] = base + (size_t)(row0 + row) * ld + kc * 8; }
    }
    __device__ __forceinline__ void fetch(int kt) {
#pragma unroll
        for (int i = 0; i < 4; ++i) r[i] = rp[i] ? *(const u32x4*)(rp[i] + kt * 64) : (u32x4){0u, 0u, 0u, 0u};
    }
    __device__ __forceinline__ void commit(char* lds) {
#pragma unroll
        for (int i = 0; i < 4; ++i) { const int c = threadIdx.x + i * 256, row = c >> 3, kc = c & 7, kh = kc >> 2, kq = kc & 3;
            *(u32x4*)(lds + ((kh * 128 + row) * 32 + kq * 8) * 2) = r[i]; }
    }
};
struct LoadF32Rows {
    const float* rp[4]; f32x4 r[4][2];
    __device__ __forceinline__ void init(const float* base, size_t ld, int row0) {
#pragma unroll
        for (int i = 0; i < 4; ++i) { const int c = threadIdx.x + i * 256, row = c >> 3, kc = c & 7; rp[i] = base + (size_t)(row0 + row) * ld + kc * 8; }
    }
    __device__ __forceinline__ void fetch(int kt) {
#pragma unroll
        for (int i = 0; i < 4; ++i) { r[i][0] = *(const f32x4*)(rp[i] + kt * 64); r[i][1] = *(const f32x4*)(rp[i] + kt * 64 + 4); }
    }
    __device__ __forceinline__ void commit(char* lds) {
#pragma unroll
        for (int i = 0; i < 4; ++i) { const int c = threadIdx.x + i * 256, row = c >> 3, kc = c & 7, kh = kc >> 2, kq = kc & 3;
            u32x4 o; o[0] = cvt_pk_bf16(r[i][0][0], r[i][0][1]); o[1] = cvt_pk_bf16(r[i][0][2], r[i][0][3]); o[2] = cvt_pk_bf16(r[i][1][0], r[i][1][1]); o[3] = cvt_pk_bf16(r[i][1][2], r[i][1][3]);
            *(u32x4*)(lds + ((kh * 128 + row) * 32 + kq * 8) * 2) = o; }
    }
};
struct LoadF32KN {
    const float* cp; size_t ldn; f32x4 r[4][2];
    __device__ __forceinline__ void init(const float* w, size_t ldn_, int colg) { ldn = ldn_; cp = w + colg + (size_t)((threadIdx.x >> 5) * 2) * ldn_; }
    __device__ __forceinline__ void fetch(int kt) {
#pragma unroll
        for (int i = 0; i < 4; ++i) { const float* q = cp + (size_t)(kt * 64 + i * 16) * ldn; r[i][0] = *(const f32x4*)q; r[i][1] = *(const f32x4*)(q + ldn); }
    }
    __device__ __forceinline__ void commit(char* lds) {
        const int nn = (threadIdx.x & 31) * 4, kr = threadIdx.x >> 5;
#pragma unroll
        for (int i = 0; i < 4; ++i) { const int kl = i * 16 + kr * 2, kh = kl >> 5, kk = kl & 31;
#pragma unroll
            for (int j = 0; j < 4; ++j) *(unsigned*)(lds + ((kh * 128 + nn + j) * 32 + kk) * 2) = cvt_pk_bf16(r[i][0][j], r[i][1][j]); }
    }
};

template <class AL, class BL, class EP>
__device__ __forceinline__ void gemm128(char* smem, int nk, AL& al, BL& bl, const EP& ep) {
    const int tid = threadIdx.x, wid = tid >> 6, lane = tid & 63, wr = wid >> 1, wc = wid & 1, fr = lane & 15, fq = lane >> 4;
    char* As = smem; char* Bs = smem + 16384;
    f32x4 acc[4][4];
#pragma unroll
    for (int m = 0; m < 4; ++m)
#pragma unroll
        for (int n = 0; n < 4; ++n) acc[m][n] = (f32x4){0.f, 0.f, 0.f, 0.f};
    al.fetch(0); bl.fetch(0);
    for (int kt = 0; kt < nk; ++kt) {
        __syncthreads();
        al.commit(As); bl.commit(Bs);
        __syncthreads();
        if (kt + 1 < nk) { al.fetch(kt + 1); bl.fetch(kt + 1); }
#pragma unroll
        for (int kh = 0; kh < 2; ++kh) {
            bf16x8 a[4], b[4];
#pragma unroll
            for (int m = 0; m < 4; ++m) a[m] = *(const bf16x8*)(As + ((kh * 128 + wr * 64 + m * 16 + fr) * 32 + fq * 8) * 2);
#pragma unroll
            for (int n = 0; n < 4; ++n) b[n] = *(const bf16x8*)(Bs + ((kh * 128 + wc * 64 + n * 16 + fr) * 32 + fq * 8) * 2);
#pragma unroll
            for (int m = 0; m < 4; ++m)
#pragma unroll
                for (int n = 0; n < 4; ++n) acc[m][n] = __builtin_amdgcn_mfma_f32_16x16x32_bf16(a[m], b[n], acc[m][n], 0, 0, 0);
        }
    }
    ep(acc, wr, wc, fr, fq);
}

struct EpiInProj { bf16_t* proj; float* dtv; int row0, col0;
    __device__ __forceinline__ void operator()(const f32x4 (&acc)[4][4], int wr, int wc, int fr, int fq) const {
#pragma unroll
        for (int m = 0; m < 4; ++m)
#pragma unroll
            for (int n = 0; n < 4; ++n) { const int col = col0 + wc * 64 + n * 16 + fr;
                if (col < INW) {
#pragma unroll
                    for (int j = 0; j < 4; ++j) { const int row = row0 + wr * 64 + m * 16 + fq * 4 + j;
                        proj[(size_t)row * INW + col] = f2bf(acc[m][n][j]);
                        if (col >= OFF_DT && col < OFF_DT + 32) dtv[(size_t)row * 32 + (col - OFF_DT)] = acc[m][n][j]; } } }
    }
};
__global__ void __launch_bounds__(256) k_inproj(Params P) {
    __shared__ __attribute__((aligned(16))) char smem[32768];
    const int ntn = INW_PAD / 128, ntm = T_TOK / 128;
    for (int u = blockIdx.x; u < ntn * ntm; u += gridDim.x) {
        const int tn = u % ntn, tm = u / ntn;
        LoadBf16 al, bl; al.init(P.nbf, DM, tm * 128, nullptr); bl.init(P.w_in_t, DM, tn * 128, nullptr);
        EpiInProj ep{P.proj, P.dtv, tm * 128, tn * 128};
        gemm128(smem, DM / 64, al, bl, ep);
    }
}

__global__ void __launch_bounds__(256) k_prep(Params P) {
    for (int t = blockIdx.x; t < T_TOK; t += gridDim.x) {
        const int s = t & (SEQ - 1);
        bf16_t* pr = P.proj + (size_t)t * INW;
        {
            const int tid = threadIdx.x, which = tid >> 7, hc = (tid >> 3) & 15, i = tid & 7;
            const float posf = (float)P.pos[t];
            const float inv_freq = powf(500000.0f, -(float)(2 * i) / 16.0f);
            const float ang = posf * inv_freq;
            const float cs = cosf(ang), sn = sinf(ang);
            bf16_t* q = pr + (which ? OFF_K : OFF_Q) + hc * 64;
            const float t1 = bf2f(q[i]), t2 = bf2f(q[i + 8]);
            q[i] = f2bf(t1 * cs - t2 * sn); q[i + 8] = f2bf(t2 * cs + t1 * sn);
        }
        for (int c = threadIdx.x; c < XBCW; c += 256) {
            float a = P.conv_b[c];
#pragma unroll
            for (int w = 0; w < 5; ++w) { const int ss = s + w - 2;
                if (ss >= 0 && ss < SEQ) a += bf2f(P.proj[(size_t)(t + w - 2) * INW + OFF_XBC + c]) * P.conv_w[w * XBCW + c]; }
            P.xbc[(size_t)t * XBCW + c] = f2bf(siluf(a));
        }
        if (threadIdx.x < 32) {
            const int j = threadIdx.x; const float b = (j < 16) ? P.dt_bias_f[j] : P.dt_bias_b[j - 16];
            const float v = P.dtv[(size_t)t * 32 + j] + b;
            P.dtv[(size_t)t * 32 + j] = fmaxf(v, 0.f) + log1pf(expf(-fabsf(v)));
        }
    }
}

__global__ void __launch_bounds__(256) k_ssd_naive(Params P) {
    __shared__ __attribute__((aligned(16))) bf16_t sB[64][128];
    __shared__ __attribute__((aligned(16))) bf16_t sC[64][128];
    __shared__ __attribute__((aligned(16))) bf16_t sX[64][64];
    __shared__ float sdt[64];
    const int tid = threadIdx.x, u = blockIdx.x, dir = u & 1, h = (u >> 1) & 15, b = u >> 5, g = h >> 3;
    const float a = -expf(dir ? P.a_log_b[h] : P.a_log_f[h]);
    const int p = tid >> 2, nq = tid & 3;
    float st[32];
#pragma unroll
    for (int i = 0; i < 32; ++i) st[i] = 0.f;
    float* y = dir ? P.yb : P.yf;
    for (int c = 0; c < SEQ / 64; ++c) {
        const int tbase = dir ? (SEQ - 64 - c * 64) : c * 64;
        __syncthreads();
#pragma unroll
        for (int i = 0; i < 4; ++i) { const int cc = tid + i * 256, r = cc >> 4, q = cc & 15; const bf16_t* src = P.xbc + (size_t)(b * SEQ + tbase + r) * XBCW;
            *(u32x4*)&sB[r][q * 8] = *(const u32x4*)(src + 1024 + g * 128 + q * 8); *(u32x4*)&sC[r][q * 8] = *(const u32x4*)(src + 1280 + g * 128 + q * 8); }
#pragma unroll
        for (int i = 0; i < 2; ++i) { const int cc = tid + i * 256, r = cc >> 3, q = cc & 7; *(u32x4*)&sX[r][q * 8] = *(const u32x4*)(P.xbc + (size_t)(b * SEQ + tbase + r) * XBCW + h * 64 + q * 8); }
        if (tid < 64) sdt[tid] = P.dtv[(size_t)(b * SEQ + tbase + tid) * 32 + dir * 16 + h];
        __syncthreads();
        for (int s = 0; s < 64; ++s) {
            const int r = dir ? 63 - s : s;
            const float dt = sdt[r], dA = expf(dt * a), xd = bf2f(sX[r][p]) * dt;
            float acc = 0.f;
#pragma unroll
            for (int i8 = 0; i8 < 4; ++i8) { const u32x4 bv = *(const u32x4*)&sB[r][nq * 32 + i8 * 8], cv = *(const u32x4*)&sC[r][nq * 32 + i8 * 8];
#pragma unroll
                for (int e = 0; e < 4; ++e) { float& s0 = st[i8 * 8 + e * 2]; float& s1 = st[i8 * 8 + e * 2 + 1];
                    s0 = s0 * dA + xd * bflo(bv[e]); acc += bflo(cv[e]) * s0; s1 = s1 * dA + xd * bfhi(bv[e]); acc += bfhi(cv[e]) * s1; } }
            acc += __shfl_xor(acc, 1); acc += __shfl_xor(acc, 2);
            if (nq == 0) y[(size_t)(b * SEQ + tbase + r) * SSDW + h * 64 + p] = acc;
        }
    }
}

__global__ void __launch_bounds__(256) k_ssd_gate(Params P) {
    __shared__ float red[8];
    for (int t = blockIdx.x; t < T_TOK; t += gridDim.x) {
        float v[4]; float ss = 0.f;
#pragma unroll
        for (int i = 0; i < 4; ++i) { const int c = threadIdx.x * 4 + i; const float xs = bf2f(P.xbc[(size_t)t * XBCW + c]);
            const float y = P.yf[(size_t)t * SSDW + c] + P.yb[(size_t)t * SSDW + c] + xs * P.d_skip[c >> 6];
            const float z = bf2f(P.proj[(size_t)t * INW + OFF_Z + c]); v[i] = y * siluf(z); ss += v[i] * v[i]; }
        ss = block_sum(ss, red);
        const float r = rsqrtf(ss * (1.f / SSDW) + EPS);
#pragma unroll
        for (int i = 0; i < 4; ++i) { const int c = threadIdx.x * 4 + i; P.mix[(size_t)t * DM + c] = f2bf(v[i] * r * P.ssd_norm_g[c]); }
    }
}

__global__ void __launch_bounds__(256) k_attn_naive(Params P) {
    __shared__ float sq[4][128];
    const int lane = threadIdx.x & 63, w = threadIdx.x >> 6;
    const int gq = blockIdx.x * 4 + w;
    const int q = gq & (SEQ - 1), h = (gq >> 11) & 7, b = gq >> 14;
    float lam;
    { float d1 = P.lam_q1[lane] * P.lam_k1[lane], d2 = P.lam_q2[lane] * P.lam_k2[lane]; d1 = wave_sum(d1); d2 = wave_sum(d2); lam = expf(d1) - expf(d2) + 0.2f; }
    const bf16_t* qrow = P.proj + (size_t)(b * SEQ + q) * INW + OFF_Q + h * 128;
    sq[w][lane] = bf2f(qrow[lane]) * 0.125f; sq[w][lane + 64] = bf2f(qrow[lane + 64]) * 0.125f;
    __syncthreads();
    float m1 = -INFINITY, m2 = -INFINITY, l1 = 0.f, l2 = 0.f, o1a = 0.f, o1b = 0.f, o2a = 0.f, o2b = 0.f;
    for (int j0 = 0; j0 < SEQ; j0 += 64) {
        const bf16_t* krow = P.proj + (size_t)(b * SEQ + j0 + lane) * INW + OFF_K + h * 128;
        float s1 = 0.f, s2 = 0.f;
#pragma unroll
        for (int c = 0; c < 8; ++c) { const u32x4 kk = *(const u32x4*)(krow + c * 8);
#pragma unroll
            for (int e = 0; e < 4; ++e) s1 += sq[w][c * 8 + 2 * e] * bflo(kk[e]) + sq[w][c * 8 + 2 * e + 1] * bfhi(kk[e]); }
#pragma unroll
        for (int c = 0; c < 8; ++c) { const u32x4 kk = *(const u32x4*)(krow + 64 + c * 8);
#pragma unroll
            for (int e = 0; e < 4; ++e) s2 += sq[w][64 + c * 8 + 2 * e] * bflo(kk[e]) + sq[w][64 + c * 8 + 2 * e + 1] * bfhi(kk[e]); }
        const float m1n = fmaxf(m1, wave_max(s1)), m2n = fmaxf(m2, wave_max(s2));
        const float p1 = expf(s1 - m1n), p2 = expf(s2 - m2n), c1 = expf(m1 - m1n), c2 = expf(m2 - m2n);
        l1 = l1 * c1 + wave_sum(p1); l2 = l2 * c2 + wave_sum(p2);
        o1a *= c1; o1b *= c1; o2a *= c2; o2b *= c2; m1 = m1n; m2 = m2n;
        for (int jj = 0; jj < 64; ++jj) {
            const float pj1 = __shfl(p1, jj), pj2 = __shfl(p2, jj);
            const bf16_t* vrow = P.proj + (size_t)(b * SEQ + j0 + jj) * INW + OFF_V + h * 128;
            const float v0 = bf2f(vrow[lane]), v1 = bf2f(vrow[lane + 64]);
            o1a += pj1 * v0; o1b += pj1 * v1; o2a += pj2 * v0; o2b += pj2 * v1;
        }
    }
    const float oa = o1a / l1 - lam * o2a / l2, ob = o1b / l1 - lam * o2b / l2;
    const float ss = wave_sum(oa * oa + ob * ob) * (1.f / 128.f);
    const float r = rsqrtf(ss + EPS) * 0.8f;
    bf16_t* mo = P.mix + (size_t)(b * SEQ + q) * DM + 1024 + h * 128;
    mo[lane] = f2bf(oa * r * P.subln_g[lane]); mo[lane + 64] = f2bf(ob * r * P.subln_g[lane + 64]);
}

struct EpiOutProj { const float* x; float* h1; int row0, col0;
    __device__ __forceinline__ void operator()(const f32x4 (&acc)[4][4], int wr, int wc, int fr, int fq) const {
#pragma unroll
        for (int m = 0; m < 4; ++m)
#pragma unroll
            for (int n = 0; n < 4; ++n)
#pragma unroll
                for (int j = 0; j < 4; ++j) { const size_t o = (size_t)(row0 + wr * 64 + m * 16 + fq * 4 + j) * DM + col0 + wc * 64 + n * 16 + fr; h1[o] = x[o] + acc[m][n][j]; }
    }
};
__global__ void __launch_bounds__(256) k_outproj(Params P) {
    __shared__ __attribute__((aligned(16))) char smem[32768];
    const int ntn = DM / 128, ntm = T_TOK / 128;
    for (int u = blockIdx.x; u < ntn * ntm; u += gridDim.x) {
        const int tn = u % ntn, tm = u / ntn;
        LoadBf16 al, bl; al.init(P.mix, DM, tm * 128, nullptr); bl.init(P.w_out_t, DM, tn * 128, nullptr);
        EpiOutProj ep{P.x, P.h1, tm * 128, tn * 128};
        gemm128(smem, DM / 64, al, bl, ep);
    }
}

__global__ void __launch_bounds__(256) k_router(Params P) {
    __shared__ float sh[DM]; __shared__ float red[8]; __shared__ float pe[4][64]; __shared__ float pg[4][8];
    for (int t = blockIdx.x; t < T_TOK; t += gridDim.x) {
        const float* hr = P.h1 + (size_t)t * DM;
        f32x4 v0 = *(const f32x4*)(hr + threadIdx.x * 8), v1 = *(const f32x4*)(hr + threadIdx.x * 8 + 4);
        float ss = v0[0] * v0[0] + v0[1] * v0[1] + v0[2] * v0[2] + v0[3] * v0[3] + v1[0] * v1[0] + v1[1] * v1[1] + v1[2] * v1[2] + v1[3] * v1[3];
        ss = block_sum(ss, red);
        const float r = rsqrtf(ss * (1.f / DM) + EPS);
        f32x4 g0 = *(const f32x4*)(P.norm_ffn_g + threadIdx.x * 8), g1 = *(const f32x4*)(P.norm_ffn_g + threadIdx.x * 8 + 4);
        float o[8];
#pragma unroll
        for (int i = 0; i < 4; ++i) { o[i] = v0[i] * r * g0[i]; o[4 + i] = v1[i] * r * g1[i]; }
        u32x4 ob; ob[0] = cvt_pk_bf16(o[0], o[1]); ob[1] = cvt_pk_bf16(o[2], o[3]); ob[2] = cvt_pk_bf16(o[4], o[5]); ob[3] = cvt_pk_bf16(o[6], o[7]);
        *(u32x4*)(P.hn + (size_t)t * DM + threadIdx.x * 8) = ob;
#pragma unroll
        for (int i = 0; i < 8; ++i) sh[threadIdx.x * 8 + i] = o[i];
        __syncthreads();
        const int j = threadIdx.x & 63, ks = threadIdx.x >> 6;
        float ae = 0.f, ag = 0.f;
        for (int k = ks * 512; k < ks * 512 + 512; ++k) { const float hv = sh[k]; ae += hv * P.w_re[(size_t)k * 64 + j]; if (j < 8) ag += hv * P.w_rg[(size_t)k * 8 + j]; }
        pe[ks][j] = ae; if (j < 8) pg[ks][j] = ag;
        __syncthreads();
        if (threadIdx.x == 0) {
            float gl[8]; int gs = 0; float gm = -INFINITY;
            for (int i = 0; i < 8; ++i) { gl[i] = pg[0][i] + pg[1][i] + pg[2][i] + pg[3][i] + P.b_rg[i]; if (gl[i] > gm) { gm = gl[i]; gs = i; } }
            float den = 0.f; for (int i = 0; i < 8; ++i) den += expf(gl[i] - gm);
            const float p_g = 1.f / den;
            float el[8]; int i0 = 0; float e0 = -INFINITY;
            for (int i = 0; i < 8; ++i) { const int c = gs * 8 + i; el[i] = pe[0][c] + pe[1][c] + pe[2][c] + pe[3][c] + P.b_re[c]; if (el[i] > e0) { e0 = el[i]; i0 = i; } }
            int i1 = -1; float e1 = -INFINITY;
            for (int i = 0; i < 8; ++i) if (i != i0 && el[i] > e1) { e1 = el[i]; i1 = i; }
            const float x1 = expf(e1 - e0), w0 = 1.f / (1.f + x1), w1 = x1 / (1.f + x1);
            const int ex0 = gs * 8 + i0, ex1 = gs * 8 + i1;
            P.tok_e[t * 2] = ex0; P.tok_e[t * 2 + 1] = ex1; P.tok_w[t * 2] = p_g * w0; P.tok_w[t * 2 + 1] = p_g * w1;
            atomicAdd(&P.counts[ex0], 1); atomicAdd(&P.counts[ex1], 1);
        }
        __syncthreads();
    }
}
__global__ void __launch_bounds__(256) k_moe_plan(Params P) {
    __shared__ int sst[NEXP + 1];
    if (threadIdx.x == 0) { int a = 0; for (int e = 0; e < NEXP; ++e) { sst[e] = a; P.starts[e] = a; a += ((P.counts[e] + 127) / 128) * 128; } sst[NEXP] = a; P.nblk[0] = a / 128; }
    __syncthreads();
    for (int bl = threadIdx.x; bl < MAXBLK; bl += 256) { int e = NEXP - 1; for (int i = 0; i < NEXP; ++i) if (bl * 128 >= sst[i] && bl * 128 < sst[i + 1]) e = i; P.blk_exp[bl] = e; }
    for (int i = threadIdx.x; i < MAXROWS; i += 256) { P.row_tok[i] = -1; P.row_slot[i] = 0; P.row_w[i] = 0.f; }
    if (threadIdx.x < NEXP) P.cursor[threadIdx.x] = 0;
}
__global__ void __launch_bounds__(256) k_moe_scatter(Params P) {
    for (int a = blockIdx.x * 256 + threadIdx.x; a < T_TOK * 2; a += gridDim.x * 256) {
        const int e = P.tok_e[a]; const int pos = P.starts[e] + atomicAdd(&P.cursor[e], 1);
        P.row_tok[pos] = a >> 1; P.row_slot[pos] = a; P.row_w[pos] = P.tok_w[a];
    }
}

struct EpiMoeGU { bf16_t* act; int row0, ff0;
    __device__ __forceinline__ void operator()(const f32x4 (&acc)[4][4], int wr, int wc, int fr, int fq) const {
#pragma unroll
        for (int m = 0; m < 4; ++m)
#pragma unroll
            for (int n = 0; n < 2; ++n)
#pragma unroll
                for (int j = 0; j < 4; ++j) { const int row = row0 + wr * 64 + m * 16 + fq * 4 + j, ff = ff0 + wc * 32 + n * 16 + fr;
                    const float g = acc[m][n][j], u = acc[m][n + 2][j]; act[(size_t)row * EFF + ff] = f2bf(siluf(g) * u); }
    }
};
struct LoadF32KN_GU {
    LoadF32KN in;
    __device__ __forceinline__ void init(const float* wg, const float* wu, int ff0) {
        const int c = (threadIdx.x & 31) * 4, wc = c >> 6, j = c & 63, mat = j >> 5, ff = ff0 + wc * 32 + (j & 31);
        in.init(mat ? wu : wg, EFF, ff);
    }
    __device__ __forceinline__ void fetch(int kt) { in.fetch(kt); }
    __device__ __forceinline__ void commit(char* lds) { in.commit(lds); }
};
__global__ void __launch_bounds__(256) k_moe_gu(Params P) {
    __shared__ __attribute__((aligned(16))) char smem[32768];
    const int nb = P.nblk[0];
    for (int u = blockIdx.x; u < nb * 8; u += gridDim.x) {
        const int nt = u & 7, rb = u >> 3, e = P.blk_exp[rb];
        LoadBf16 al; al.init(P.hn, DM, rb * 128, P.row_tok);
        LoadF32KN_GU bl; bl.init(P.w_eg + (size_t)e * DM * EFF, P.w_eu + (size_t)e * DM * EFF, nt * 64);
        EpiMoeGU ep{P.act, rb * 128, nt * 64};
        gemm128(smem, DM / 64, al, bl, ep);
    }
}
struct EpiMoeDown { bf16_t* ymoe; const int* row_tok; const int* row_slot; const float* row_w; int row0, col0;
    __device__ __forceinline__ void operator()(const f32x4 (&acc)[4][4], int wr, int wc, int fr, int fq) const {
#pragma unroll
        for (int m = 0; m < 4; ++m)
#pragma unroll
            for (int j = 0; j < 4; ++j) { const int row = row0 + wr * 64 + m * 16 + fq * 4 + j;
                if (row_tok[row] >= 0) { const float w = row_w[row]; bf16_t* yr = ymoe + (size_t)row_slot[row] * DM + col0 + wc * 64 + fr;
#pragma unroll
                    for (int n = 0; n < 4; ++n) yr[n * 16] = f2bf(acc[m][n][j] * w); } }
    }
};
__global__ void __launch_bounds__(256) k_moe_down(Params P) {
    __shared__ __attribute__((aligned(16))) char smem[32768];
    const int nb = P.nblk[0];
    for (int u = blockIdx.x; u < nb * 16; u += gridDim.x) {
        const int nt = u & 15, rb = u >> 4, e = P.blk_exp[rb];
        LoadBf16 al; al.init(P.act, EFF, rb * 128, nullptr);
        LoadF32KN bl; bl.init(P.w_ed + (size_t)e * EFF * DM, DM, nt * 128 + (threadIdx.x & 31) * 4);
        EpiMoeDown ep{P.ymoe, P.row_tok, P.row_slot, P.row_w, rb * 128, nt * 128};
        gemm128(smem, EFF / 64, al, bl, ep);
    }
}
__global__ void __launch_bounds__(256) k_combine(Params P) {
    for (int t = blockIdx.x; t < T_TOK; t += gridDim.x) {
        float* hr = P.h1 + (size_t)t * DM + threadIdx.x * 8;
        f32x4 v0 = *(const f32x4*)hr, v1 = *(const f32x4*)(hr + 4);
        const u32x4 a = *(const u32x4*)(P.ymoe + (size_t)(2 * t) * DM + threadIdx.x * 8), b = *(const u32x4*)(P.ymoe + (size_t)(2 * t + 1) * DM + threadIdx.x * 8);
        v0[0] += bflo(a[0]) + bflo(b[0]); v0[1] += bfhi(a[0]) + bfhi(b[0]); v0[2] += bflo(a[1]) + bflo(b[1]); v0[3] += bfhi(a[1]) + bfhi(b[1]);
        v1[0] += bflo(a[2]) + bflo(b[2]); v1[1] += bfhi(a[2]) + bfhi(b[2]); v1[2] += bflo(a[3]) + bflo(b[3]); v1[3] += bfhi(a[3]) + bfhi(b[3]);
        *(f32x4*)hr = v0; *(f32x4*)(hr + 4) = v1;
        u32x4 o; o[0] = cvt_pk_bf16(v0[0], v0[1]); o[1] = cvt_pk_bf16(v0[2], v0[3]); o[2] = cvt_pk_bf16(v1[0], v1[1]); o[3] = cvt_pk_bf16(v1[2], v1[3]);
        *(u32x4*)(P.h2b + (size_t)t * DM + threadIdx.x * 8) = o;
    }
}
struct EpiPP { float* pp; int row0, col0;
    __device__ __forceinline__ void operator()(const f32x4 (&acc)[4][4], int wr, int wc, int fr, int fq) const {
#pragma unroll
        for (int m = 0; m < 4; ++m)
#pragma unroll
            for (int n = 0; n < 4; ++n)
#pragma unroll
                for (int j = 0; j < 4; ++j) pp[(size_t)(row0 + wr * 64 + m * 16 + fq * 4 + j) * DM + col0 + wc * 64 + n * 16 + fr] = acc[m][n][j];
    }
};
__global__ void __launch_bounds__(256) k_pleproj(Params P) {
    __shared__ __attribute__((aligned(16))) char smem[32768];
    const int ntn = DM / 128, ntm = T_TOK / 128;
    for (int u = blockIdx.x; u < ntn * ntm; u += gridDim.x) {
        const int tn = u % ntn, tm = u / ntn;
        LoadF32Rows al; al.init(P.p, 256, tm * 128); LoadBf16 bl; bl.init(P.w_pp_t, 256, tn * 128, nullptr);
        EpiPP ep{P.pp, tm * 128, tn * 128};
        gemm128(smem, 256 / 64, al, bl, ep);
    }
}
__global__ void __launch_bounds__(256) k_pp_stats(Params P) {
    __shared__ float red[8];
    for (int t = blockIdx.x; t < T_TOK; t += gridDim.x) {
        const float* r = P.pp + (size_t)t * DM + threadIdx.x * 8; float ss = 0.f;
#pragma unroll
        for (int i = 0; i < 8; ++i) ss += r[i] * r[i];
        ss = block_sum(ss, red);
        if (threadIdx.x == 0) P.prinv[t] = rsqrtf(ss * (1.f / DM) + EPS);
    }
}
struct EpiGate { const float* h2; const float* pp; const float* prinv; const float* ple_g; const float* b_pg; float* out; int row0, col0;
    __device__ __forceinline__ void operator()(const f32x4 (&acc)[4][4], int wr, int wc, int fr, int fq) const {
#pragma unroll
        for (int m = 0; m < 4; ++m)
#pragma unroll
            for (int n = 0; n < 4; ++n)
#pragma unroll
                for (int j = 0; j < 4; ++j) { const int row = row0 + wr * 64 + m * 16 + fq * 4 + j, col = col0 + wc * 64 + n * 16 + fr; const size_t o = (size_t)row * DM + col;
                    const float gte = 1.f / (1.f + expf(-(acc[m][n][j] + b_pg[col]))); const float ple = pp[o] * prinv[row] * ple_g[col]; out[o] = h2[o] + gte * ple; }
    }
};
__global__ void __launch_bounds__(256) k_plegate(Params P) {
    __shared__ __attribute__((aligned(16))) char smem[32768];
    const int ntn = DM / 128, ntm = T_TOK / 128;
    for (int u = blockIdx.x; u < ntn * ntm; u += gridDim.x) {
        const int tn = u % ntn, tm = u / ntn;
        LoadBf16 al, bl; al.init(P.h2b, DM, tm * 128, nullptr); bl.init(P.w_pg_t, DM, tn * 128, nullptr);
        EpiGate ep{P.h1, P.pp, P.prinv, P.ple_g, P.b_pg, P.out, tm * 128, tn * 128};
        gemm128(smem, DM / 64, al, bl, ep);
    }
}
__global__ void __launch_bounds__(256) k_final(Params P) {
    __shared__ float red[8];
    for (int t = blockIdx.x; t < T_TOK; t += gridDim.x) {
        float* r = P.out + (size_t)t * DM + threadIdx.x * 8;
        f32x4 v0 = *(const f32x4*)r, v1 = *(const f32x4*)(r + 4);
        float ss = v0[0] * v0[0] + v0[1] * v0[1] + v0[2] * v0[2] + v0[3] * v0[3] + v1[0] * v1[0] + v1[1] * v1[1] + v1[2] * v1[2] + v1[3] * v1[3];
        ss = block_sum(ss, red);
        const float rr = rsqrtf(ss * (1.f / DM) + EPS);
        const f32x4 g0 = *(const f32x4*)(P.final_g + threadIdx.x * 8), g1 = *(const f32x4*)(P.final_g + threadIdx.x * 8 + 4);
        *(f32x4*)r = v0 * rr * g0; *(f32x4*)(r + 4) = v1 * rr * g1;
    }
}

static inline size_t al256(size_t x) { return (x + 255) & ~(size_t)255; }

extern "C" void kernel_launch(void* const* d_in, const int* in_sizes, int n_in, void* d_out, int out_size, void* d_ws, size_t ws_size, hipStream_t stream) {
    Params P{};
    P.x = (const float*)d_in[0]; P.p = (const float*)d_in[1]; P.pos = (const int*)d_in[2]; P.norm_mix_g = (const float*)d_in[3]; P.w_in = (const float*)d_in[4];
    P.conv_w = (const float*)d_in[5]; P.conv_b = (const float*)d_in[6]; P.dt_bias_f = (const float*)d_in[7]; P.dt_bias_b = (const float*)d_in[8];
    P.a_log_f = (const float*)d_in[9]; P.a_log_b = (const float*)d_in[10]; P.d_skip = (const float*)d_in[11]; P.ssd_norm_g = (const float*)d_in[12];
    P.lam_q1 = (const float*)d_in[13]; P.lam_k1 = (const float*)d_in[14]; P.lam_q2 = (const float*)d_in[15]; P.lam_k2 = (const float*)d_in[16];
    P.subln_g = (const float*)d_in[17]; P.w_out = (const float*)d_in[18]; P.norm_ffn_g = (const float*)d_in[19]; P.w_rg = (const float*)d_in[20];
    P.b_rg = (const float*)d_in[21]; P.w_re = (const float*)d_in[22]; P.b_re = (const float*)d_in[23]; P.w_eg = (const float*)d_in[24];
    P.w_eu = (const float*)d_in[25]; P.w_ed = (const float*)d_in[26]; P.w_pp = (const float*)d_in[27]; P.ple_g = (const float*)d_in[28];
    P.w_pg = (const float*)d_in[29]; P.b_pg = (const float*)d_in[30]; P.final_g = (const float*)d_in[31];
    P.out = (float*)d_out;
    char* ws = (char*)d_ws; size_t o = 0;
    auto take = [&](size_t bytes) { char* r = ws + o; o = al256(o + bytes); return r; };
    P.bar = (unsigned*)take(16384);
    P.counts = (int*)take(256); P.cursor = (int*)take(256); P.starts = (int*)take(512); P.nblk = (int*)take(256);
    P.w_in_t = (bf16_t*)take((size_t)INW_PAD * DM * 2); P.w_out_t = (bf16_t*)take((size_t)DM * DM * 2); P.w_pg_t = (bf16_t*)take((size_t)DM * DM * 2); P.w_pp_t = (bf16_t*)take((size_t)DM * 256 * 2);
    P.nbf = (bf16_t*)take((size_t)T_TOK * DM * 2); P.proj = (bf16_t*)take((size_t)T_TOK * INW * 2); P.dtv = (float*)take((size_t)T_TOK * 32 * 4);
    P.xbc = (bf16_t*)take((size_t)T_TOK * XBCW * 2); P.yf = (float*)take((size_t)T_TOK * SSDW * 4); P.yb = (float*)take((size_t)T_TOK * SSDW * 4);
    P.mix = (bf16_t*)take((size_t)T_TOK * DM * 2); P.h1 = (float*)take((size_t)T_TOK * DM * 4); P.hn = (bf16_t*)take((size_t)T_TOK * DM * 2);
    P.tok_e = (int*)take((size_t)T_TOK * 2 * 4); P.tok_w = (float*)take((size_t)T_TOK * 2 * 4);
    P.row_tok = (int*)take((size_t)MAXROWS * 4); P.row_slot = (int*)take((size_t)MAXROWS * 4); P.row_w = (float*)take((size_t)MAXROWS * 4); P.blk_exp = (int*)take(1024);
    P.act = (bf16_t*)take((size_t)MAXROWS * EFF * 2); P.ymoe = (bf16_t*)take((size_t)T_TOK * 2 * DM * 2); P.h2b = (bf16_t*)take((size_t)T_TOK * DM * 2);
    P.pp = (float*)take((size_t)T_TOK * DM * 4); P.prinv = (float*)take((size_t)T_TOK * 4);
    (void)ws_size; (void)in_sizes; (void)n_in; (void)out_size;

    hipMemsetAsync(P.counts, 0, 256, stream);
    const int G = 2048;
    k_wt<<<G, 256, 0, stream>>>(P.w_in, P.w_in_t, DM, INW, INW_PAD);
    k_wt<<<G, 256, 0, stream>>>(P.w_out, P.w_out_t, DM, DM, DM);
    k_wt<<<G, 256, 0, stream>>>(P.w_pg, P.w_pg_t, DM, DM, DM);
    k_wt<<<512, 256, 0, stream>>>(P.w_pp, P.w_pp_t, 256, DM, DM);
    k_norm_x<<<G, 256, 0, stream>>>(P);
    k_inproj<<<G, 256, 0, stream>>>(P);
    k_prep<<<G, 256, 0, stream>>>(P);
    k_ssd_naive<<<NB * 16 * 2, 256, 0, stream>>>(P);
    k_ssd_gate<<<G, 256, 0, stream>>>(P);
    k_attn_naive<<<NB * 8 * SEQ / 4, 256, 0, stream>>>(P);
    k_outproj<<<G, 256, 0, stream>>>(P);
    k_router<<<G, 256, 0, stream>>>(P);
    k_moe_plan<<<1, 256, 0, stream>>>(P);
    k_moe_scatter<<<64, 256, 0, stream>>>(P);
    k_moe_gu<<<G, 256, 0, stream>>>(P);
    k_moe_down<<<G, 256, 0, stream>>>(P);
    k_combine<<<G, 256, 0, stream>>>(P);
    k_pleproj<<<G, 256, 0, stream>>>(P);
    k_pp_stats<<<G, 256, 0, stream>>>(P);
    k_plegate<<<G, 256, 0, stream>>>(P);
    k_final<<<G, 256, 0, stream>>>(P);
}
```

```cpp
#include <hip/hip_runtime.h>
#include <stdint.h>

typedef unsigned short bf16_t;
typedef short bf16x8 __attribute__((ext_vector_type(8)));
typedef float f32x4 __attribute__((ext_vector_type(4)));
typedef unsigned u32x4 __attribute__((ext_vector_type(4)));
typedef unsigned u32x2 __attribute__((ext_vector_type(2)));

#define NT 512
#define T_TOK 8192
#define DM 2048
#define SEQ 2048
#define NB 4
#define INW 5664
#define INW_PAD 5888
#define OFF_Z 0
#define OFF_XBC 1024
#define OFF_DT 2560
#define OFF_Q 2592
#define OFF_K 3616
#define OFF_V 4640
#define XBCW 1536
#define SSDW 1024
#define NEXP 64
#define EFF 512
#define MAXROWS 24576
#define EPS 1e-6f

__device__ __forceinline__ unsigned cvt_pk_bf16(float lo, float hi) { unsigned r; asm("v_cvt_pk_bf16_f32 %0, %1, %2" : "=v"(r) : "v"(lo), "v"(hi)); return r; }
__device__ __forceinline__ bf16_t f2bf(float x) { return (bf16_t)(cvt_pk_bf16(x, 0.f) & 0xffffu); }
__device__ __forceinline__ float bf2f(bf16_t b) { return __uint_as_float(((unsigned)b) << 16); }
__device__ __forceinline__ float bflo(unsigned u) { return __uint_as_float(u << 16); }
__device__ __forceinline__ float bfhi(unsigned u) { return __uint_as_float(u & 0xffff0000u); }
__device__ __forceinline__ float siluf(float x) { return x / (1.f + expf(-x)); }
__device__ __forceinline__ float wave_sum(float v) { for (int o = 32; o > 0; o >>= 1) v += __shfl_xor(v, o); return v; }
__device__ __forceinline__ float wave_max(float v) { for (int o = 32; o > 0; o >>= 1) v = fmaxf(v, __shfl_xor(v, o)); return v; }
__device__ __forceinline__ float block_sum(float v, float* red) {
    v = wave_sum(v);
    __syncthreads();
    if ((threadIdx.x & 63) == 0) red[threadIdx.x >> 6] = v;
    __syncthreads();
    float s = 0.f;
#pragma unroll
    for (int i = 0; i < NT / 64; ++i) s += red[i];
    return s;
}

#define XB_TMO      128
#define XB_XCNT(j)  (256  + 64 * (j))
#define XB_XSUB(j)  (1280 + 64 * (j))
#define XB_XGEN(j)  (2304 + 64 * (j))
#define XB_TOP      3328
#define XB_TOPGEN   3392
#define XCD_BAR_WORDS 3456
#define XB_SPIN_CAP (1u << 18)
#define LAS __attribute__((address_space(3)))

__device__ __forceinline__ unsigned xb_ld(unsigned* p)              { return __hip_atomic_load(p, __ATOMIC_RELAXED, __HIP_MEMORY_SCOPE_AGENT); }
__device__ __forceinline__ unsigned xb_add(unsigned* p, unsigned v) { return __hip_atomic_fetch_add(p, v, __ATOMIC_RELAXED, __HIP_MEMORY_SCOPE_AGENT); }
__device__ __forceinline__ unsigned xb_xcc_id() { return (unsigned)__builtin_amdgcn_s_getreg((3 << 11) | 20) & 0xFu; }
#define XB_SPIN(cond, bar) do { unsigned _sp = 0; while (cond) { __builtin_amdgcn_s_sleep(1); \
    if ((++_sp & 255u) == 0u) { if (xb_ld(&(bar)[XB_TMO])) break; if (_sp > XB_SPIN_CAP) { atomicAdd(&(bar)[XB_TMO], 1u); break; } } } } while (0)

struct XcdBarrier { unsigned* bar; unsigned x; volatile LAS unsigned* st; };

__device__ __forceinline__ XcdBarrier xcd_barrier_post(unsigned* bar, volatile LAS unsigned* st) {
    XcdBarrier b; b.bar = bar; b.x = xb_xcc_id(); b.st = st;
    if (threadIdx.x == 0) (void)xb_add(&bar[XB_XCNT(b.x)], 1u);
    return b;
}
__device__ __forceinline__ void xcd_barrier_complete(unsigned* bar, unsigned x, unsigned& nloc, unsigned& nx) {
    const unsigned G = gridDim.x * gridDim.y * gridDim.z;
    unsigned sum, cnt, mine, sp = 0u;
    for (;;) {
        sum = 0u; cnt = 0u; mine = 0u;
#pragma unroll
        for (unsigned j = 0; j < 16; ++j) { const unsigned c = xb_ld(&bar[XB_XCNT(j)]); sum += c; cnt += (c > 0u) ? 1u : 0u; mine = (j == x) ? c : mine; }
        if (sum == G) break;
        __builtin_amdgcn_s_sleep(1);
        if ((++sp & 255u) == 0u) { if (xb_ld(&bar[XB_TMO])) break; if (sp > XB_SPIN_CAP) { atomicAdd(&bar[XB_TMO], 1u); break; } }
    }
    nloc = mine > 0u ? mine : 1u; nx = cnt > 0u ? cnt : 1u;
}
__device__ __forceinline__ void xcd_barrier(const XcdBarrier& b) {
    asm volatile("s_waitcnt vmcnt(0)" ::: "memory");
    __syncthreads();
    if (threadIdx.x == 0) {
        unsigned* bar = b.bar;
        __builtin_amdgcn_s_waitcnt(0);
        unsigned nloc = b.st[0], nx = b.st[1];
        if (nloc == 0u) { xcd_barrier_complete(bar, b.x, nloc, nx); b.st[0] = nloc; b.st[1] = nx; }
        const unsigned old = xb_add(&bar[XB_XSUB(b.x)], 1u);
        const unsigned gen = old / nloc;
        if (old + 1u == (gen + 1u) * nloc) {
            __builtin_amdgcn_fence(__ATOMIC_RELEASE, "agent");
            asm volatile("s_waitcnt vmcnt(0)" ::: "memory");
            const unsigned og = xb_add(&bar[XB_TOP], 1u);
            const unsigned tg = og / nx;
            if (og + 1u == (tg + 1u) * nx) xb_add(&bar[XB_TOPGEN], 1u);
            else XB_SPIN(xb_ld(&bar[XB_TOPGEN]) == tg, bar);
            __builtin_amdgcn_fence(__ATOMIC_ACQUIRE, "agent");
            xb_add(&bar[XB_XGEN(b.x)], 1u);
            asm volatile("s_waitcnt vmcnt(0)" ::: "memory");
        } else {
            XB_SPIN(xb_ld(&bar[XB_XGEN(b.x)]) == gen, bar);
            __builtin_amdgcn_fence(__ATOMIC_ACQUIRE, "agent");
            asm volatile("s_waitcnt vmcnt(0)" ::: "memory");
        }
    }
    __syncthreads();
}

struct Params {
    const float* x; const float* p; const int* pos; const float* norm_mix_g; const float* w_in; const float* conv_w; const float* conv_b;
    const float* dt_bias_f; const float* dt_bias_b; const float* a_log_f; const float* a_log_b; const float* d_skip; const float* ssd_norm_g;
    const float* lam_q1; const float* lam_k1; const float* lam_q2; const float* lam_k2; const float* subln_g; const float* w_out; const float* norm_ffn_g;
    const float* w_rg; const float* b_rg; const float* w_re; const float* b_re; const float* w_eg; const float* w_eu; const float* w_ed;
    const float* w_pp; const float* ple_g; const float* w_pg; const float* b_pg; const float* final_g;
    float* out;
    unsigned* bar; int* counts; int* cursor;
    bf16_t* w_in_t; bf16_t* w_out_t; bf16_t* w_pg_t; bf16_t* w_pp_t;
    bf16_t* nbf; bf16_t* proj; float* dtv; bf16_t* xbc; float* yf; float* yb; bf16_t* mix; float* h1; bf16_t* hn;
    int* tok_e; float* tok_w; int* row_tok; int* row_slot; float* row_w;
    bf16_t* act; bf16_t* ymoe; bf16_t* h2b; float* pp; float* prinv;
};

__device__ __forceinline__ void ph_wt(char* smem, const float* __restrict__ w, bf16_t* __restrict__ wt, int K, int N, int Npad) {
    float (*tile)[65] = (float (*)[65])smem;
    const int tilesK = K / 64, tilesN = Npad / 64, tid = threadIdx.x;
    for (int tI = blockIdx.x; tI < tilesK * tilesN; tI += gridDim.x) {
        const int tk = tI % tilesK, tn = tI / tilesK, k0 = tk * 64, n0 = tn * 64;
        for (int i = tid >> 6; i < 64; i += NT / 64) { const int n = n0 + (tid & 63); tile[i][tid & 63] = (n < N) ? w[(size_t)(k0 + i) * N + n] : 0.f; }
        __syncthreads();
        for (int j = tid >> 6; j < 64; j += NT / 64) wt[(size_t)(n0 + j) * K + k0 + (tid & 63)] = f2bf(tile[tid & 63][j]);
        __syncthreads();
    }
}

__device__ __forceinline__ void row_load(const float* r, f32x4 (&v)[8], int lane) {
#pragma unroll
    for (int i = 0; i < 8; ++i) v[i] = *(const f32x4*)(r + (i * 64 + lane) * 4);
}
__device__ __forceinline__ float row_sumsq(const f32x4 (&v)[8]) {
    float s = 0.f;
#pragma unroll
    for (int i = 0; i < 8; ++i) s += v[i][0] * v[i][0] + v[i][1] * v[i][1] + v[i][2] * v[i][2] + v[i][3] * v[i][3];
    return wave_sum(s);
}

__device__ __forceinline__ void ph_norm_x(const Params& P) {
    const int lane = threadIdx.x & 63, w = threadIdx.x >> 6;
    for (int row = blockIdx.x * (NT / 64) + w; row < T_TOK; row += gridDim.x * (NT / 64)) {
        f32x4 v[8]; row_load(P.x + (size_t)row * DM, v, lane);
        const float r = rsqrtf(row_sumsq(v) * (1.f / DM) + EPS);
#pragma unroll
        for (int i = 0; i < 8; ++i) { const f32x4 g = *(const f32x4*)(P.norm_mix_g + (i * 64 + lane) * 4);
            u32x2 o; o[0] = cvt_pk_bf16(v[i][0] * r * g[0], v[i][1] * r * g[1]); o[1] = cvt_pk_bf16(v[i][2] * r * g[2], v[i][3] * r * g[3]);
            *(u32x2*)(P.nbf + (size_t)row * DM + (i * 64 + lane) * 4) = o; }
    }
}

struct LoadBf16 {
    const bf16_t* rp[2]; u32x4 r[2];
    __device__ __forceinline__ void init(const bf16_t* base, size_t ld, int row0, const int* gather) {
#pragma unroll
        for (int i = 0; i < 2; ++i) { const int c = threadIdx.x + i * NT, row = c >> 3, kc = c & 7;
            if (gather) { const int t = gather[row0 + row]; rp[i] = (t >= 0) ? base + (size_t)t * ld + kc * 8 : nullptr; }
            else rp[i] = base + (size_t)(row0 + row) * ld + kc * 8; }
    }
    __device__ __forceinline__ void fetch(int kt) {
#pragma unroll
        for (int i = 0; i < 2; ++i) r[i] = rp[i] ? *(const u32x4*)(rp[i] + kt * 64) : (u32x4){0u, 0u, 0u, 0u};
    }
    __device__ __forceinline__ void commit(char* lds) {
#pragma unroll
        for (int i = 0; i < 2; ++i) { const int c = threadIdx.x + i * NT, row = c >> 3, kc = c & 7, kh = kc >> 2, kq = kc & 3;
            *(u32x4*)(lds + ((kh * 128 + row) * 32 + kq * 8) * 2) = r[i]; }
    }
};
struct LoadF32Rows {
    const float* rp[2]; f32x4 r[2][2];
    __device__ __forceinline__ void init(const float* base, size_t ld, int row0) {
#pragma unroll
        for (int i = 0; i < 2; ++i) { const int c = threadIdx.x + i * NT, row = c >> 3, kc = c & 7; rp[i] = base + (size_t)(row0 + row) * ld + kc * 8; }
    }
    __device__ __forceinline__ void fetch(int kt) {
#pragma unroll
        for (int i = 0; i < 2; ++i) { r[i][0] = *(const f32x4*)(rp[i] + kt * 64); r[i][1] = *(const f32x4*)(rp[i] + kt * 64 + 4); }
    }
    __device__ __forceinline__ void commit(char* lds) {
#pragma unroll
        for (int i = 0; i < 2; ++i) { const int c = threadIdx.x + i * NT, row = c >> 3, kc = c & 7, kh = kc >> 2, kq = kc & 3;
            u32x4 o; o[0] = cvt_pk_bf16(r[i][0][0], r[i][0][1]); o[1] = cvt_pk_bf16(r[i][0][2], r[i][0][3]); o[2] = cvt_pk_bf16(r[i][1][0], r[i][1][1]); o[3] = cvt_pk_bf16(r[i][1][2], r[i][1][3]);
            *(u32x4*)(lds + ((kh * 128 + row) * 32 + kq * 8) * 2) = o; }
    }
};
struct LoadF32KN {
    const float* cp; size_t ldn; f32x4 r[2][2];
    __device__ __forceinline__ void init(const float* w, size_t ldn_, int colg) { ldn = ldn_; cp = w + colg + (size_t)((threadIdx.x >> 5) * 2) * ldn_; }
    __device__ __forceinline__ void fetch(int kt) {
#pragma unroll
        for (int i = 0; i < 2; ++i) { const float* q = cp + (size_t)(kt * 64 + i * 32) * ldn; r[i][0] = *(const f32x4*)q; r[i][1] = *(const f32x4*)(q + ldn); }
    }
    __device__ __forceinline__ void commit(char* lds) {
        const int nn = (threadIdx.x & 31) * 4, kr = threadIdx.x >> 5;
#pragma unroll
        for (int i = 0; i < 2; ++i) { const int kl = i * 32 + kr * 2, kh = kl >> 5, kk = kl & 31;
#pragma unroll
            for (int j = 0; j < 4; ++j) *(unsigned*)(lds + ((kh * 128 + nn + j) * 32 + kk) * 2) = cvt_pk_bf16(r[i][0][j], r[i][1][j]); }
    }
};

template <class AL, class BL, class EP>
__device__ __forceinline__ void gemm128(char* smem, int nk, AL& al, BL& bl, const EP& ep) {
    const int tid = threadIdx.x, wid = tid >> 6, lane = tid & 63, wr = wid >> 2, wc = wid & 3, fr = lane & 15, fq = lane >> 4;
    char* As = smem; char* Bs = smem + 16384;
    f32x4 acc[4][2];
#pragma unroll
    for (int m = 0; m < 4; ++m)
#pragma unroll
        for (int n = 0; n < 2; ++n) acc[m][n] = (f32x4){0.f, 0.f, 0.f, 0.f};
    al.fetch(0); bl.fetch(0);
    for (int kt = 0; kt < nk; ++kt) {
        __syncthreads();
        al.commit(As); bl.commit(Bs);
        __syncthreads();
        if (kt + 1 < nk) { al.fetch(kt + 1); bl.fetch(kt + 1); }
#pragma unroll
        for (int kh = 0; kh < 2; ++kh) {
            bf16x8 a[4], b[2];
#pragma unroll
            for (int m = 0; m < 4; ++m) a[m] = *(const bf16x8*)(As + ((kh * 128 + wr * 64 + m * 16 + fr) * 32 + fq * 8) * 2);
#pragma unroll
            for (int n = 0; n < 2; ++n) b[n] = *(const bf16x8*)(Bs + ((kh * 128 + wc * 32 + n * 16 + fr) * 32 + fq * 8) * 2);
#pragma unroll
            for (int m = 0; m < 4; ++m)
#pragma unroll
                for (int n = 0; n < 2; ++n) acc[m][n] = __builtin_amdgcn_mfma_f32_16x16x32_bf16(a[m], b[n], acc[m][n], 0, 0, 0);
        }
    }
    ep(acc, wr, wc, fr, fq);
    __syncthreads();
}

struct EpiInProj { bf16_t* proj; float* dtv; int row0, col0;
    __device__ __forceinline__ void operator()(const f32x4 (&acc)[4][2], int wr, int wc, int fr, int fq) const {
#pragma unroll
        for (int m = 0; m < 4; ++m)
#pragma unroll
            for (int n = 0; n < 2; ++n) { const int col = col0 + wc * 32 + n * 16 + fr;
                if (col < INW) {
#pragma unroll
                    for (int j = 0; j < 4; ++j) { const int row = row0 + wr * 64 + m * 16 + fq * 4 + j;
                        proj[(size_t)row * INW + col] = f2bf(acc[m][n][j]);
                        if (col >= OFF_DT && col < OFF_DT + 32) dtv[(size_t)row * 32 + (col - OFF_DT)] = acc[m][n][j]; } } }
    }
};
__device__ __forceinline__ void ph_inproj(const Params& P, char* smem) {
    const int ntn = INW_PAD / 128, ntm = T_TOK / 128;
    for (int u = blockIdx.x; u < ntn * ntm; u += gridDim.x) {
        const int tn = u % ntn, tm = u / ntn;
        LoadBf16 al, bl; al.init(P.nbf, DM, tm * 128, nullptr); bl.init(P.w_in_t, DM, tn * 128, nullptr);
        EpiInProj ep{P.proj, P.dtv, tm * 128, tn * 128};
        gemm128(smem, DM / 64, al, bl, ep);
    }
}

__device__ __forceinline__ void ph_prep(const Params& P) {
    const int tid = threadIdx.x;
    for (int t = blockIdx.x; t < T_TOK; t += gridDim.x) {
        const int s = t & (SEQ - 1);
        bf16_t* pr = P.proj + (size_t)t * INW;
        if (tid < 256) {
            const int which = tid >> 7, hc = (tid >> 3) & 15, i = tid & 7;
            const float posf = (float)P.pos[t];
            const float inv_freq = powf(500000.0f, -(float)(2 * i) / 16.0f);
            const float ang = posf * inv_freq;
            const float cs = cosf(ang), sn = sinf(ang);
            bf16_t* q = pr + (which ? OFF_K : OFF_Q) + hc * 64;
            const float t1 = bf2f(q[i]), t2 = bf2f(q[i + 8]);
            q[i] = f2bf(t1 * cs - t2 * sn); q[i + 8] = f2bf(t2 * cs + t1 * sn);
        } else if (tid < 288) {
            const int j = tid - 256; const float b = (j < 16) ? P.dt_bias_f[j] : P.dt_bias_b[j - 16];
            const float v = P.dtv[(size_t)t * 32 + j] + b;
            P.dtv[(size_t)t * 32 + j] = fmaxf(v, 0.f) + log1pf(expf(-fabsf(v)));
        }
        for (int c = tid; c < XBCW; c += NT) {
            float a = P.conv_b[c];
#pragma unroll
            for (int w = 0; w < 5; ++w) { const int ss = s + w - 2;
                if (ss >= 0 && ss < SEQ) a += bf2f(P.proj[(size_t)(t + w - 2) * INW + OFF_XBC + c]) * P.conv_w[w * XBCW + c]; }
            P.xbc[(size_t)t * XBCW + c] = f2bf(siluf(a));
        }
    }
}

__device__ __forceinline__ void ph_ssd_naive(const Params& P, char* smem) {
    bf16_t (*sB)[128] = (bf16_t (*)[128])smem; bf16_t (*sC)[128] = (bf16_t (*)[128])(smem + 16384); bf16_t (*sX)[64] = (bf16_t (*)[64])(smem + 32768); float* sdt = (float*)(smem + 40960);
    const int tid = threadIdx.x;
    for (int u = blockIdx.x; u < NB * 16 * 2; u += gridDim.x) {
        const int dir = u & 1, h = (u >> 1) & 15, b = u >> 5, g = h >> 3;
        const float a = -expf(dir ? P.a_log_b[h] : P.a_log_f[h]);
        const int p = tid >> 3, nq = tid & 7;
        float st[16];
#pragma unroll
        for (int i = 0; i < 16; ++i) st[i] = 0.f;
        float* y = dir ? P.yb : P.yf;
        for (int c = 0; c < SEQ / 64; ++c) {
            const int tbase = dir ? (SEQ - 64 - c * 64) : c * 64;
            __syncthreads();
#pragma unroll
            for (int i = 0; i < 2; ++i) { const int cc = tid + i * NT, r = cc >> 4, q = cc & 15; const bf16_t* src = P.xbc + (size_t)(b * SEQ + tbase + r) * XBCW;
                *(u32x4*)&sB[r][q * 8] = *(const u32x4*)(src + 1024 + g * 128 + q * 8); *(u32x4*)&sC[r][q * 8] = *(const u32x4*)(src + 1280 + g * 128 + q * 8); }
            { const int r = tid >> 3, q = tid & 7; *(u32x4*)&sX[r][q * 8] = *(const u32x4*)(P.xbc + (size_t)(b * SEQ + tbase + r) * XBCW + h * 64 + q * 8); }
            if (tid < 64) sdt[tid] = P.dtv[(size_t)(b * SEQ + tbase + tid) * 32 + dir * 16 + h];
            __syncthreads();
            for (int s = 0; s < 64; ++s) {
                const int r = dir ? 63 - s : s;
                const float dt = sdt[r], dA = expf(dt * a), xd = bf2f(sX[r][p]) * dt;
                float acc = 0.f;
#pragma unroll
                for (int i8 = 0; i8 < 2; ++i8) { const u32x4 bv = *(const u32x4*)&sB[r][nq * 16 + i8 * 8], cv = *(const u32x4*)&sC[r][nq * 16 + i8 * 8];
#pragma unroll
                    for (int e = 0; e < 4; ++e) { float& s0 = st[i8 * 8 + e * 2]; float& s1 = st[i8 * 8 + e * 2 + 1];
                        s0 = s0 * dA + xd * bflo(bv[e]); acc += bflo(cv[e]) * s0; s1 = s1 * dA + xd * bfhi(bv[e]); acc += bfhi(cv[e]) * s1; } }
                acc += __shfl_xor(acc, 1); acc += __shfl_xor(acc, 2); acc += __shfl_xor(acc, 4);
                if (nq == 0) y[(size_t)(b * SEQ + tbase + r) * SSDW + h * 64 + p] = acc;
            }
        }
        __syncthreads();
    }
}

__device__ __forceinline__ void ph_ssd_gate(const Params& P) {
    const int lane = threadIdx.x & 63, w = threadIdx.x >> 6;
    for (int t = blockIdx.x * (NT / 64) + w; t < T_TOK; t += gridDim.x * (NT / 64)) {
        float v[16]; float ss = 0.f;
#pragma unroll
        for (int i = 0; i < 4; ++i) { const int c = (i * 64 + lane) * 4;
            const f32x4 a = *(const f32x4*)(P.yf + (size_t)t * SSDW + c), bb = *(const f32x4*)(P.yb + (size_t)t * SSDW + c);
            const u32x2 xs = *(const u32x2*)(P.xbc + (size_t)t * XBCW + c), zz = *(const u32x2*)(P.proj + (size_t)t * INW + OFF_Z + c);
            const float d = P.d_skip[c >> 6];
            const float xv[4] = {bflo(xs[0]), bfhi(xs[0]), bflo(xs[1]), bfhi(xs[1])}, zv[4] = {bflo(zz[0]), bfhi(zz[0]), bflo(zz[1]), bfhi(zz[1])};
#pragma unroll
            for (int j = 0; j < 4; ++j) { const float y = a[j] + bb[j] + xv[j] * d; v[i * 4 + j] = y * siluf(zv[j]); ss += v[i * 4 + j] * v[i * 4 + j]; } }
        ss = wave_sum(ss);
        const float r = rsqrtf(ss * (1.f / SSDW) + EPS);
#pragma unroll
        for (int i = 0; i < 4; ++i) { const int c = (i * 64 + lane) * 4; const f32x4 g = *(const f32x4*)(P.ssd_norm_g + c);
            u32x2 o; o[0] = cvt_pk_bf16(v[i * 4] * r * g[0], v[i * 4 + 1] * r * g[1]); o[1] = cvt_pk_bf16(v[i * 4 + 2] * r * g[2], v[i * 4 + 3] * r * g[3]);
            *(u32x2*)(P.mix + (size_t)t * DM + c) = o; }
    }
}

__device__ __forceinline__ void ph_attn_naive(const Params& P, char* smem) {
    float (*sq)[128] = (float (*)[128])smem;
    const int lane = threadIdx.x & 63, w = threadIdx.x >> 6;
    float lam;
    { float d1 = P.lam_q1[lane] * P.lam_k1[lane], d2 = P.lam_q2[lane] * P.lam_k2[lane]; d1 = wave_sum(d1); d2 = wave_sum(d2); lam = expf(d1) - expf(d2) + 0.2f; }
    for (int u = blockIdx.x; u < NB * 8 * SEQ / (NT / 64); u += gridDim.x) {
        const int gq = u * (NT / 64) + w;
        const int q = gq & (SEQ - 1), h = (gq >> 11) & 7, b = gq >> 14;
        const bf16_t* qrow = P.proj + (size_t)(b * SEQ + q) * INW + OFF_Q + h * 128;
        __syncthreads();
        sq[w][lane] = bf2f(qrow[lane]) * 0.125f; sq[w][lane + 64] = bf2f(qrow[lane + 64]) * 0.125f;
        __syncthreads();
        float m1 = -INFINITY, m2 = -INFINITY, l1 = 0.f, l2 = 0.f, o1a = 0.f, o1b = 0.f, o2a = 0.f, o2b = 0.f;
        for (int j0 = 0; j0 < SEQ; j0 += 64) {
            const bf16_t* krow = P.proj + (size_t)(b * SEQ + j0 + lane) * INW + OFF_K + h * 128;
            float s1 = 0.f, s2 = 0.f;
#pragma unroll
            for (int c = 0; c < 8; ++c) { const u32x4 kk = *(const u32x4*)(krow + c * 8);
#pragma unroll
                for (int e = 0; e < 4; ++e) s1 += sq[w][c * 8 + 2 * e] * bflo(kk[e]) + sq[w][c * 8 + 2 * e + 1] * bfhi(kk[e]); }
#pragma unroll
            for (int c = 0; c < 8; ++c) { const u32x4 kk = *(const u32x4*)(krow + 64 + c * 8);
#pragma unroll
                for (int e = 0; e < 4; ++e) s2 += sq[w][64 + c * 8 + 2 * e] * bflo(kk[e]) + sq[w][64 + c * 8 + 2 * e + 1] * bfhi(kk[e]); }
            const float m1n = fmaxf(m1, wave_max(s1)), m2n = fmaxf(m2, wave_max(s2));
            const float p1 = expf(s1 - m1n), p2 = expf(s2 - m2n), c1 = expf(m1 - m1n), c2 = expf(m2 - m2n);
            l1 = l1 * c1 + wave_sum(p1); l2 = l2 * c2 + wave_sum(p2);
            o1a *= c1; o1b *= c1; o2a *= c2; o2b *= c2; m1 = m1n; m2 = m2n;
            for (int jj = 0; jj < 64; ++jj) {
                const float pj1 = __shfl(p1, jj), pj2 = __shfl(p2, jj);
                const bf16_t* vrow = P.proj + (size_t)(b * SEQ + j0 + jj) * INW + OFF_V + h * 128;
                const float v0 = bf2f(vrow[lane]), v1 = bf2f(vrow[lane + 64]);
                o1a += pj1 * v0; o1b += pj1 * v1; o2a += pj2 * v0; o2b += pj2 * v1;
            }
        }
        const float oa = o1a / l1 - lam * o2a / l2, ob = o1b / l1 - lam * o2b / l2;
        const float ss = wave_sum(oa * oa + ob * ob) * (1.f / 128.f);
        const float r = rsqrtf(ss + EPS) * 0.8f;
        bf16_t* mo = P.mix + (size_t)(b * SEQ + q) * DM + 1024 + h * 128;
        mo[lane] = f2bf(oa * r * P.subln_g[lane]); mo[lane + 64] = f2bf(ob * r * P.subln_g[lane + 64]);
    }
    __syncthreads();
}

struct EpiOutProj { const float* x; float* h1; int row0, col0;
    __device__ __forceinline__ void operator()(const f32x4 (&acc)[4][2], int wr, int wc, int fr, int fq) const {
#pragma unroll
        for (int m = 0; m < 4; ++m)
#pragma unroll
            for (int n = 0; n < 2; ++n)
#pragma unroll
                for (int j = 0; j < 4; ++j) { const size_t o = (size_t)(row0 + wr * 64 + m * 16 + fq * 4 + j) * DM + col0 + wc * 32 + n * 16 + fr; h1[o] = x[o] + acc[m][n][j]; }
    }
};
__device__ __forceinline__ void ph_outproj(const Params& P, char* smem) {
    const int ntn = DM / 128, ntm = T_TOK / 128;
    for (int u = blockIdx.x; u < ntn * ntm; u += gridDim.x) {
        const int tn = u % ntn, tm = u / ntn;
        LoadBf16 al, bl; al.init(P.mix, DM, tm * 128, nullptr); bl.init(P.w_out_t, DM, tn * 128, nullptr);
        EpiOutProj ep{P.x, P.h1, tm * 128, tn * 128};
        gemm128(smem, DM / 64, al, bl, ep);
    }
}

__device__ __forceinline__ void ph_router(const Params& P, char* smem) {
    float* sh = (float*)smem; float* red = (float*)(smem + 8192); float (*pe)[64] = (float (*)[64])(smem + 8192 + 64); float (*pg)[8] = (float (*)[8])(smem + 8192 + 64 + 2048);
    const int tid = threadIdx.x;
    for (int t = blockIdx.x; t < T_TOK; t += gridDim.x) {
        const f32x4 v = *(const f32x4*)(P.h1 + (size_t)t * DM + tid * 4);
        float ss = v[0] * v[0] + v[1] * v[1] + v[2] * v[2] + v[3] * v[3];
        ss = block_sum(ss, red);
        const float r = rsqrtf(ss * (1.f / DM) + EPS);
        const f32x4 g = *(const f32x4*)(P.norm_ffn_g + tid * 4);
        const f32x4 o = v * r * g;
        u32x2 ob; ob[0] = cvt_pk_bf16(o[0], o[1]); ob[1] = cvt_pk_bf16(o[2], o[3]);
        *(u32x2*)(P.hn + (size_t)t * DM + tid * 4) = ob;
        *(f32x4*)(sh + tid * 4) = o;
        __syncthreads();
        const int j = tid & 63, ks = tid >> 6;
        float ae = 0.f, ag = 0.f;
        for (int k = ks * 256; k < ks * 256 + 256; ++k) { const float hv = sh[k]; ae += hv * P.w_re[(size_t)k * 64 + j]; if (j < 8) ag += hv * P.w_rg[(size_t)k * 8 + j]; }
        pe[ks][j] = ae; if (j < 8) pg[ks][j] = ag;
        __syncthreads();
        if (tid == 0) {
            float gl[8]; int gs = 0; float gm = -INFINITY;
#pragma unroll
            for (int i = 0; i < 8; ++i) { float a = P.b_rg[i];
#pragma unroll
                for (int s = 0; s < 8; ++s) a += pg[s][i];
                gl[i] = a; if (a > gm) { gm = a; gs = i; } }
            float den = 0.f;
#pragma unroll
            for (int i = 0; i < 8; ++i) den += expf(gl[i] - gm);
            const float p_g = 1.f / den;
            int i0 = 0, i1 = 0; float e0 = -INFINITY, e1 = -INFINITY;
#pragma unroll
            for (int i = 0; i < 8; ++i) { const int c = gs * 8 + i; float a = P.b_re[c];
                for (int s = 0; s < 8; ++s) a += pe[s][c];
                if (a > e0) { e1 = e0; i1 = i0; e0 = a; i0 = i; } else if (a > e1) { e1 = a; i1 = i; } }
            const float x1 = expf(e1 - e0), w0 = 1.f / (1.f + x1), w1 = x1 / (1.f + x1);
            const int ex0 = gs * 8 + i0, ex1 = gs * 8 + i1;
            P.tok_e[t * 2] = ex0; P.tok_e[t * 2 + 1] = ex1; P.tok_w[t * 2] = p_g * w0; P.tok_w[t * 2 + 1] = p_g * w1;
            atomicAdd(&P.counts[ex0], 1); atomicAdd(&P.counts[ex1], 1);
        }
        __syncthreads();
    }
}
__device__ __forceinline__ void moe_starts(const Params& P, int* sst) {
    __syncthreads();
    if (threadIdx.x == 0) { int a = 0; for (int e = 0; e < NEXP; ++e) { sst[e] = a; a += ((__hip_atomic_load(&P.counts[e], __ATOMIC_RELAXED, __HIP_MEMORY_SCOPE_AGENT) + 127) / 128) * 128; } sst[NEXP] = a; }
    __syncthreads();
}
__device__ __forceinline__ void ph_moe_scatter(const Params& P, char* smem) {
    int* sst = (int*)smem; moe_starts(P, sst);
    for (int a = blockIdx.x * NT + threadIdx.x; a < T_TOK * 2; a += gridDim.x * NT) {
        const int e = P.tok_e[a]; const int pos = sst[e] + atomicAdd(&P.cursor[e], 1);
        P.row_tok[pos] = a >> 1; P.row_slot[pos] = a; P.row_w[pos] = P.tok_w[a];
    }
}
__device__ __forceinline__ int moe_blk_exp(const int* sst, int rb) { int e = 0;
#pragma unroll 1
    for (int i = 0; i < NEXP; ++i) if (rb * 128 >= sst[i + 1]) e = i + 1;
    return e < NEXP ? e : NEXP - 1; }

struct EpiMoeGU { bf16_t* act; int row0, ff0;
    __device__ __forceinline__ void operator()(const f32x4 (&acc)[4][2], int wr, int wc, int fr, int fq) const {
#pragma unroll
        for (int m = 0; m < 4; ++m)
#pragma unroll
            for (int j = 0; j < 4; ++j) { const int row = row0 + wr * 64 + m * 16 + fq * 4 + j, ff = ff0 + wc * 16 + fr;
                const float g = acc[m][0][j], u = acc[m][1][j]; act[(size_t)row * EFF + ff] = f2bf(siluf(g) * u); }
    }
};
struct LoadF32KN_GU {
    LoadF32KN in;
    __device__ __forceinline__ void init(const float* wg, const float* wu, int ff0) {
        const int c = (threadIdx.x & 31) * 4, wc = c >> 5, j = c & 31, mat = j >> 4, ff = ff0 + wc * 16 + (j & 15);
        in.init(mat ? wu : wg, EFF, ff);
    }
    __device__ __forceinline__ void fetch(int kt) { in.fetch(kt); }
    __device__ __forceinline__ void commit(char* lds) { in.commit(lds); }
};
__device__ __forceinline__ void ph_moe_gu(const Params& P, char* smem) {
    int* sst = (int*)(smem + 32768); moe_starts(P, sst);
    const int nb = sst[NEXP] / 128;
    for (int u = blockIdx.x; u < nb * 8; u += gridDim.x) {
        const int nt = u & 7, rb = u >> 3, e = moe_blk_exp(sst, rb);
        LoadBf16 al; al.init(P.hn, DM, rb * 128, P.row_tok);
        LoadF32KN_GU bl; bl.init(P.w_eg + (size_t)e * DM * EFF, P.w_eu + (size_t)e * DM * EFF, nt * 64);
        EpiMoeGU ep{P.act, rb * 128, nt * 64};
        gemm128(smem, DM / 64, al, bl, ep);
    }
}
struct EpiMoeDown { bf16_t* ymoe; const int* row_tok; const int* row_slot; const float* row_w; int row0, col0;
    __device__ __forceinline__ void operator()(const f32x4 (&acc)[4][2], int wr, int wc, int fr, int fq) const {
#pragma unroll
        for (int m = 0; m < 4; ++m)
#pragma unroll
            for (int j = 0; j < 4; ++j) { const int row = row0 + wr * 64 + m * 16 + fq * 4 + j;
                if (row_tok[row] >= 0) { const float w = row_w[row]; bf16_t* yr = ymoe + (size_t)row_slot[row] * DM + col0 + wc * 32 + fr;
#pragma unroll
                    for (int n = 0; n < 2; ++n) yr[n * 16] = f2bf(acc[m][n][j] * w); } }
    }
};
__device__ __forceinline__ void ph_moe_down(const Params& P, char* smem) {
    int* sst = (int*)(smem + 32768); moe_starts(P, sst);
    const int nb = sst[NEXP] / 128;
    for (int u = blockIdx.x; u < nb * 16; u += gridDim.x) {
        const int nt = u & 15, rb = u >> 4, e = moe_blk_exp(sst, rb);
        LoadBf16 al; al.init(P.act, EFF, rb * 128, nullptr);
        LoadF32KN bl; bl.init(P.w_ed + (size_t)e * EFF * DM, DM, nt * 128 + (threadIdx.x & 31) * 4);
        EpiMoeDown ep{P.ymoe, P.row_tok, P.row_slot, P.row_w, rb * 128, nt * 128};
        gemm128(smem, EFF / 64, al, bl, ep);
    }
}
__device__ __forceinline__ void ph_combine(const Params& P) {
    const int lane = threadIdx.x & 63, w = threadIdx.x >> 6;
    for (int t = blockIdx.x * (NT / 64) + w; t < T_TOK; t += gridDim.x * (NT / 64)) {
        float* hr = P.h1 + (size_t)t * DM;
#pragma unroll
        for (int i = 0; i < 8; ++i) { const int c = (i * 64 + lane) * 4;
            f32x4 v = *(const f32x4*)(hr + c);
            const u32x2 a = *(const u32x2*)(P.ymoe + (size_t)(2 * t) * DM + c), b = *(const u32x2*)(P.ymoe + (size_t)(2 * t + 1) * DM + c);
            v[0] += bflo(a[0]) + bflo(b[0]); v[1] += bfhi(a[0]) + bfhi(b[0]); v[2] += bflo(a[1]) + bflo(b[1]); v[3] += bfhi(a[1]) + bfhi(b[1]);
            *(f32x4*)(hr + c) = v;
            u32x2 o; o[0] = cvt_pk_bf16(v[0], v[1]); o[1] = cvt_pk_bf16(v[2], v[3]);
            *(u32x2*)(P.h2b + (size_t)t * DM + c) = o; }
        f32x4 pv[8]; row_load(P.pp + (size_t)t * DM, pv, lane);
        const float ss = row_sumsq(pv);
        if (lane == 0) P.prinv[t] = rsqrtf(ss * (1.f / DM) + EPS);
    }
}
struct EpiPP { float* pp; int row0, col0;
    __device__ __forceinline__ void operator()(const f32x4 (&acc)[4][2], int wr, int wc, int fr, int fq) const {
#pragma unroll
        for (int m = 0; m < 4; ++m)
#pragma unroll
            for (int n = 0; n < 2; ++n)
#pragma unroll
                for (int j = 0; j < 4; ++j) pp[(size_t)(row0 + wr * 64 + m * 16 + fq * 4 + j) * DM + col0 + wc * 32 + n * 16 + fr] = acc[m][n][j];
    }
};
__device__ __forceinline__ void ph_pleproj(const Params& P, char* smem) {
    const int ntn = DM / 128, ntm = T_TOK / 128;
    for (int u = blockIdx.x; u < ntn * ntm; u += gridDim.x) {
        const int tn = u % ntn, tm = u / ntn;
        LoadF32Rows al; al.init(P.p, 256, tm * 128); LoadBf16 bl; bl.init(P.w_pp_t, 256, tn * 128, nullptr);
        EpiPP ep{P.pp, tm * 128, tn * 128};
        gemm128(smem, 256 / 64, al, bl, ep);
    }
}
struct EpiGate { const float* h2; const float* pp; const float* prinv; const float* ple_g; const float* b_pg; float* out; int row0, col0;
    __device__ __forceinline__ void operator()(const f32x4 (&acc)[4][2], int wr, int wc, int fr, int fq) const {
#pragma unroll
        for (int m = 0; m < 4; ++m)
#pragma unroll
            for (int n = 0; n < 2; ++n)
#pragma unroll
                for (int j = 0; j < 4; ++j) { const int row = row0 + wr * 64 + m * 16 + fq * 4 + j, col = col0 + wc * 32 + n * 16 + fr; const size_t o = (size_t)row * DM + col;
                    const float gte = 1.f / (1.f + expf(-(acc[m][n][j] + b_pg[col]))); const float ple = pp[o] * prinv[row] * ple_g[col]; out[o] = h2[o] + gte * ple; }
    }
};
__device__ __forceinline__ void ph_plegate(const Params& P, char* smem) {
    const int ntn = DM / 128, ntm = T_TOK / 128;
    for (int u = blockIdx.x; u < ntn * ntm; u += gridDim.x) {
        const int tn = u % ntn, tm = u / ntn;
        LoadBf16 al, bl; al.init(P.h2b, DM, tm * 128, nullptr); bl.init(P.w_pg_t, DM, tn * 128, nullptr);
        EpiGate ep{P.h1, P.pp, P.prinv, P.ple_g, P.b_pg, P.out, tm * 128, tn * 128};
        gemm128(smem, DM / 64, al, bl, ep);
    }
}
__device__ __forceinline__ void ph_final(const Params& P) {
    const int lane = threadIdx.x & 63, w = threadIdx.x >> 6;
    for (int t = blockIdx.x * (NT / 64) + w; t < T_TOK; t += gridDim.x * (NT / 64)) {
        float* r = P.out + (size_t)t * DM;
        f32x4 v[8]; row_load(r, v, lane);
        const float rr = rsqrtf(row_sumsq(v) * (1.f / DM) + EPS);
#pragma unroll
        for (int i = 0; i < 8; ++i) { const f32x4 g = *(const f32x4*)(P.final_g + (i * 64 + lane) * 4); *(f32x4*)(r + (i * 64 + lane) * 4) = v[i] * rr * g; }
    }
}

#define LDS_BYTES 49152
__global__ void __launch_bounds__(NT, 2) hymba_fwd(Params P) {
    extern __shared__ __attribute__((aligned(16))) char smem_raw[];
    char* smem = smem_raw + 16;
    if (threadIdx.x == 0) *(uint4*)smem_raw = make_uint4(0u, 0u, 0u, 0u);
    __syncthreads();
    XcdBarrier bar = xcd_barrier_post(P.bar, (volatile LAS unsigned*)smem_raw);
    ph_wt(smem, P.w_in, P.w_in_t, DM, INW, INW_PAD);
    ph_wt(smem, P.w_out, P.w_out_t, DM, DM, DM);
    ph_wt(smem, P.w_pg, P.w_pg_t, DM, DM, DM);
    ph_wt(smem, P.w_pp, P.w_pp_t, 256, DM, DM);
    ph_norm_x(P);
    for (int i = blockIdx.x * NT + threadIdx.x; i < MAXROWS; i += gridDim.x * NT) { P.row_tok[i] = -1; P.row_slot[i] = 0; P.row_w[i] = 0.f; }
    xcd_barrier(bar);
    ph_inproj(P, smem);
    ph_pleproj(P, smem);
    xcd_barrier(bar);
    ph_prep(P);
    xcd_barrier(bar);
    ph_ssd_naive(P, smem);
    ph_attn_naive(P, smem);
    xcd_barrier(bar);
    ph_ssd_gate(P);
    xcd_barrier(bar);
    ph_outproj(P, smem);
    xcd_barrier(bar);
    ph_router(P, smem);
    xcd_barrier(bar);
    ph_moe_scatter(P, smem);
    xcd_barrier(bar);
    ph_moe_gu(P, smem);
    xcd_barrier(bar);
    ph_moe_down(P, smem);
    xcd_barrier(bar);
    ph_combine(P);
    xcd_barrier(bar);
    ph_plegate(P, smem);
    xcd_barrier(bar);
    ph_final(P);
}

static inline size_t al256(size_t x) { return (x + 255) & ~(size_t)255; }

extern "C" void kernel_launch(void* const* d_in, const int* in_sizes, int n_in, void* d_out, int out_size, void* d_ws, size_t ws_size, hipStream_t stream) {
    Params P{};
    P.x = (const float*)d_in[0]; P.p = (const float*)d_in[1]; P.pos = (const int*)d_in[2]; P.norm_mix_g = (const float*)d_in[3]; P.w_in = (const float*)d_in[4];
    P.conv_w = (const float*)d_in[5]; P.conv_b = (const float*)d_in[6]; P.dt_bias_f = (const float*)d_in[7]; P.dt_bias_b = (const float*)d_in[8];
    P.a_log_f = (const float*)d_in[9]; P.a_log_b = (const float*)d_in[10]; P.d_skip = (const float*)d_in[11]; P.ssd_norm_g = (const float*)d_in[12];
    P.lam_q1 = (const float*)d_in[13]; P.lam_k1 = (const float*)d_in[14]; P.lam_q2 = (const float*)d_in[15]; P.lam_k2 = (const float*)d_in[16];
    P.subln_g = (const float*)d_in[17]; P.w_out = (const float*)d_in[18]; P.norm_ffn_g = (const float*)d_in[19]; P.w_rg = (const float*)d_in[20];
    P.b_rg = (const float*)d_in[21]; P.w_re = (const float*)d_in[22]; P.b_re = (const float*)d_in[23]; P.w_eg = (const float*)d_in[24];
    P.w_eu = (const float*)d_in[25]; P.w_ed = (const float*)d_in[26]; P.w_pp = (const float*)d_in[27]; P.ple_g = (const float*)d_in[28];
    P.w_pg = (const float*)d_in[29]; P.b_pg = (const float*)d_in[30]; P.final_g = (const float*)d_in[31];
    P.out = (float*)d_out;
    char* ws = (char*)d_ws; size_t o = 0;
    auto take = [&](size_t bytes) { char* r = ws + o; o = al256(o + bytes); return r; };
    P.bar = (unsigned*)take(16384);
    P.counts = (int*)(P.bar + 3584); P.cursor = (int*)(P.bar + 3584 + 128);
    P.w_in_t = (bf16_t*)take((size_t)INW_PAD * DM * 2); P.w_out_t = (bf16_t*)take((size_t)DM * DM * 2); P.w_pg_t = (bf16_t*)take((size_t)DM * DM * 2); P.w_pp_t = (bf16_t*)take((size_t)DM * 256 * 2);
    P.nbf = (bf16_t*)take((size_t)T_TOK * DM * 2); P.proj = (bf16_t*)take((size_t)T_TOK * INW * 2); P.dtv = (float*)take((size_t)T_TOK * 32 * 4);
    P.xbc = (bf16_t*)take((size_t)T_TOK * XBCW * 2); P.yf = (float*)take((size_t)T_TOK * SSDW * 4); P.yb = (float*)take((size_t)T_TOK * SSDW * 4);
    P.mix = (bf16_t*)take((size_t)T_TOK * DM * 2); P.h1 = (float*)take((size_t)T_TOK * DM * 4); P.hn = (bf16_t*)take((size_t)T_TOK * DM * 2);
    P.tok_e = (int*)take((size_t)T_TOK * 2 * 4); P.tok_w = (float*)take((size_t)T_TOK * 2 * 4);
    P.row_tok = (int*)take((size_t)MAXROWS * 4); P.row_slot = (int*)take((size_t)MAXROWS * 4); P.row_w = (float*)take((size_t)MAXROWS * 4);
    P.act = (bf16_t*)take((size_t)MAXROWS * EFF * 2); P.ymoe = (bf16_t*)take((size_t)T_TOK * 2 * DM * 2); P.h2b = (bf16_t*)take((size_t)T_TOK * DM * 2);
    P.pp = (float*)take((size_t)T_TOK * DM * 4); P.prinv = (float*)take((size_t)T_TOK * 4);
    (void)ws_size; (void)in_sizes; (void)n_in; (void)out_size;

    static int grid = 0;
    if (!grid) {
        int dev = 0, cus = 0, per_cu = 0;
        (void)hipGetDevice(&dev);
        (void)hipDeviceGetAttribute(&cus, hipDeviceAttributeMultiprocessorCount, dev);
        (void)hipFuncSetAttribute((const void*)hymba_fwd, hipFuncAttributeMaxDynamicSharedMemorySize, LDS_BYTES);
        (void)hipOccupancyMaxActiveBlocksPerMultiprocessor(&per_cu, hymba_fwd, NT, LDS_BYTES);
        if (cus <= 0) cus = 256;
        grid = cus * (per_cu < 1 ? 1 : 1);
    }
    (void)hipMemsetAsync(P.bar, 0, 16384, stream);
    hipLaunchKernelGGL(hymba_fwd, dim3(grid), dim3(NT), LDS_BYTES, stream, P);
}
```

```cpp
#include <hip/hip_runtime.h>
#include <stdint.h>

typedef unsigned short bf16_t;
typedef short bf16x8 __attribute__((ext_vector_type(8)));
typedef float f32x4 __attribute__((ext_vector_type(4)));
typedef unsigned u32x4 __attribute__((ext_vector_type(4)));
typedef unsigned u32x2 __attribute__((ext_vector_type(2)));

#define NT 512
#define T_TOK 8192
#define DM 2048
#define SEQ 2048
#define NB 4
#define INW 5664
#define INW_PAD 5888
#define OFF_Z 0
#define OFF_XBC 1024
#define OFF_DT 2560
#define OFF_Q 2592
#define OFF_K 3616
#define OFF_V 4640
#define XBCW 1536
#define SSDW 1024
#define NEXP 64
#define EFF 512
#define MAXROWS 24576
#define EPS 1e-6f

__device__ __forceinline__ int TIDX() { int t = (int)__builtin_amdgcn_workitem_id_x(); asm volatile("" : "+v"(t)); return t; }
typedef __bf16 bf16x2_t __attribute__((ext_vector_type(2)));
typedef float f32x2_t __attribute__((ext_vector_type(2)));
__device__ __forceinline__ unsigned cvt_pk_bf16(float lo, float hi) { const f32x2_t v = {lo, hi}; return __builtin_bit_cast(unsigned, __builtin_convertvector(v, bf16x2_t)); }
__device__ __forceinline__ bf16_t f2bf(float x) { return (bf16_t)(cvt_pk_bf16(x, 0.f) & 0xffffu); }
__device__ __forceinline__ float bf2f(bf16_t b) { return __uint_as_float(((unsigned)b) << 16); }
__device__ __forceinline__ float bflo(unsigned u) { return __uint_as_float(u << 16); }
__device__ __forceinline__ float bfhi(unsigned u) { return __uint_as_float(u & 0xffff0000u); }
__device__ __forceinline__ float siluf(float x) { return x / (1.f + expf(-x)); }
__device__ __forceinline__ int olane() { int l = (int)__builtin_amdgcn_mbcnt_hi(~0u, __builtin_amdgcn_mbcnt_lo(~0u, 0u)); asm volatile("" : "+v"(l)); return l; }
__device__ __forceinline__ float shx(float v, int ln, int m) { return __builtin_bit_cast(float, __builtin_amdgcn_ds_bpermute((ln ^ m) << 2, __builtin_bit_cast(int, v))); }
__device__ __forceinline__ float wave_sum(float v) { const int ln = olane(); for (int o = 32; o > 0; o >>= 1) v += shx(v, ln, o); return v; }
__device__ __forceinline__ float wave_max(float v) { const int ln = olane(); for (int o = 32; o > 0; o >>= 1) v = fmaxf(v, shx(v, ln, o)); return v; }
__device__ __forceinline__ float block_sum(float v, float* red) {
    v = wave_sum(v);
    __syncthreads();
    if ((TIDX() & 63) == 0) red[TIDX() >> 6] = v;
    __syncthreads();
    float s = 0.f;
#pragma unroll
    for (int i = 0; i < NT / 64; ++i) s += red[i];
    return s;
}

#define XB_TMO      128
#define XB_XCNT(j)  (256  + 64 * (j))
#define XB_XSUB(j)  (1280 + 64 * (j))
#define XB_XGEN(j)  (2304 + 64 * (j))
#define XB_TOP      3328
#define XB_TOPGEN   3392
#define XCD_BAR_WORDS 3456
#define XB_SPIN_CAP (1u << 18)
#define LAS __attribute__((address_space(3)))

__device__ __forceinline__ unsigned xb_ld(unsigned* p)              { return __hip_atomic_load(p, __ATOMIC_RELAXED, __HIP_MEMORY_SCOPE_AGENT); }
__device__ __forceinline__ unsigned xb_add(unsigned* p, unsigned v) { return __hip_atomic_fetch_add(p, v, __ATOMIC_RELAXED, __HIP_MEMORY_SCOPE_AGENT); }
__device__ __forceinline__ unsigned xb_xcc_id() { return (unsigned)__builtin_amdgcn_s_getreg((3 << 11) | 20) & 0xFu; }
#define XB_SPIN(cond, bar) do { unsigned _sp = 0; while (cond) { __builtin_amdgcn_s_sleep(1); \
    if ((++_sp & 255u) == 0u) { if (xb_ld(&(bar)[XB_TMO])) break; if (_sp > XB_SPIN_CAP) { atomicAdd(&(bar)[XB_TMO], 1u); break; } } } } while (0)

struct XcdBarrier { unsigned* bar; unsigned x; volatile LAS unsigned* st; };

__device__ __forceinline__ XcdBarrier xcd_barrier_post(unsigned* bar, volatile LAS unsigned* st) {
    XcdBarrier b; b.bar = bar; b.x = xb_xcc_id(); b.st = st;
    if (TIDX() == 0) (void)xb_add(&bar[XB_XCNT(b.x)], 1u);
    return b;
}
__device__ __forceinline__ void xcd_barrier_complete(unsigned* bar, unsigned x, unsigned& nloc, unsigned& nx) {
    const unsigned G = gridDim.x * gridDim.y * gridDim.z;
    unsigned sum, cnt, mine, sp = 0u;
    for (;;) {
        sum = 0u; cnt = 0u; mine = 0u;
#pragma unroll
        for (unsigned j = 0; j < 16; ++j) { const unsigned c = xb_ld(&bar[XB_XCNT(j)]); sum += c; cnt += (c > 0u) ? 1u : 0u; mine = (j == x) ? c : mine; }
        if (sum == G) break;
        __builtin_amdgcn_s_sleep(1);
        if ((++sp & 255u) == 0u) { if (xb_ld(&bar[XB_TMO])) break; if (sp > XB_SPIN_CAP) { atomicAdd(&bar[XB_TMO], 1u); break; } }
    }
    nloc = mine > 0u ? mine : 1u; nx = cnt > 0u ? cnt : 1u;
}
__device__ __forceinline__ void xcd_barrier(const XcdBarrier& b) {
    asm volatile("s_waitcnt vmcnt(0)" ::: "memory");
    __syncthreads();
    if (TIDX() == 0) {
        unsigned* bar = b.bar;
        __builtin_amdgcn_s_waitcnt(0);
        unsigned nloc = b.st[0], nx = b.st[1];
        if (nloc == 0u) { xcd_barrier_complete(bar, b.x, nloc, nx); b.st[0] = nloc; b.st[1] = nx; }
        const unsigned old = xb_add(&bar[XB_XSUB(b.x)], 1u);
        const unsigned gen = old / nloc;
        if (old + 1u == (gen + 1u) * nloc) {
            __builtin_amdgcn_fence(__ATOMIC_RELEASE, "agent");
            asm volatile("s_waitcnt vmcnt(0)" ::: "memory");
            const unsigned og = xb_add(&bar[XB_TOP], 1u);
            const unsigned tg = og / nx;
            if (og + 1u == (tg + 1u) * nx) xb_add(&bar[XB_TOPGEN], 1u);
            else XB_SPIN(xb_ld(&bar[XB_TOPGEN]) == tg, bar);
            __builtin_amdgcn_fence(__ATOMIC_ACQUIRE, "agent");
            xb_add(&bar[XB_XGEN(b.x)], 1u);
            asm volatile("s_waitcnt vmcnt(0)" ::: "memory");
        } else {
            XB_SPIN(xb_ld(&bar[XB_XGEN(b.x)]) == gen, bar);
            __builtin_amdgcn_fence(__ATOMIC_ACQUIRE, "agent");
            asm volatile("s_waitcnt vmcnt(0)" ::: "memory");
        }
    }
    __syncthreads();
}

struct Params {
    const float* x; const float* p; const int* pos; const float* norm_mix_g; const float* w_in; const float* conv_w; const float* conv_b;
    const float* dt_bias_f; const float* dt_bias_b; const float* a_log_f; const float* a_log_b; const float* d_skip; const float* ssd_norm_g;
    const float* lam_q1; const float* lam_k1; const float* lam_q2; const float* lam_k2; const float* subln_g; const float* w_out; const float* norm_ffn_g;
    const float* w_rg; const float* b_rg; const float* w_re; const float* b_re; const float* w_eg; const float* w_eu; const float* w_ed;
    const float* w_pp; const float* ple_g; const float* w_pg; const float* b_pg; const float* final_g;
    float* out;
    unsigned* bar; int* counts; int* cursor;
    bf16_t* w_in_t; bf16_t* w_out_t; bf16_t* w_pg_t; bf16_t* w_pp_t;
    bf16_t* nbf; bf16_t* proj; float* dtv; bf16_t* xbc; float* yf; float* yb; bf16_t* mix; float* h1; bf16_t* hn;
    int* tok_e; float* tok_w; int* row_tok; int* row_slot; float* row_w;
    bf16_t* act; bf16_t* ymoe; bf16_t* h2b; bf16_t* pp; float* prss; float* wcat; float* rope; bf16_t* h3b;
};

__device__ __forceinline__ void ph_wt(char* smem, const float* __restrict__ w, bf16_t* __restrict__ wt, int K, int N, int Npad) {
    float* tile = (float*)smem;
    const int tilesK = K / 64, tilesN = Npad / 64, tid = TIDX();
    for (int tI = blockIdx.x; tI < tilesK * tilesN; tI += gridDim.x) {
        const int tk = tI % tilesK, tn = tI / tilesK, k0 = tk * 64, n0 = tn * 64;
#pragma unroll
        for (int j = 0; j < 2; ++j) { const int row = (tid >> 4) + 32 * j, n4 = (tid & 15) * 4, n = n0 + n4;
            f32x4 v = {0.f, 0.f, 0.f, 0.f};
            if (n + 3 < N) v = *(const f32x4*)(w + (size_t)(k0 + row) * N + n);
            else { for (int e = 0; e < 4; ++e) if (n + e < N) v[e] = w[(size_t)(k0 + row) * N + n + e]; }
#pragma unroll
            for (int e = 0; e < 4; ++e) tile[row * 65 + n4 + e] = v[e]; }
        __syncthreads();
#pragma unroll
        for (int j = 0; j < 2; ++j) { const int item = tid + NT * j, kq = item & 15, n = item >> 4;
            u32x2 o; o[0] = cvt_pk_bf16(tile[(4 * kq) * 65 + n], tile[(4 * kq + 1) * 65 + n]); o[1] = cvt_pk_bf16(tile[(4 * kq + 2) * 65 + n], tile[(4 * kq + 3) * 65 + n]);
            *(u32x2*)(wt + (size_t)(n0 + n) * K + k0 + 4 * kq) = o; }
        __syncthreads();
    }
}

__device__ __forceinline__ void row_load(const float* r, f32x4 (&v)[8], int lane) {
#pragma unroll
    for (int i = 0; i < 8; ++i) v[i] = *(const f32x4*)(r + (i * 64 + lane) * 4);
}
__device__ __forceinline__ float row_sumsq(const f32x4 (&v)[8]) {
    float s = 0.f;
#pragma unroll
    for (int i = 0; i < 8; ++i) s += v[i][0] * v[i][0] + v[i][1] * v[i][1] + v[i][2] * v[i][2] + v[i][3] * v[i][3];
    return wave_sum(s);
}

__device__ __forceinline__ void ph_norm_x(const Params& P) {
    const int lane = TIDX() & 63, w = TIDX() >> 6;
    for (int row = blockIdx.x * (NT / 64) + w; row < T_TOK; row += gridDim.x * (NT / 64)) {
        f32x4 v[8]; row_load(P.x + (size_t)row * DM, v, lane);
        const float r = rsqrtf(row_sumsq(v) * (1.f / DM) + EPS);
#pragma unroll
        for (int i = 0; i < 8; ++i) { const f32x4 g = *(const f32x4*)(P.norm_mix_g + (i * 64 + lane) * 4);
            u32x2 o; o[0] = cvt_pk_bf16(v[i][0] * r * g[0], v[i][1] * r * g[1]); o[1] = cvt_pk_bf16(v[i][2] * r * g[2], v[i][3] * r * g[3]);
            *(u32x2*)(P.nbf + (size_t)row * DM + (i * 64 + lane) * 4) = o; }
    }
}

struct LoadBf16 {
    const bf16_t* rp[2]; u32x4 r[2];
    __device__ __forceinline__ void init(const bf16_t* base, size_t ld, int row0, const int* gather) {
#pragma unroll
        for (int i = 0; i < 2; ++i) { const int c = TIDX() + i * NT, row = c >> 3, kc = c & 7;
            if (gather) { const int t = gather[row0 + row]; rp[i] = (t >= 0) ? base + (size_t)t * ld + kc * 8 : nullptr; }
            else rp[i] = base + (size_t)(row0 + row) * ld + kc * 8; }
    }
    __device__ __forceinline__ void fetch(int kt) {
#pragma unroll
        for (int i = 0; i < 2; ++i) r[i] = rp[i] ? *(const u32x4*)(rp[i] + kt * 64) : (u32x4){0u, 0u, 0u, 0u};
    }
    __device__ __forceinline__ void commit(char* lds) {
#pragma unroll
        for (int i = 0; i < 2; ++i) { const int c = TIDX() + i * NT, row = c >> 3, kc = c & 7, kh = kc >> 2, kq = kc & 3;
            *(u32x4*)(lds + ((kh * 128 + row) * 32 + kq * 8) * 2) = r[i]; }
    }
};
struct LoadF32Rows {
    const float* rp[2]; f32x4 r[2][2];
    __device__ __forceinline__ void init(const float* base, size_t ld, int row0) {
#pragma unroll
        for (int i = 0; i < 2; ++i) { const int c = TIDX() + i * NT, row = c >> 3, kc = c & 7; rp[i] = base + (size_t)(row0 + row) * ld + kc * 8; }
    }
    __device__ __forceinline__ void fetch(int kt) {
#pragma unroll
        for (int i = 0; i < 2; ++i) { r[i][0] = *(const f32x4*)(rp[i] + kt * 64); r[i][1] = *(const f32x4*)(rp[i] + kt * 64 + 4); }
    }
    __device__ __forceinline__ void commit(char* lds) {
#pragma unroll
        for (int i = 0; i < 2; ++i) { const int c = TIDX() + i * NT, row = c >> 3, kc = c & 7, kh = kc >> 2, kq = kc & 3;
            u32x4 o; o[0] = cvt_pk_bf16(r[i][0][0], r[i][0][1]); o[1] = cvt_pk_bf16(r[i][0][2], r[i][0][3]); o[2] = cvt_pk_bf16(r[i][1][0], r[i][1][1]); o[3] = cvt_pk_bf16(r[i][1][2], r[i][1][3]);
            *(u32x4*)(lds + ((kh * 128 + row) * 32 + kq * 8) * 2) = o; }
    }
};
template <class AL, class BL, class EP>
__device__ __forceinline__ void gemm128(char* smem, int nk, AL& al, BL& bl, const EP& ep) {
    const int tid = TIDX(), wid = tid >> 6, lane = tid & 63, wr = wid >> 2, wc = wid & 3, fr = lane & 15, fq = lane >> 4;
    char* As = smem; char* Bs = smem + 16384;
    f32x4 acc[4][2];
#pragma unroll
    for (int m = 0; m < 4; ++m)
#pragma unroll
        for (int n = 0; n < 2; ++n) acc[m][n] = (f32x4){0.f, 0.f, 0.f, 0.f};
    al.fetch(0); bl.fetch(0);
    for (int kt = 0; kt < nk; ++kt) {
        __syncthreads();
        al.commit(As); bl.commit(Bs);
        __syncthreads();
        if (kt + 1 < nk) { al.fetch(kt + 1); bl.fetch(kt + 1); }
#pragma unroll
        for (int kh = 0; kh < 2; ++kh) {
            bf16x8 a[4], b[2];
#pragma unroll
            for (int m = 0; m < 4; ++m) a[m] = *(const bf16x8*)(As + ((kh * 128 + wr * 64 + m * 16 + fr) * 32 + fq * 8) * 2);
#pragma unroll
            for (int n = 0; n < 2; ++n) b[n] = *(const bf16x8*)(Bs + ((kh * 128 + wc * 32 + n * 16 + fr) * 32 + fq * 8) * 2);
#pragma unroll
            for (int m = 0; m < 4; ++m)
#pragma unroll
                for (int n = 0; n < 2; ++n) acc[m][n] = __builtin_amdgcn_mfma_f32_16x16x32_bf16(a[m], b[n], acc[m][n], 0, 0, 0);
        }
    }
    ep(acc, wr, wc, fr, fq);
    __syncthreads();
}

namespace pg8 {
#define PG8_LAS __attribute__((address_space(3)))
typedef unsigned short bf16_t;
typedef short bf16x8 __attribute__((ext_vector_type(8)));
typedef float f32x4 __attribute__((ext_vector_type(4)));
typedef unsigned u32x4 __attribute__((ext_vector_type(4)));
constexpr int BM = 256, BK = 64, HALF = 128, HTB = HALF * BK * 2  , STAGE_BYTES = 8 * HTB, NXCD = 8, WGM = 8;

__host__ __device__ __forceinline__ int lds_byte(int r, int c) { const int st = (r >> 4) * 2 + (c >> 5), rr = r & 15, cc = c & 31, ob = rr * 64 + cc * 2; return st * 1024 + (ob ^ (((ob >> 9) & 1) << 5)); }
__host__ __device__ __forceinline__ void stage_rc(int b, int& R, int& C) { const int st = b / 1024, sb = b % 1024, swz = sb ^ (((sb >> 9) & 1) << 5); R = (st >> 1) * 16 + swz / 64; C = (st & 1) * 32 + (swz % 64) / 2; }
__host__ __device__ __forceinline__ int perm32(int rho) { const int n = rho >> 4, i = rho & 15; return 8 * (i >> 2) + 4 * n + (i & 3); }

struct Unit { int pm, pn; };
struct Gemm { const bf16_t* A; const bf16_t* Bt; int M, N, K; };

struct StaticOrder {
    int nM, nN, nwg, G, c;
    __host__ __device__ void init(int M, int N, int G_, int c_) { nM = M / BM; nN = N / BM; nwg = nM * nN; G = G_; c = c_; }
    __host__ __device__ bool next(int i, Unit& u) const {
        const long L = (long)i * G + c; if (L >= nwg) return false;
        int wgid = (int)L; { const int q = nwg / NXCD, r = nwg % NXCD, xcd = wgid % NXCD, off = wgid / NXCD; wgid = (xcd < r ? xcd * (q + 1) : r * (q + 1) + (xcd - r) * q) + off; }
        const int nig = WGM * nN, gid = wgid / nig, fm = gid * WGM, gsz = (nM - fm) < WGM ? (nM - fm) : WGM;
        u.pm = fm + ((wgid % nig) % gsz); u.pn = (wgid % nig) / gsz; return true;
    }
    __device__ __forceinline__ void a_ready(const Unit&) const {}
    __device__ __forceinline__ void done(const Unit&) const {}
};

template <class Epi, class Sched, bool STAMP = false>
__device__ __forceinline__ void gemm_phase(PG8_LAS unsigned char* lds, const Gemm g, const Sched& S, const Epi& E, unsigned long long* stamps) {
    const int tid = TIDX(), wid = __builtin_amdgcn_readfirstlane(tid >> 6), lane = tid & 63, wr = wid >> 2, wc = wid & 3, fr = lane & 15, fq = lane >> 4;
    const int K = g.K, nt = K / BK;
    int ts_lo = 0, ts_hi = 0, nts = 0; const unsigned long long rt_entry = STAMP ? (unsigned long long)wall_clock64() : 0ull;
#define PG8_STAMP() do { if (STAMP && wid == 0 && nts < 64) { const unsigned long long _c = (unsigned long long)clock64(); \
        ts_lo = (lane == nts) ? (int)(unsigned)_c : ts_lo; ts_hi = (lane == nts) ? (int)(unsigned)(_c >> 32) : ts_hi; ++nts; } } while (0)
    PG8_STAMP();
    unsigned voffA[2], voffB[2];
#pragma unroll
    for (int i = 0; i < 2; ++i) { int R, C; stage_rc(tid * 16 + i * 8192, R, C); const int Rb = Epi::PERM ? ((R & ~31) + perm32(R & 31)) : R;
        voffA[i] = (unsigned)(R * K + C) * 2u; voffB[i] = (unsigned)(Rb * K + C) * 2u; }
    const size_t kstep = (size_t)(BK * 2);
    const size_t hstep = (size_t)HALF * K * 2;
    const size_t tstep = 2 * hstep;
    const unsigned ldsw = (unsigned)wid * 1024u;
    const int aoff = lds_byte(wr * 64 + fr, fq * 8), boff = lds_byte(wc * 32 + fr, fq * 8);
#define PG8_SA(b, h) (((b) * 2 + (h)) * HTB)
#define PG8_SB(b, h) ((4 + (b) * 2 + (h)) * HTB)
#define PG8_STAGE(bufoff, gbase, voff) do { _Pragma("unroll") for (int _i = 0; _i < 2; ++_i) \
        __builtin_amdgcn_global_load_lds((const unsigned*)((const char*)(gbase) + (voff)[_i]), (PG8_LAS unsigned*)(lds + (bufoff) + ldsw + _i * 8192), 16, 0, 0); } while (0)
#define PG8_LDA(dst, b, h) do { _Pragma("unroll") for (int m = 0; m < 4; ++m) _Pragma("unroll") for (int k = 0; k < 2; ++k) dst[m][k] = *(const PG8_LAS bf16x8*)(lds + PG8_SA(b, h) + aoff + m * 2048 + k * 1024); } while (0)
#define PG8_LDB(dst, b, h) do { _Pragma("unroll") for (int n = 0; n < 2; ++n) _Pragma("unroll") for (int k = 0; k < 2; ++k) dst[n][k] = *(const PG8_LAS bf16x8*)(lds + PG8_SB(b, h) + boff + n * 2048 + k * 1024); } while (0)
#define PG8_MMA(ai, bj, At, Bt) do { __builtin_amdgcn_s_setprio(1); _Pragma("unroll") for (int m = 0; m < 4; ++m) _Pragma("unroll") for (int n = 0; n < 2; ++n) _Pragma("unroll") for (int k = 0; k < 2; ++k) \
        acc[ai][bj][m][n] = __builtin_amdgcn_mfma_f32_16x16x32_bf16(Bt[n][k], At[m][k], acc[ai][bj][m][n], 0, 0, 0); __builtin_amdgcn_s_setprio(0); } while (0)
#define PG8_WAIT_V(n) asm volatile("s_waitcnt vmcnt(" #n ")" ::: "memory")
#define PG8_WAIT_L(n) asm volatile("s_waitcnt lgkmcnt(" #n ")" ::: "memory")
#define PG8_BAR __builtin_amdgcn_s_barrier()
#define PG8_SCHED __builtin_amdgcn_sched_barrier(0)
    Unit cur, nxt; int ui = 0;
    if (!S.next(0, cur)) return;
    f32x4 acc[2][2][4][2];
#pragma unroll
    for (int a = 0; a < 2; ++a)
#pragma unroll
        for (int b = 0; b < 2; ++b)
#pragma unroll
            for (int m = 0; m < 4; ++m)
#pragma unroll
                for (int n = 0; n < 2; ++n) acc[a][b][m][n] = (f32x4){0.f, 0.f, 0.f, 0.f};
    bf16x8 At[4][2], B0[2][2], B1[2][2];
    const char* cA = (const char*)g.A + (size_t)cur.pm * tstep; const char* cB = (const char*)g.Bt + (size_t)cur.pn * tstep;
    S.a_ready(cur);
    PG8_STAGE(PG8_SB(0, 0), cB, voffB); PG8_STAGE(PG8_SA(0, 0), cA, voffA); PG8_STAGE(PG8_SB(0, 1), cB + hstep, voffB); PG8_STAGE(PG8_SA(0, 1), cA + hstep, voffA);
    if (wr == 1) PG8_BAR;
    PG8_WAIT_V(4); PG8_BAR;
    PG8_STAGE(PG8_SB(1, 0), cB + kstep, voffB); PG8_STAGE(PG8_SA(1, 0), cA + kstep, voffA); PG8_STAGE(PG8_SB(1, 1), cB + hstep + kstep, voffB);
    PG8_WAIT_V(6); PG8_BAR;
    PG8_STAMP();
    for (;;) {
        const bool has_next = S.next(ui + 1, nxt);
        const char* nA = has_next ? (const char*)g.A + (size_t)nxt.pm * tstep : cA; const char* nB = has_next ? (const char*)g.Bt + (size_t)nxt.pn * tstep : cB;
        for (int t = 0; t < nt; t += 2) {
            const bool last = (t == nt - 2);
            const char* a1 = cA + (size_t)(t + 1) * kstep;
            const char* a2 = last ? nA : cA + (size_t)(t + 2) * kstep; const char* b2 = last ? nB : cB + (size_t)(t + 2) * kstep;
            const char* a3 = a2 + kstep; const char* b3 = b2 + kstep;
            if (last && has_next) S.a_ready(nxt);
            PG8_LDB(B0, 0, 0); PG8_SCHED; PG8_LDA(At, 0, 0); PG8_STAGE(PG8_SA(1, 1), a1 + hstep, voffA);
            PG8_WAIT_L(8); PG8_BAR; PG8_WAIT_L(0); PG8_MMA(0, 0, At, B0); PG8_BAR; PG8_SCHED;
            PG8_LDB(B1, 0, 1); PG8_STAGE(PG8_SB(0, 0), b2, voffB);
            PG8_BAR; PG8_WAIT_L(0); PG8_MMA(0, 1, At, B1); PG8_BAR;
            PG8_LDA(At, 0, 1); PG8_STAGE(PG8_SA(0, 0), a2, voffA);
            PG8_BAR; PG8_WAIT_L(0); PG8_MMA(1, 0, At, B0); PG8_BAR; PG8_SCHED;
            PG8_STAGE(PG8_SB(0, 1), b2 + hstep, voffB);
            PG8_WAIT_V(6); PG8_BAR; PG8_MMA(1, 1, At, B1); PG8_BAR;
            PG8_LDB(B0, 1, 0); PG8_SCHED; PG8_LDA(At, 1, 0); PG8_STAGE(PG8_SA(0, 1), a2 + hstep, voffA);
            PG8_WAIT_L(8); PG8_BAR; PG8_WAIT_L(0); PG8_MMA(0, 0, At, B0); PG8_BAR; PG8_SCHED;
            PG8_LDB(B1, 1, 1); PG8_STAGE(PG8_SB(1, 0), b3, voffB);
            PG8_BAR; PG8_WAIT_L(0); PG8_MMA(0, 1, At, B1); PG8_BAR;
            PG8_LDA(At, 1, 1); PG8_STAGE(PG8_SA(1, 0), a3, voffA);
            PG8_BAR; PG8_WAIT_L(0); PG8_MMA(1, 0, At, B0); PG8_BAR; PG8_SCHED;
            PG8_STAGE(PG8_SB(1, 1), b3 + hstep, voffB);
            PG8_WAIT_V(6); PG8_BAR; PG8_MMA(1, 1, At, B1); PG8_BAR;
        }
        PG8_STAMP();
        if constexpr (!Epi::AFTER_DRAIN) { E(acc, cur, wr, wc, fr, fq); S.done(cur); }
        PG8_STAMP();
        if (!has_next) break;
#pragma unroll
        for (int a = 0; a < 2; ++a)
#pragma unroll
            for (int b = 0; b < 2; ++b)
#pragma unroll
                for (int m = 0; m < 4; ++m)
#pragma unroll
                    for (int n = 0; n < 2; ++n) acc[a][b][m][n] = (f32x4){0.f, 0.f, 0.f, 0.f};
        cur = nxt; cA = nA; cB = nB; ++ui;
    }
    PG8_WAIT_V(0);
    if (wr == 0) PG8_BAR;
    PG8_BAR;
    if constexpr (Epi::AFTER_DRAIN) { E.fused(acc, cur, wr, wc, fr, fq, lds, wid, lane); S.done(cur); }
    PG8_STAMP();
    if (STAMP && wid == 0) { stamps[lane] = lane < nts ? (((unsigned long long)(unsigned)ts_hi << 32) | (unsigned)ts_lo) : 0ull;
        if (lane == 62) stamps[62] = rt_entry; if (lane == 63) stamps[63] = (unsigned long long)wall_clock64(); }
#undef PG8_STAMP
#undef PG8_SA
#undef PG8_SB
#undef PG8_STAGE
#undef PG8_LDA
#undef PG8_LDB
#undef PG8_MMA
#undef PG8_WAIT_V
#undef PG8_WAIT_L
#undef PG8_BAR
#undef PG8_SCHED
}
}


struct EpiInProjF {
    static constexpr bool PERM = true, AFTER_DRAIN = false;
    bf16_t* proj; float* dtv; const float* rope; const float* dt_bias_f; const float* dt_bias_b;
    __device__ __forceinline__ void operator()(const f32x4 (&acc)[2][2][4][2], const pg8::Unit& u, int wr, int wc, int fr, int fq) const {
        const int row0 = u.pm * 256 + wr * 64 + fr;
        const bool qk_tile = (u.pn >= 10) && (u.pn <= 18);
#pragma unroll
        for (int ai = 0; ai < 2; ++ai)
#pragma unroll
            for (int m = 0; m < 4; ++m) { const int row = row0 + ai * 128 + m * 16;
                f32x4 c0 = {0.f, 0.f, 0.f, 0.f}, c1 = c0, s0 = c0, s1 = c0;
                if (qk_tile) { const float* rp = rope + (size_t)row * 16; c0 = *(const f32x4*)rp; c1 = *(const f32x4*)(rp + 4); s0 = *(const f32x4*)(rp + 8); s1 = *(const f32x4*)(rp + 12); }
#pragma unroll
                for (int bj = 0; bj < 2; ++bj) { const int col0 = u.pn * 256 + bj * 128 + wc * 32 + 8 * fq;
                    f32x4 v0 = acc[ai][bj][m][0], v1 = acc[ai][bj][m][1];
                    if (qk_tile) {
                        f32x4 p0, p1;
                        const int ln_ = olane();
#pragma unroll
                        for (int j = 0; j < 4; ++j) { p0[j] = shx(v0[j], ln_, 16); p1[j] = shx(v1[j], ln_, 16); }
                        const int d0 = (col0 - OFF_Q) & 63;
                        if (col0 >= OFF_Q && col0 < OFF_V && d0 < 16) {
                            if (d0 == 0) { v0 = v0 * c0 - p0 * s0; v1 = v1 * c1 - p1 * s1; }
                            else         { v0 = v0 * c0 + p0 * s0; v1 = v1 * c1 + p1 * s1; }
                        }
                    }
                    if (col0 < INW) {
                        u32x4 w; w[0] = cvt_pk_bf16(v0[0], v0[1]); w[1] = cvt_pk_bf16(v0[2], v0[3]); w[2] = cvt_pk_bf16(v1[0], v1[1]); w[3] = cvt_pk_bf16(v1[2], v1[3]);
                        *(u32x4*)(proj + (size_t)row * INW + col0) = w;
                        if (col0 >= OFF_DT && col0 < OFF_DT + 32) { const int j0 = col0 - OFF_DT; const float* bp = (j0 < 16) ? (dt_bias_f + j0) : (dt_bias_b + (j0 - 16));
                            f32x4 o0, o1;
#pragma unroll
                            for (int j = 0; j < 4; ++j) { const float a = v0[j] + bp[j], b = v1[j] + bp[4 + j];
                                o0[j] = fmaxf(a, 0.f) + log1pf(expf(-fabsf(a))); o1[j] = fmaxf(b, 0.f) + log1pf(expf(-fabsf(b))); }
                            *(f32x4*)(dtv + (size_t)row * 32 + j0) = o0; *(f32x4*)(dtv + (size_t)row * 32 + j0 + 4) = o1; } } } }
    }
};
__device__ __forceinline__ void ph_inproj(const Params& P, char* smem) {
    pg8::Gemm g{P.nbf, P.w_in_t, T_TOK, INW_PAD, DM};
    pg8::StaticOrder S; S.init(T_TOK, INW_PAD, gridDim.x, blockIdx.x);
    EpiInProjF E{P.proj, P.dtv, P.rope, P.dt_bias_f, P.dt_bias_b};
    pg8::gemm_phase<EpiInProjF, pg8::StaticOrder>((PG8_LAS unsigned char*)smem, g, S, E, nullptr);
    __syncthreads();
}

__device__ __forceinline__ void ph_rope_table(const Params& P) {
    for (int i = blockIdx.x * NT + TIDX(); i < T_TOK * 8; i += gridDim.x * NT) { const int t = i >> 3, f = i & 7;
        const float ang = (float)P.pos[t] * powf(500000.0f, -(float)(2 * f) / 16.0f);
        P.rope[t * 16 + f] = cosf(ang); P.rope[t * 16 + 8 + f] = sinf(ang); }
}
__device__ __forceinline__ void ph_conv(const Params& P) {
    for (int id = blockIdx.x * NT + TIDX(); id < (XBCW / 8) * (T_TOK / 16); id += gridDim.x * NT) {
        const int cg = id % (XBCW / 8), tg = id / (XBCW / 8), c = cg * 8, t0 = tg * 16, s0 = t0 & (SEQ - 1);
        float w[5][8], bias[8];
#pragma unroll
        for (int k = 0; k < 5; ++k) { const f32x4 a = *(const f32x4*)(P.conv_w + k * XBCW + c), b = *(const f32x4*)(P.conv_w + k * XBCW + c + 4);
#pragma unroll
            for (int j = 0; j < 4; ++j) { w[k][j] = a[j]; w[k][4 + j] = b[j]; } }
        { const f32x4 a = *(const f32x4*)(P.conv_b + c), b = *(const f32x4*)(P.conv_b + c + 4);
#pragma unroll
          for (int j = 0; j < 4; ++j) { bias[j] = a[j]; bias[4 + j] = b[j]; } }
        const bf16_t* src = P.proj + (size_t)t0 * INW + OFF_XBC + c;
        u32x4 win[5];
#pragma unroll
        for (int k = 0; k < 4; ++k) { const int ss = s0 + k - 2; win[k + 1] = (ss >= 0) ? *(const u32x4*)(src + (ptrdiff_t)(k - 2) * INW) : (u32x4){0u, 0u, 0u, 0u}; }
#pragma unroll
        for (int r = 0; r < 16; ++r) {
#pragma unroll
            for (int k = 0; k < 4; ++k) win[k] = win[k + 1];
            { const int ss = s0 + r + 2; win[4] = (ss < SEQ) ? *(const u32x4*)(src + (ptrdiff_t)(r + 2) * INW) : (u32x4){0u, 0u, 0u, 0u}; }
            float o[8];
#pragma unroll
            for (int j = 0; j < 8; ++j) o[j] = bias[j];
#pragma unroll
            for (int k = 0; k < 5; ++k)
#pragma unroll
                for (int e = 0; e < 4; ++e) { o[2 * e] += bflo(win[k][e]) * w[k][2 * e]; o[2 * e + 1] += bfhi(win[k][e]) * w[k][2 * e + 1]; }
            u32x4 ov;
#pragma unroll
            for (int e = 0; e < 4; ++e) { const float a = o[2 * e], b = o[2 * e + 1]; ov[e] = cvt_pk_bf16(a / (1.f + __expf(-a)), b / (1.f + __expf(-b))); }
            *(u32x4*)(P.xbc + (size_t)(t0 + r) * XBCW + c) = ov;
        }
    }
}

typedef float f32x16 __attribute__((ext_vector_type(16)));
typedef short s16x4 __attribute__((ext_vector_type(4)));
__device__ __forceinline__ int crow(int r, int hi) { return (r & 3) + 8 * (r >> 2) + 4 * hi; }
__device__ __forceinline__ unsigned off_b(unsigned row, unsigned ch) { return 256u * row + 16u * (ch ^ (((row & 3) << 2) | ((row >> 2) & 3))); }
__device__ __forceinline__ unsigned off_x(unsigned l, unsigned ch) { return 128u * l + 16u * (ch ^ (((l >> 1) & 1) << 2)); }
__device__ __forceinline__ s16x4 tr_read_a(unsigned addr) { s16x4 r; asm volatile("ds_read_b64_tr_b16 %0, %1" : "=&v"(r) : "v"(addr) : "memory"); return r; }
#define SSD_B 0
#define SSD_C 32768
#define SSD_XD 65536
#define SSD_XE 81920
#define SSD_S 98304
#define SSD_ARR 114688
#define SSD_SPLIT 10
__device__ __forceinline__ void ph_ssd(const Params& P, char* smem) {
    const int tid = TIDX(), wid = __builtin_amdgcn_readfirstlane(tid >> 6), lane = tid & 63, r32 = lane & 31, hi = lane >> 5;
    const unsigned lbase = (unsigned)(uintptr_t)smem;
    float* arrA = (float*)(smem + SSD_ARR); float* arrEA = arrA + 128; float* arrDT = arrA + 256; float* arrDTE = arrA + 384; float* arrTOT = arrA + 512;
    const int lt = wid >> 1, pt = wid & 1;
    const int spt = wid >> 2, snt = wid & 3;
    const unsigned tq = (lane & 15) >> 2, tp = lane & 3, tblk = (lane >> 4) & 1;
#pragma unroll 1
    for (int u = blockIdx.x; u < NB * 16 * 2 * 2; u += gridDim.x) {
        const int dir = u & 1, h = (u >> 1) & 15, b = (u >> 5) & 3, hv = u >> 7, g = h >> 3;
        const float a = -expf(dir ? P.a_log_b[h] : P.a_log_f[h]);
        float* y = dir ? P.yb : P.yf;
        f32x16 S = f32x16{};
        __syncthreads();
        for (int i = tid; i < 64 * 128 / 2; i += NT) ((unsigned*)(smem + SSD_S))[i] = 0u;
#pragma unroll 1
        for (int ci = 0; ci < (hv ? SEQ / 128 : SSD_SPLIT); ++ci) {
            const bool full = ci >= (hv ? SSD_SPLIT : 0);
            const int c = dir ? (SEQ / 128 - 1 - ci) : ci;
            const size_t t0 = (size_t)b * SEQ + (size_t)c * 128;
            __syncthreads();
            u32x4 rb[4], rc[4], rx[2];
#pragma unroll
            for (int i = 0; i < 4; ++i) { const int cc = tid + i * NT, l = cc >> 4, ch = cc & 15; const bf16_t* src = P.xbc + (t0 + l) * XBCW + g * 128 + ch * 8;
                rb[i] = *(const u32x4*)(src + 1024); if (full) rc[i] = *(const u32x4*)(src + 1280); }
#pragma unroll
            for (int i = 0; i < 2; ++i) { const int cc = tid + i * NT, l = cc >> 3, ch = cc & 7; rx[i] = *(const u32x4*)(P.xbc + (t0 + l) * XBCW + h * 64 + ch * 8); }
            if (wid == 0) {
                const float dt0 = P.dtv[(t0 + 2 * lane) * 32 + dir * 16 + h], dt1 = P.dtv[(t0 + 2 * lane + 1) * 32 + dir * 16 + h];
                const float da0 = dt0 * a, da1 = dt1 * a;
                float pr = da0 + da1;
#pragma unroll
                for (int o = 1; o < 64; o <<= 1) { const float v = __shfl_up(pr, o); if (lane >= o) pr += v; }
                const float tot = __shfl(pr, 63), acs1 = pr, acs0 = pr - da1;
                const float A0 = dir ? (tot - acs0 + da0) : acs0, A1 = dir ? (tot - acs1 + da1) : acs1;
                arrA[2 * lane] = A0; arrA[2 * lane + 1] = A1; arrEA[2 * lane] = expf(A0); arrEA[2 * lane + 1] = expf(A1);
                arrDT[2 * lane] = dt0; arrDT[2 * lane + 1] = dt1; arrDTE[2 * lane] = dt0 * expf(tot - A0); arrDTE[2 * lane + 1] = dt1 * expf(tot - A1);
                if (lane == 0) arrTOT[0] = expf(tot);
            }
#pragma unroll
            for (int i = 0; i < 4; ++i) { const int cc = tid + i * NT, l = cc >> 4, ch = cc & 15; *(u32x4*)(smem + SSD_B + off_b(l, ch)) = rb[i]; if (full) *(u32x4*)(smem + SSD_C + off_b(l, ch)) = rc[i]; }
            __syncthreads();
#pragma unroll
            for (int i = 0; i < 2; ++i) { const int cc = tid + i * NT, l = cc >> 3, ch = cc & 7; const float dt = arrDT[l], dte = arrDTE[l];
                u32x4 xd, xe;
#pragma unroll
                for (int e = 0; e < 4; ++e) { const float lo = bflo(rx[i][e]), hv = bfhi(rx[i][e]); xd[e] = cvt_pk_bf16(lo * dt, hv * dt); xe[e] = cvt_pk_bf16(lo * dte, hv * dte); }
                if (full) *(u32x4*)(smem + SSD_XD + off_x(l, ch)) = xd; *(u32x4*)(smem + SSD_XE + off_x(l, ch)) = xe; }
            __syncthreads();
            if (full) {
            f32x16 Y = f32x16{};
#define SSD_CF(ks) (*(const bf16x8*)(smem + SSD_C + off_b(32 * lt + r32, 2 * (ks) + hi)))
            if (ci > 0) {
#pragma unroll
                for (int ks = 0; ks < 8; ++ks) { const bf16x8 sf = *(const bf16x8*)(smem + SSD_S + off_b(32 * pt + r32, 2 * ks + hi));
                    Y = __builtin_amdgcn_mfma_f32_32x32x16_bf16(SSD_CF(ks), sf, Y, 0, 0, 0); }
#pragma unroll
                for (int r = 0; r < 16; ++r) Y[r] *= arrEA[32 * lt + crow(r, hi)];
            }
            const float Al = arrA[32 * lt + r32];
            const int j0 = dir ? lt : 0, j1 = dir ? 3 : lt;
#pragma unroll 1
            for (int j = j0; j <= j1; ++j) {
                f32x16 X1 = f32x16{};
#pragma unroll
                for (int ks = 0; ks < 8; ++ks) { const bf16x8 bfr = *(const bf16x8*)(smem + SSD_B + off_b(32 * j + r32, 2 * ks + hi));
                    X1 = __builtin_amdgcn_mfma_f32_32x32x16_bf16(bfr, SSD_CF(ks), X1, 0, 0, 0); }
#pragma unroll
                for (int r = 0; r < 16; ++r) { const int sl = crow(r, hi); const float As = arrA[32 * j + sl];
                    const bool valid = (j != lt) || (dir ? (sl >= r32) : (sl <= r32));
                    X1[r] = valid ? X1[r] * expf(Al - As) : 0.f; }
#pragma unroll
                for (int k2 = 0; k2 < 2; ++k2) {
                    u32x4 aw; aw[0] = cvt_pk_bf16(X1[8 * k2 + 0], X1[8 * k2 + 1]); aw[1] = cvt_pk_bf16(X1[8 * k2 + 2], X1[8 * k2 + 3]);
                    aw[2] = cvt_pk_bf16(X1[8 * k2 + 4], X1[8 * k2 + 5]); aw[3] = cvt_pk_bf16(X1[8 * k2 + 6], X1[8 * k2 + 7]);
                    const unsigned rw0 = 32 * j + 16 * k2 + 4 * hi + tq, rw1 = rw0 + 8;
                    const s16x4 x0 = tr_read_a(lbase + SSD_XD + off_x(rw0, 4 * pt + 2 * tblk + (tp >> 1)) + 8 * (tp & 1));
                    const s16x4 x1 = tr_read_a(lbase + SSD_XD + off_x(rw1, 4 * pt + 2 * tblk + (tp >> 1)) + 8 * (tp & 1));
                    asm volatile("s_waitcnt lgkmcnt(0)" ::: "memory"); __builtin_amdgcn_sched_barrier(0);
                    const bf16x8 xf = (bf16x8){x0[0], x0[1], x0[2], x0[3], x1[0], x1[1], x1[2], x1[3]};
                    Y = __builtin_amdgcn_mfma_f32_32x32x16_bf16(*reinterpret_cast<bf16x8*>(&aw), xf, Y, 0, 0, 0);
                }
            }
            {   int opq = 0; asm volatile("" : "+v"(opq));
                float* yo = y + (t0 + 32 * lt + 4 * hi + opq) * SSDW + h * 64 + 32 * pt + r32;
#pragma unroll
                for (int r = 0; r < 16; ++r) yo[(size_t)((r & 3) + 8 * (r >> 2)) * SSDW] = Y[r]; }
            }
            { const float tot = arrTOT[0];
#pragma unroll
              for (int r = 0; r < 16; ++r) S[r] *= tot; }
#pragma unroll
            for (int ks = 0; ks < 8; ++ks) {
                const unsigned rw0 = 16 * ks + 8 * hi + tq, rw1 = rw0 + 4;
                const s16x4 a0 = tr_read_a(lbase + SSD_XE + off_x(rw0, 4 * spt + 2 * tblk + (tp >> 1)) + 8 * (tp & 1));
                const s16x4 a1 = tr_read_a(lbase + SSD_XE + off_x(rw1, 4 * spt + 2 * tblk + (tp >> 1)) + 8 * (tp & 1));
                const s16x4 b0 = tr_read_a(lbase + SSD_B + off_b(rw0, 4 * snt + 2 * tblk + (tp >> 1)) + 8 * (tp & 1));
                const s16x4 b1 = tr_read_a(lbase + SSD_B + off_b(rw1, 4 * snt + 2 * tblk + (tp >> 1)) + 8 * (tp & 1));
                asm volatile("s_waitcnt lgkmcnt(0)" ::: "memory"); __builtin_amdgcn_sched_barrier(0);
                const bf16x8 af = (bf16x8){a0[0], a0[1], a0[2], a0[3], a1[0], a1[1], a1[2], a1[3]};
                const bf16x8 bfr = (bf16x8){b0[0], b0[1], b0[2], b0[3], b1[0], b1[1], b1[2], b1[3]};
                S = __builtin_amdgcn_mfma_f32_32x32x16_bf16(af, bfr, S, 0, 0, 0);
            }
            __syncthreads();
#pragma unroll
            for (int r = 0; r < 16; ++r) { const unsigned pr = 32 * spt + crow(r, hi), n = 32 * snt + r32;
                *(bf16_t*)(smem + SSD_S + off_b(pr, n >> 3) + (n & 7) * 2) = f2bf(S[r]); }
        }
    }
    __syncthreads();
}

__device__ __forceinline__ void ph_ssd_gate(const Params& P) {
    const int lane = TIDX() & 63, w = TIDX() >> 6;
    for (int t = blockIdx.x * (NT / 64) + w; t < T_TOK; t += gridDim.x * (NT / 64)) {
        float v[16]; float ss = 0.f;
#pragma unroll
        for (int i = 0; i < 4; ++i) { const int c = (i * 64 + lane) * 4;
            const f32x4 a = *(const f32x4*)(P.yf + (size_t)t * SSDW + c), bb = *(const f32x4*)(P.yb + (size_t)t * SSDW + c);
            const u32x2 xs = *(const u32x2*)(P.xbc + (size_t)t * XBCW + c), zz = *(const u32x2*)(P.proj + (size_t)t * INW + OFF_Z + c);
            const float d = P.d_skip[c >> 6];
            const float xv[4] = {bflo(xs[0]), bfhi(xs[0]), bflo(xs[1]), bfhi(xs[1])}, zv[4] = {bflo(zz[0]), bfhi(zz[0]), bflo(zz[1]), bfhi(zz[1])};
#pragma unroll
            for (int j = 0; j < 4; ++j) { const float y = a[j] + bb[j] + xv[j] * d; v[i * 4 + j] = y * siluf(zv[j]); ss += v[i * 4 + j] * v[i * 4 + j]; } }
        ss = wave_sum(ss);
        const float r = rsqrtf(ss * (1.f / SSDW) + EPS);
#pragma unroll
        for (int i = 0; i < 4; ++i) { const int c = (i * 64 + lane) * 4; const f32x4 g = *(const f32x4*)(P.ssd_norm_g + c);
            u32x2 o; o[0] = cvt_pk_bf16(v[i * 4] * r * g[0], v[i * 4 + 1] * r * g[1]); o[1] = cvt_pk_bf16(v[i * 4 + 2] * r * g[2], v[i * 4 + 3] * r * g[3]);
            *(u32x2*)(P.mix + (size_t)t * DM + c) = o; }
    }
}

#define AT_SHM_V 16384
#define AT_SHM_K 8192
#define AT_KVBLK 64
#define AT_THR 8.f
#define AT_SCALE 0.125f
#define KSWZ64(row, colB) ((row) * 128 + ((colB) ^ (((row) & 7) << 4)))
#define SBAR() __builtin_amdgcn_sched_barrier(0)
__device__ __forceinline__ void partialSM(f32x16& p0, f32x16& p1, float& m_reg, float& mn, float& alpha) {
    constexpr float C = AT_SCALE * 1.4426950408889634f;
    float pmax = p0[0];
#pragma unroll
    for (int r = 1; r < 16; ++r) pmax = fmaxf(pmax, p0[r]);
#pragma unroll
    for (int r = 0; r < 16; ++r) pmax = fmaxf(pmax, p1[r]);
    { auto rr = __builtin_amdgcn_permlane32_swap(__float_as_uint(pmax), __float_as_uint(pmax), false, false);
      pmax = fmaxf(__uint_as_float(rr[0]), __uint_as_float(rr[1])); }
    if (__builtin_expect(__all(pmax - m_reg <= AT_THR / AT_SCALE), 1)) { mn = m_reg; alpha = 1.f; }
    else { mn = fmaxf(m_reg, pmax); alpha = __builtin_amdgcn_exp2f((m_reg - mn) * C); m_reg = mn; }
    const float mnC = -mn * C;
#pragma unroll
    for (int r = 0; r < 16; ++r) p0[r] = fmaf(p0[r], C, mnC);
#pragma unroll
    for (int r = 0; r < 16; ++r) p1[r] = fmaf(p1[r], C, mnC);
#pragma unroll
    for (int r = 0; r < 16; ++r) p0[r] = __builtin_amdgcn_exp2f(p0[r]);
}
__device__ __forceinline__ void finishSM(f32x16& p0, f32x16& p1, float alpha, float& l_reg, bf16x8& pa0, bf16x8& pa1, bf16x8& pa2, bf16x8& pa3) {
#pragma unroll
    for (int r = 0; r < 16; ++r) p1[r] = __builtin_amdgcn_exp2f(p1[r]);
    float ps = 0;
#pragma unroll
    for (int r = 0; r < 16; ++r) ps += p0[r];
#pragma unroll
    for (int r = 0; r < 16; ++r) ps += p1[r];
    { auto rr = __builtin_amdgcn_permlane32_swap(__float_as_uint(ps), __float_as_uint(ps), false, false);
      ps = __uint_as_float(rr[0]) + __uint_as_float(rr[1]); }
    l_reg = l_reg * alpha + ps;
#define PK4(P, BASE, OUT) do { unsigned a0 = cvt_pk_bf16(P[BASE + 0], P[BASE + 1]), a1 = cvt_pk_bf16(P[BASE + 2], P[BASE + 3]);   \
    unsigned b0 = cvt_pk_bf16(P[BASE + 4], P[BASE + 5]), b1 = cvt_pk_bf16(P[BASE + 6], P[BASE + 7]);                              \
    auto r0 = __builtin_amdgcn_permlane32_swap(a0, b0, false, false); auto r1 = __builtin_amdgcn_permlane32_swap(a1, b1, false, false); \
    u32x4 w = {r0[0], r1[0], r0[1], r1[1]}; OUT = *reinterpret_cast<bf16x8*>(&w); } while (0)
    PK4(p0, 0, pa0); PK4(p0, 8, pa1); PK4(p1, 0, pa2); PK4(p1, 8, pa3);
#undef PK4
}
__device__ __forceinline__ void qkt64(f32x16& p0, f32x16& p1, const char* Ks, const bf16x8* qr, int r32, int hi) {
    p0 = f32x16{}; p1 = f32x16{};
#pragma unroll
    for (int d0 = 0; d0 < 4; ++d0) { const int cb = (d0 * 16 + hi * 8) * 2;
        const bf16x8 b0 = *reinterpret_cast<const bf16x8*>(Ks + KSWZ64(r32, cb));
        const bf16x8 b1 = *reinterpret_cast<const bf16x8*>(Ks + KSWZ64(32 + r32, cb));
        p0 = __builtin_amdgcn_mfma_f32_32x32x16_bf16(b0, qr[d0], p0, 0, 0, 0);
        p1 = __builtin_amdgcn_mfma_f32_32x32x16_bf16(b1, qr[d0], p1, 0, 0, 0); }
}
__device__ __forceinline__ int v_st(int k, int c) { const int kk = (k & ~0xC) | ((k & 4) << 1) | ((k & 8) >> 1); return ((kk >> 3) * 4 + (c >> 5)) * 512 + ((kk & 7) * 32 + (c & 31)) * 2; }
__device__ __forceinline__ int v_rd_base(int lane) { return ((lane & 3) << 3) | (((lane >> 2) & 3) << 6) | (((lane >> 4) & 1) << 5) | (((lane >> 5) & 1) << 8); }
constexpr int v_rd_off(int d0, int ks, int half) { return d0 * 512 + ks * 4096 + half * 2048; }
template <int OFF> __device__ __forceinline__ s16x4 tr_read(int vb) {
    s16x4 r; asm volatile("ds_read_b64_tr_b16 %0, %1 offset:%2" : "=&v"(r) : "v"(vb), "i"(OFF) : "memory"); return r;
}
template <int D0> __device__ __forceinline__ void pv_one(f32x16& od, int vb, bf16x8 pa0, bf16x8 pa1, bf16x8 pa2, bf16x8 pa3) {
    const s16x4 l0 = tr_read<v_rd_off(D0, 0, 0)>(vb), h0 = tr_read<v_rd_off(D0, 0, 1)>(vb), l1 = tr_read<v_rd_off(D0, 1, 0)>(vb), h1 = tr_read<v_rd_off(D0, 1, 1)>(vb);
    const s16x4 l2 = tr_read<v_rd_off(D0, 2, 0)>(vb), h2 = tr_read<v_rd_off(D0, 2, 1)>(vb), l3 = tr_read<v_rd_off(D0, 3, 0)>(vb), h3 = tr_read<v_rd_off(D0, 3, 1)>(vb);
    asm volatile("s_waitcnt lgkmcnt(0)" ::: "memory"); SBAR();
#define PKV(L, H) (bf16x8){L[0], L[1], L[2], L[3], H[0], H[1], H[2], H[3]}
    od = __builtin_amdgcn_mfma_f32_32x32x16_bf16(pa0, PKV(l0, h0), od, 0, 0, 0);
    od = __builtin_amdgcn_mfma_f32_32x32x16_bf16(pa1, PKV(l1, h1), od, 0, 0, 0);
    od = __builtin_amdgcn_mfma_f32_32x32x16_bf16(pa2, PKV(l2, h2), od, 0, 0, 0);
    od = __builtin_amdgcn_mfma_f32_32x32x16_bf16(pa3, PKV(l3, h3), od, 0, 0, 0);
#undef PKV
}
__device__ __forceinline__ void pv_d0(f32x16* o, int vb, bf16x8 pa0, bf16x8 pa1, bf16x8 pa2, bf16x8 pa3) {
    pv_one<0>(o[0], vb, pa0, pa1, pa2, pa3); pv_one<1>(o[1], vb, pa0, pa1, pa2, pa3); pv_one<2>(o[2], vb, pa0, pa1, pa2, pa3); pv_one<3>(o[3], vb, pa0, pa1, pa2, pa3);
}
__device__ __forceinline__ void attn_pass(const bf16_t* __restrict__ Qb, const bf16_t* __restrict__ Kh, const bf16_t* __restrict__ Vh, char* lds, f32x16 (&o)[4]) {
    const int tid = TIDX(), wid = tid >> 6, lane = tid & 63, r32 = lane & 31, hi = lane >> 5;
    char* V_lds = lds; char* K_lds = lds + 2 * AT_SHM_V;
    float* ws = (float*)(lds + 2 * AT_SHM_V + 2 * AT_SHM_K) + wid * 64; float* li_l = ws; float* al_l = ws + 32;
    float m_reg = -1e30f, l_reg = 0;
#pragma unroll
    for (int d = 0; d < 4; ++d) o[d] = f32x16{};
    bf16x8 qr[4];
    const bf16_t* Qw = Qb + (size_t)(wid * 32 + r32) * INW + hi * 8;
#pragma unroll
    for (int d0 = 0; d0 < 4; ++d0) qr[d0] = *reinterpret_cast<const bf16x8*>(Qw + d0 * 16);
    const int sr = tid >> 4, sc = (tid & 15) * 8, vst0 = v_st(sr, sc), vst1 = v_st(32 + sr, sc);
    const int kr = tid >> 3, kc = (tid & 7) * 8, kst = KSWZ64(kr, kc * 2);
    const int vb0 = (int)(uintptr_t)V_lds + v_rd_base(lane);
    struct { bf16x8 vs0, vs1, ks0; } sr_[2];
    const unsigned voff0 = (unsigned)(sr * INW + sc), voff1 = (unsigned)((32 + sr) * INW + sc), koff = (unsigned)(kr * INW + kc);
#define SLOAD(i, k0) do { const bf16_t* Vt = Vh + (size_t)(k0) * INW; const bf16_t* Kt = Kh + (size_t)(k0) * INW; \
    sr_[i].vs0 = *reinterpret_cast<const bf16x8*>(Vt + voff0); sr_[i].vs1 = *reinterpret_cast<const bf16x8*>(Vt + voff1); sr_[i].ks0 = *reinterpret_cast<const bf16x8*>(Kt + koff); } while (0)
#define SWRITE(b, i) do { *(bf16x8*)(V_lds + (b) * AT_SHM_V + vst0) = sr_[i].vs0; *(bf16x8*)(V_lds + (b) * AT_SHM_V + vst1) = sr_[i].vs1; \
    *(bf16x8*)(K_lds + (b) * AT_SHM_K + kst) = sr_[i].ks0; } while (0)
#define SWAIT() asm volatile("s_waitcnt vmcnt(3)" ::: "memory")
#define RESC(a) do { if (__any((a) < 1.f)) { if (hi == 0) al_l[r32] = (a); asm volatile("s_waitcnt lgkmcnt(0)" ::: "memory"); \
    _Pragma("unroll") for (int d = 0; d < 4; ++d) _Pragma("unroll") for (int r = 0; r < 16; ++r) o[d][r] *= al_l[crow(r, hi)]; } } while (0)
    f32x16 pA0, pA1, pB0, pB1; float mnA, mnB, alA, alB; bf16x8 pa0, pa1, pa2, pa3; const int NTL = SEQ / AT_KVBLK;
    constexpr int SE = 0, SO = 1;
    SLOAD(SE, 0); asm volatile("s_waitcnt vmcnt(0)" ::: "memory"); SWRITE(0, SE); __syncthreads();
    qkt64(pA0, pA1, K_lds, qr, r32, hi); partialSM(pA0, pA1, m_reg, mnA, alA);
    SLOAD(SO, AT_KVBLK); SLOAD(SE, 2 * AT_KVBLK);
    SWAIT(); SWRITE(1, SO); __syncthreads();
#pragma unroll 1
    for (int j = 1; j + 1 < NTL; j += 2) {
        SBAR(); qkt64(pB0, pB1, K_lds + AT_SHM_K, qr, r32, hi);
        finishSM(pA0, pA1, alA, l_reg, pa0, pa1, pa2, pa3); SBAR();
        SLOAD(SO, (j + 2) * AT_KVBLK); SBAR();
        pv_d0(o, vb0, pa0, pa1, pa2, pa3); partialSM(pB0, pB1, m_reg, mnB, alB);
        __syncthreads(); SWAIT(); SWRITE(0, SE);
        RESC(alB); __syncthreads();
        SBAR(); qkt64(pA0, pA1, K_lds, qr, r32, hi);
        finishSM(pB0, pB1, alB, l_reg, pa0, pa1, pa2, pa3); SBAR();
        if (j + 3 < NTL) SLOAD(SE, (j + 3) * AT_KVBLK); SBAR();
        pv_d0(o, vb0 + AT_SHM_V, pa0, pa1, pa2, pa3); partialSM(pA0, pA1, m_reg, mnA, alA);
        __syncthreads(); SWAIT(); SWRITE(1, SO);
        RESC(alA); __syncthreads();
    }
    SBAR(); qkt64(pB0, pB1, K_lds + AT_SHM_K, qr, r32, hi);
    finishSM(pA0, pA1, alA, l_reg, pa0, pa1, pa2, pa3); SBAR();
    pv_d0(o, vb0, pa0, pa1, pa2, pa3); partialSM(pB0, pB1, m_reg, mnB, alB);
    __syncthreads(); RESC(alB);
    finishSM(pB0, pB1, alB, l_reg, pa0, pa1, pa2, pa3); SBAR();
    pv_d0(o, vb0 + AT_SHM_V, pa0, pa1, pa2, pa3);
    if (hi == 0) li_l[r32] = l_reg; asm volatile("s_waitcnt lgkmcnt(0)" ::: "memory");
#pragma unroll
    for (int r = 0; r < 16; ++r) { const float rl = __builtin_amdgcn_rcpf(li_l[crow(r, hi)]);
#pragma unroll
        for (int d0 = 0; d0 < 4; ++d0) o[d0][r] *= rl; }
#undef SLOAD
#undef SWRITE
#undef SWAIT
#undef RESC
}
__device__ __forceinline__ void ph_attn(const Params& P, char* lds) {
    const int tid = TIDX(), wid = tid >> 6, lane = tid & 63, r32 = lane & 31, hi = lane >> 5;
    float lam;
    { float d1 = P.lam_q1[lane] * P.lam_k1[lane], d2 = P.lam_q2[lane] * P.lam_k2[lane]; d1 = wave_sum(d1); d2 = wave_sum(d2); lam = expf(d1) - expf(d2) + 0.2f; }
#pragma unroll 1
    for (int u = blockIdx.x; u < NB * 8 * (SEQ / 256); u += gridDim.x) {
        const int slot = u >> 3, bh = (u & 7) * 4 + (slot >> 3), qblk = slot & 7, b = bh >> 3, h = bh & 7;
        const bf16_t* base = P.proj + (size_t)(b * SEQ) * INW;
        const bf16_t* Qb = base + (size_t)(qblk * 256) * INW + OFF_Q + h * 128;
        const bf16_t* Kh = base + OFF_K + h * 128;
        const bf16_t* Vh = base + OFF_V + h * 128;
        f32x16 o[4];
        attn_pass(Qb, Kh, Vh, lds, o);
        unsigned* park = (unsigned*)(lds + 2 * AT_SHM_V + 2 * AT_SHM_K + 2048) + wid * 2048 + lane;
#pragma unroll
        for (int d0 = 0; d0 < 4; ++d0)
#pragma unroll
            for (int i = 0; i < 8; ++i) park[(d0 * 8 + i) * 64] = cvt_pk_bf16(o[d0][2 * i], o[d0][2 * i + 1]);
        attn_pass(Qb + 64, Kh + 64, Vh, lds, o);
        unsigned o1p[4][8];
#pragma unroll
        for (int d0 = 0; d0 < 4; ++d0)
#pragma unroll
            for (int i = 0; i < 8; ++i) o1p[d0][i] = park[(d0 * 8 + i) * 64];
        float ss[16];
#pragma unroll
        for (int r = 0; r < 16; ++r) { float s = 0.f;
#pragma unroll
            for (int d0 = 0; d0 < 4; ++d0) { const float o1 = (r & 1) ? bfhi(o1p[d0][r >> 1]) : bflo(o1p[d0][r >> 1]); const float v = o1 - lam * o[d0][r]; o[d0][r] = v; s += v * v; }
            ss[r] = s; }
        const int ln_ = olane();
#pragma unroll
        for (int r = 0; r < 16; ++r) { float s = ss[r]; s += shx(s, ln_, 1); s += shx(s, ln_, 2); s += shx(s, ln_, 4); s += shx(s, ln_, 8); s += shx(s, ln_, 16);
            ss[r] = rsqrtf(s * (1.f / 128.f) + EPS) * 0.8f; }
        int opq = 0; asm volatile("" : "+v"(opq));
        bf16_t* mo = P.mix + (size_t)(b * SEQ + qblk * 256 + wid * 32 + 4 * hi + opq) * DM + 1024 + h * 128 + r32;
#pragma unroll
        for (int d0 = 0; d0 < 4; ++d0) { const float g = P.subln_g[d0 * 32 + r32 + opq];
#pragma unroll
            for (int r = 0; r < 16; ++r) mo[(size_t)((r & 3) + 8 * (r >> 2)) * DM + d0 * 32] = f2bf(o[d0][r] * ss[r] * g); }
        __syncthreads();
    }
}

struct EpiOutProjF {
    static constexpr bool PERM = false, AFTER_DRAIN = false;
    const float* x; float* h1;
    __device__ __forceinline__ void operator()(const f32x4 (&acc)[2][2][4][2], const pg8::Unit& u, int wr, int wc, int fr, int fq) const {
        const int row0 = u.pm * 256 + wr * 64 + fr, col0 = u.pn * 256 + wc * 32 + 4 * fq;
#pragma unroll
        for (int ai = 0; ai < 2; ++ai)
#pragma unroll
            for (int m = 0; m < 4; ++m) { const size_t ro = (size_t)(row0 + ai * 128 + m * 16) * DM + col0;
#pragma unroll
                for (int bj = 0; bj < 2; ++bj)
#pragma unroll
                    for (int n = 0; n < 2; ++n) { const size_t o = ro + bj * 128 + n * 16; *(f32x4*)(h1 + o) = *(const f32x4*)(x + o) + acc[ai][bj][m][n]; } }
    }
};
__device__ __forceinline__ void ph_outproj(const Params& P, char* smem) {
    pg8::Gemm g{P.mix, P.w_out_t, T_TOK, DM, DM};
    pg8::StaticOrder S; S.init(T_TOK, DM, gridDim.x, blockIdx.x);
    EpiOutProjF E{P.x, P.h1};
    pg8::gemm_phase<EpiOutProjF, pg8::StaticOrder>((PG8_LAS unsigned char*)smem, g, S, E, nullptr);
    __syncthreads();
}

__device__ __forceinline__ void ph_wcat(const Params& P) {
    for (int i = blockIdx.x * NT + TIDX(); i < DM * 96; i += gridDim.x * NT) { const int k = i / 96, j = i - k * 96;
        const float w = (j < 64) ? P.w_re[(size_t)k * 64 + j] : ((j < 72) ? P.w_rg[(size_t)k * 8 + (j - 64)] : 0.f);
        P.wcat[i] = w * P.norm_ffn_g[k]; }
}
__device__ __forceinline__ void ph_router(const Params& P, char* smem) {
    const int tid = TIDX(), wid = __builtin_amdgcn_readfirstlane(tid >> 6), lane = tid & 63, r32 = lane & 31, hi = lane >> 5;
    float* part = (float*)smem;
    float* ssp = (float*)(smem + 98304);
    float* logit = (float*)(smem + 98304 + 2048);
    float* rinv_s = (float*)(smem + 98304 + 2048 + 32 * 97 * 4);
#pragma unroll 1
    for (int u = blockIdx.x; u < T_TOK / 32; u += gridDim.x) {
        const int t0 = u * 32;
        f32x16 acc0 = f32x16{}, acc1 = f32x16{}, acc2 = f32x16{};
        float ss = 0.f;
        const float* ap = P.h1 + (size_t)(t0 + r32) * DM + wid * 256;
        const float* wp = P.wcat + (size_t)(wid * 256 + hi) * 96 + r32;
#pragma unroll 4
        for (int s = 0; s < 64; ++s) {
            const f32x4 a4 = *(const f32x4*)(ap + 4 * s);
            ss += a4[0] * a4[0] + a4[1] * a4[1] + a4[2] * a4[2] + a4[3] * a4[3];
            const float* w0 = wp + (size_t)(4 * s) * 96; const float* w1 = w0 + 2 * 96;
            const float aA = hi ? a4[1] : a4[0], aB = hi ? a4[3] : a4[2];
            acc0 = __builtin_amdgcn_mfma_f32_32x32x2f32(aA, w0[0], acc0, 0, 0, 0);
            acc1 = __builtin_amdgcn_mfma_f32_32x32x2f32(aA, w0[32], acc1, 0, 0, 0);
            acc2 = __builtin_amdgcn_mfma_f32_32x32x2f32(aA, w0[64], acc2, 0, 0, 0);
            acc0 = __builtin_amdgcn_mfma_f32_32x32x2f32(aB, w1[0], acc0, 0, 0, 0);
            acc1 = __builtin_amdgcn_mfma_f32_32x32x2f32(aB, w1[32], acc1, 0, 0, 0);
            acc2 = __builtin_amdgcn_mfma_f32_32x32x2f32(aB, w1[64], acc2, 0, 0, 0);
        }
        __syncthreads();
#pragma unroll
        for (int r = 0; r < 16; ++r) { part[((wid * 3 + 0) * 16 + r) * 64 + lane] = acc0[r]; part[((wid * 3 + 1) * 16 + r) * 64 + lane] = acc1[r]; part[((wid * 3 + 2) * 16 + r) * 64 + lane] = acc2[r]; }
        ssp[wid * 64 + lane] = ss;
        __syncthreads();
        for (int o = tid; o < 3 * 16 * 64; o += NT) {
            float s = 0.f;
#pragma unroll
            for (int w = 0; w < 8; ++w) s += part[w * 3072 + o];
            const int l = o & 63, r = (o >> 6) & 15, nt = o >> 10;
            logit[crow(r, l >> 5) * 97 + 32 * nt + (l & 31)] = s;
        }
        if (tid < 32) { float s = 0.f;
#pragma unroll
            for (int w = 0; w < 8; ++w) s += ssp[w * 64 + tid] + ssp[w * 64 + 32 + tid];
            rinv_s[tid] = rsqrtf(s * (0.5f / DM) + EPS); }
        __syncthreads();
        if (tid < 32) {
            const int t = t0 + tid; const float rv = rinv_s[tid]; const float* lg = logit + tid * 97;
            float gl[8]; int gs = 0; float gm = -INFINITY;
#pragma unroll
            for (int i = 0; i < 8; ++i) { const float a = lg[64 + i] * rv + P.b_rg[i]; gl[i] = a; if (a > gm) { gm = a; gs = i; } }
            float den = 0.f;
#pragma unroll
            for (int i = 0; i < 8; ++i) den += expf(gl[i] - gm);
            const float p_g = 1.f / den;
            int i0 = 0, i1 = 0; float e0 = -INFINITY, e1 = -INFINITY;
#pragma unroll
            for (int i = 0; i < 8; ++i) { const float a = lg[gs * 8 + i] * rv + P.b_re[gs * 8 + i];
                if (a > e0) { e1 = e0; i1 = i0; e0 = a; i0 = i; } else if (a > e1) { e1 = a; i1 = i; } }
            const float x1 = expf(e1 - e0), w0 = 1.f / (1.f + x1), w1 = x1 / (1.f + x1);
            const int ex0 = gs * 8 + i0, ex1 = gs * 8 + i1;
            P.tok_e[t * 2] = ex0; P.tok_e[t * 2 + 1] = ex1; P.tok_w[t * 2] = p_g * w0; P.tok_w[t * 2 + 1] = p_g * w1;
            atomicAdd(&P.counts[ex0], 1); atomicAdd(&P.counts[ex1], 1);
        }
#pragma unroll 1
        for (int q = 0; q < 4; ++q) { const int ti = wid * 4 + q; const float rv = rinv_s[ti]; const float* hr = P.h1 + (size_t)(t0 + ti) * DM;
#pragma unroll
            for (int i = 0; i < 8; ++i) { const int c = (i * 64 + lane) * 4; const f32x4 v = *(const f32x4*)(hr + c), g = *(const f32x4*)(P.norm_ffn_g + c);
                u32x2 o; o[0] = cvt_pk_bf16(v[0] * rv * g[0], v[1] * rv * g[1]); o[1] = cvt_pk_bf16(v[2] * rv * g[2], v[3] * rv * g[3]);
                *(u32x2*)(P.hn + (size_t)(t0 + ti) * DM + c) = o; } }
        __syncthreads();
    }
}
__device__ __forceinline__ void moe_starts(const Params& P, int* sst) {
    __syncthreads();
    if (TIDX() < 64) { const int lane = TIDX(); const int c = __hip_atomic_load(&P.counts[lane], __ATOMIC_RELAXED, __HIP_MEMORY_SCOPE_AGENT);
        const int p = ((c + 127) >> 7) << 7; int incl = p;
#pragma unroll
        for (int o = 1; o < 64; o <<= 1) { const int v = __shfl_up(incl, o); if (lane >= o) incl += v; }
        sst[lane] = incl - p; if (lane == 63) sst[NEXP] = incl; }
    __syncthreads();
}
__device__ __forceinline__ void ph_moe_scatter(const Params& P, char* smem) {
    int* sst = (int*)smem; int* lcount = (int*)(smem + 512); int* lbase = (int*)(smem + 1024); moe_starts(P, sst);
    const int tid = TIDX();
    for (int a0 = blockIdx.x * 128; a0 < T_TOK * 2; a0 += gridDim.x * 128) {
        const int a = a0 + tid; const bool valid = (tid < 128) && (a < T_TOK * 2);
        __syncthreads();
        if (tid < NEXP) lcount[tid] = 0;
        __syncthreads();
        const int e = valid ? P.tok_e[a] : 0;
        const int rank = valid ? atomicAdd(&lcount[e], 1) : 0;
        __syncthreads();
        if (tid < NEXP) { const int c = lcount[tid]; lbase[tid] = c ? atomicAdd(&P.cursor[tid], c) : 0; }
        __syncthreads();
        if (valid) { const int pos = sst[e] + lbase[e] + rank; P.row_tok[pos] = a >> 1; P.row_slot[pos] = a; P.row_w[pos] = P.tok_w[a]; }
    }
}
#define MG_B 49152
template <int NRB> struct MoeALoad {
    const bf16_t* base; unsigned off[NRB][2]; u32x4 r[NRB]; unsigned aw;
    __device__ __forceinline__ void init(char* smem, const bf16_t* b, size_t ld_, int row0, const int* gather, int zrow) { base = b; (void)smem;
        const int tid = TIDX(); { const int row = tid >> 3, kc = tid & 7, kh = kc >> 2, kq = kc & 3; aw = (unsigned)(((kh * 128 + row) * 32 + kq * 8) * 2); }
#pragma unroll
        for (int rb = 0; rb < NRB; ++rb)
#pragma unroll
            for (int i = 0; i < 2; ++i) { const int c = tid + i * NT, row = row0 + rb * 128 + (c >> 3); const int t = gather ? gather[row] : row;
                off[rb][i] = (unsigned)((t >= 0) ? t : zrow) * (unsigned)(ld_ * 2) + (unsigned)((c & 7) * 16); } }
    __device__ __forceinline__ void fetch1(int rb, int i, int kt) { r[rb] = *(const u32x4*)((const char*)base + (size_t)kt * 128 + off[rb][i]); }
    __device__ __forceinline__ void commit1(int rb, int i, char* lds) { *(u32x4*)(lds + rb * 16384 + i * 4096 + aw) = r[rb]; }
    __device__ __forceinline__ void fetch_half(int i, int kt) {
#pragma unroll
        for (int rb = 0; rb < NRB; ++rb) fetch1(rb, i, kt);
    }
    __device__ __forceinline__ void commit_half(int i, char* lds) {
#pragma unroll
        for (int rb = 0; rb < NRB; ++rb) commit1(rb, i, lds);
    }
};
template <bool GU> struct MoeBLoadT {
    const float* ub[2]; unsigned ldb, voff, bw[2];
    __device__ __forceinline__ void init(const float* b0_, const float* b1_, unsigned ld_) { const unsigned tid = (unsigned)TIDX(); ub[0] = b0_; ub[1] = b1_; ldb = ld_ * 4;
        if (GU) { const unsigned k0 = tid >> 4, ffl4 = (tid & 15) * 4; voff = k0 * ldb + ffl4 * 4;
#pragma unroll
            for (int mat = 0; mat < 2; ++mat) { const unsigned n4 = (ffl4 >> 4) * 32 + mat * 16 + (ffl4 & 15); bw[mat] = off_b(k0, n4 >> 3) + (n4 & 4) * 2; } }
        else { const unsigned k0 = tid >> 5, n4 = (tid & 31) * 4; voff = k0 * ldb + n4 * 4; bw[0] = bw[1] = off_b(k0, n4 >> 3) + (n4 & 4) * 2; } }
    __device__ __forceinline__ void fetch1(f32x4 (&r)[4], int i, int kt) const {
        const char* b = (const char*)(GU ? ub[i >> 1] : ub[0]) + (size_t)((unsigned)kt * 64u + (GU ? (unsigned)(i & 1) * 32u : (unsigned)i * 16u)) * ldb;
        r[i] = __builtin_nontemporal_load((const f32x4*)(b + voff)); }
    __device__ __forceinline__ void commit1(const f32x4 (&r)[4], int i, char* bimg) const { u32x2 v; v[0] = cvt_pk_bf16(r[i][0], r[i][1]); v[1] = cvt_pk_bf16(r[i][2], r[i][3]);
        *(u32x2*)(bimg + (GU ? (i & 1) * 8192 : i * 4096) + (GU ? bw[i >> 1] : bw[0])) = v; }
    __device__ __forceinline__ void fetch(f32x4 (&r)[4], int kt) const {
#pragma unroll
        for (int i = 0; i < 4; ++i) fetch1(r, i, kt);
    }
    __device__ __forceinline__ void commit(const f32x4 (&r)[4], char* bimg) const {
#pragma unroll
        for (int i = 0; i < 4; ++i) commit1(r, i, bimg);
    }
};
typedef LAS s16x4 lds_s16x4_t;
__device__ __forceinline__ s16x4 trb(unsigned addr) { return __builtin_amdgcn_ds_read_tr16_b64_v4i16((lds_s16x4_t*)addr); }
template <int NK, int NRB, class BL, class EP>
__device__ __forceinline__ void moe_gemm_unit(char* smem, MoeALoad<NRB>& al, const BL& bl, const EP& ep) {
    const int tid = TIDX(), wid = __builtin_amdgcn_readfirstlane(tid >> 6), lane = tid & 63, wr = wid >> 2, wc = wid & 3, fr = lane & 15, fq = lane >> 4;
    const unsigned lbase = (unsigned)(uintptr_t)smem + MG_B;
    const unsigned tq = (lane & 15) >> 2, tp = lane & 3;
    f32x4 acc[3][4][2];
#pragma unroll
    for (int rb = 0; rb < 3; ++rb)
#pragma unroll
        for (int m = 0; m < 4; ++m)
#pragma unroll
            for (int n = 0; n < 2; ++n) acc[rb][m][n] = (f32x4){0.f, 0.f, 0.f, 0.f};
    f32x4 b0[4], b1[4];
    bl.fetch(b0, 0); bl.fetch(b1, 1); al.fetch_half(0, 0);
    const unsigned tb00 = lbase + off_b(8 * fq + tq, 2 * (2 * wc) + (tp >> 1)) + 8 * (tp & 1), tb01 = lbase + off_b(8 * fq + 4 + tq, 2 * (2 * wc) + (tp >> 1)) + 8 * (tp & 1);
    const unsigned tb10 = lbase + off_b(8 * fq + tq, 2 * (2 * wc + 1) + (tp >> 1)) + 8 * (tp & 1), tb11 = lbase + off_b(8 * fq + 4 + tq, 2 * (2 * wc + 1) + (tp >> 1)) + 8 * (tp & 1);
    const char* ard = smem + ((wr * 64 + fr) * 32 + fq * 8) * 2;
    __syncthreads();
    al.commit_half(0, smem); al.fetch_half(1, 0); bl.commit(b0, smem + MG_B); bl.fetch1(b0, 0, 2 < NK ? 2 : NK - 1); bl.fetch1(b0, 1, 2 < NK ? 2 : NK - 1); al.commit_half(1, smem);
    __builtin_amdgcn_sched_barrier(0);
    al.fetch_half(0, 1 < NK ? 1 : NK - 1); __builtin_amdgcn_sched_barrier(0); bl.fetch1(b0, 2, 2 < NK ? 2 : NK - 1); bl.fetch1(b0, 3, 2 < NK ? 2 : NK - 1); __builtin_amdgcn_sched_barrier(0);
    __syncthreads();
#define MG_BF(BUF, KH) do { const s16x4 t00 = trb(tb00 + (BUF) * 65536 + (KH) * 8192), t01 = trb(tb01 + (BUF) * 65536 + (KH) * 8192), t10 = trb(tb10 + (BUF) * 65536 + (KH) * 8192), t11 = trb(tb11 + (BUF) * 65536 + (KH) * 8192); \
        bfr[KH][0] = (bf16x8){t00[0], t00[1], t00[2], t00[3], t01[0], t01[1], t01[2], t01[3]}; bfr[KH][1] = (bf16x8){t10[0], t10[1], t10[2], t10[3], t11[0], t11[1], t11[2], t11[3]}; } while (0)
#define MG_AR(BUF, SET, KH, RB, MH) do { _Pragma("unroll") for (int m_ = 0; m_ < 2; ++m_) a[SET][m_] = *(const bf16x8*)(ard + (BUF) * 65536 + (RB) * 16384 + (KH) * 8192 + ((MH) * 2 + m_) * 1024); } while (0)
#define MG_STEP(BUF, BS, KT1, KT2, KTB) do { constexpr int NH = 4 * NRB, NP = 2 * NRB + 4, NS = 2 * NH, HP = NRB + 2; char* stg = smem + (1 - (BUF)) * 65536; const int kt1_ = (KT1), kt2_ = (KT2), ktb_ = (KTB); \
        bf16x8 a[2][2], bfr[2][2]; MG_BF(BUF, 0); MG_AR(BUF, 0, 0, 0, 0); \
        _Pragma("unroll") for (int h = 0; h < NH; ++h) { const int kh = h / (2 * NRB), rb = (h >> 1) % NRB, mh = h & 1, cur = h & 1; \
            if (h + 1 < NH) { const int kh1 = (h + 1) / (2 * NRB), rb1 = ((h + 1) >> 1) % NRB, mh1 = (h + 1) & 1; if (h + 1 == 2 * NRB) MG_BF(BUF, 1); MG_AR(BUF, cur ^ 1, kh1, rb1, mh1); } \
            __builtin_amdgcn_sched_barrier(0); \
            _Pragma("unroll") for (int mi = 0; mi < 2; ++mi) { const int m = mh * 2 + mi, s = h * 2 + mi; \
                acc[rb][m][0] = __builtin_amdgcn_mfma_f32_16x16x32_bf16(a[cur][mi], bfr[kh][0], acc[rb][m][0], 0, 0, 0); \
                acc[rb][m][1] = __builtin_amdgcn_mfma_f32_16x16x32_bf16(a[cur][mi], bfr[kh][1], acc[rb][m][1], 0, 0, 0); \
                __builtin_amdgcn_sched_barrier(0); \
                _Pragma("unroll") for (int q = 0; q < NP; ++q) if (q * NS / NP == s) { const int hf = q / HP, qq = q % HP; \
                    if (qq < NRB) { al.commit1(qq, hf, stg); al.fetch1(qq, hf ^ 1, hf ? kt2_ : kt1_); } \
                    else { bl.commit1(BS, hf * 2 + qq - NRB, stg + MG_B); bl.fetch1(BS, hf * 2 + qq - NRB, ktb_); } \
                    __builtin_amdgcn_sched_barrier(0); } } } } while (0)
#pragma unroll 1
    for (int kt = 0; kt < NK; kt += 2) {
        MG_STEP(0, b1, kt + 1 < NK ? kt + 1 : NK - 1, kt + 2 < NK ? kt + 2 : NK - 1, kt + 3 < NK ? kt + 3 : NK - 1);
        __syncthreads();
        MG_STEP(1, b0, kt + 2 < NK ? kt + 2 : NK - 1, kt + 3 < NK ? kt + 3 : NK - 1, kt + 4 < NK ? kt + 4 : NK - 1);
        __syncthreads();
    }
#undef MG_STEP
#undef MG_AR
#undef MG_BF
    ep(acc, NRB, wr, wc, fr, fq);
    __syncthreads();
}
template <int NK, class BL, class EP>
__device__ __forceinline__ void moe_gemm_dispatch(char* smem, int nrb, const bf16_t* abase, size_t ald, int row0, const int* gather, int zrow, const BL& bl, const EP& ep) {
    if (nrb == 3)      { MoeALoad<3> al; al.init(smem, abase, ald, row0, gather, zrow); moe_gemm_unit<NK, 3>(smem, al, bl, ep); }
    else if (nrb == 2) { MoeALoad<2> al; al.init(smem, abase, ald, row0, gather, zrow); moe_gemm_unit<NK, 2>(smem, al, bl, ep); }
    else               { MoeALoad<1> al; al.init(smem, abase, ald, row0, gather, zrow); moe_gemm_unit<NK, 1>(smem, al, bl, ep); }
}
struct EpiMoeGU { bf16_t* act; int row0, ff0;
    __device__ __forceinline__ void operator()(const f32x4 (&acc)[3][4][2], int nrb, int wr, int wc, int fr, int fq) const {
#pragma unroll
        for (int rb = 0; rb < 3; ++rb) if (rb < nrb) {
#pragma unroll
            for (int m = 0; m < 4; ++m)
#pragma unroll
                for (int j = 0; j < 4; ++j) { const int row = row0 + rb * 128 + wr * 64 + m * 16 + fq * 4 + j, ff = ff0 + wc * 16 + fr;
                    const float g = acc[rb][m][0][j], u = acc[rb][m][1][j]; act[(size_t)row * EFF + ff] = f2bf(g / (1.f + __expf(-g)) * u); } }
    }
};
__device__ __forceinline__ void ph_moe_gu(const Params& P, char* smem) {
    int* sst = (int*)(smem + 131072); moe_starts(P, sst);
    const int i = blockIdx.x, x = i & 7, slot = i >> 3;
#pragma unroll 1
    for (int rnd = 0; rnd * (int)gridDim.x < NEXP * 8; ++rnd) {
        int e, nt;
        if (gridDim.x == 256) { e = rnd * 32 + x * 4 + (slot >> 3); nt = slot & 7; } else { const int u = rnd * gridDim.x + i; e = u >> 3; nt = u & 7; }
        if (e >= NEXP) break;
        const int r_lo = sst[e], nrb_tot = (sst[e + 1] - r_lo) >> 7;
        MoeBLoadT<true> bl; bl.init(P.w_eg + (size_t)e * DM * EFF + nt * 64, P.w_eu + (size_t)e * DM * EFF + nt * 64, EFF);
#pragma unroll 1
        for (int rbp = 0; rbp < nrb_tot; rbp += 3) { const int nrb = (nrb_tot - rbp) < 3 ? (nrb_tot - rbp) : 3;
            EpiMoeGU ep{P.act, r_lo + rbp * 128, nt * 64};
            moe_gemm_dispatch<DM / 64>(smem, nrb, P.hn, DM, r_lo + rbp * 128, P.row_tok, T_TOK, bl, ep); }
    }
}
struct EpiMoeDown { bf16_t* ymoe; const int* s_slot; const float* s_w; int col0; char* lds;
    __device__ __forceinline__ void operator()(const f32x4 (&acc)[3][4][2], int nrb, int wr, int wc, int fr, int fq) const {
        const int lane = fq * 16 + fr, wid = wr * 4 + wc; char* patch = lds + wid * 5120;
#pragma unroll
        for (int rb = 0; rb < 3; ++rb) if (rb < nrb) {
#pragma unroll
            for (int m = 0; m < 4; ++m)
#pragma unroll
                for (int j = 0; j < 4; ++j) { const int r = m * 16 + fq * 4 + j; const float w = s_w[rb * 128 + wr * 64 + r];
#pragma unroll
                    for (int n = 0; n < 2; ++n) *(bf16_t*)(patch + r * 80 + (n * 16 + fr) * 2) = f2bf(acc[rb][m][n][j] * w); }
#pragma unroll
            for (int it = 0; it < 4; ++it) { const int r = it * 16 + (lane >> 2), c = lane & 3; const int sl = s_slot[rb * 128 + wr * 64 + r];
                const u32x4 v = *(const u32x4*)(patch + r * 80 + c * 16);
                if (sl >= 0) *(u32x4*)(ymoe + (size_t)sl * DM + col0 + wc * 32 + c * 8) = v; }
        }
    }
};
__device__ __forceinline__ void ph_moe_down(const Params& P, char* smem) {
    int* sst = (int*)(smem + 131072); moe_starts(P, sst);
    const int i = blockIdx.x, x = i & 7, slot = i >> 3;
#pragma unroll 1
    for (int rnd = 0; rnd * (int)gridDim.x < NEXP * 16; ++rnd) {
        int e, ct;
        if (gridDim.x == 256) { e = rnd * 16 + x * 2 + (slot >> 4); ct = slot & 15; } else { const int u = rnd * gridDim.x + i; e = u >> 4; ct = u & 15; }
        if (e >= NEXP) break;
        const int r_lo = sst[e], nrb_tot = (sst[e + 1] - r_lo) >> 7;
        MoeBLoadT<false> bl; { const float* b = P.w_ed + (size_t)e * EFF * DM + ct * 128; bl.init(b, b, DM); }
#pragma unroll 1
        for (int rbp = 0; rbp < nrb_tot; rbp += 3) { const int nrb = (nrb_tot - rbp) < 3 ? (nrb_tot - rbp) : 3;
            int* s_slot = (int*)(smem + 145408); float* s_w = (float*)(smem + 145408 + 1536);
            __syncthreads();
            if (TIDX() < 384) { const int rl = TIDX(); int row = r_lo + rbp * 128 + rl; row = row < MAXROWS ? row : MAXROWS - 1;
                const bool ok = (rl < nrb * 128) && (P.row_tok[row] >= 0); s_slot[rl] = ok ? P.row_slot[row] : -1; s_w[rl] = ok ? P.row_w[row] : 0.f; }
            EpiMoeDown ep{P.ymoe, s_slot, s_w, ct * 128, smem};
            moe_gemm_dispatch<EFF / 64>(smem, nrb, P.act, EFF, r_lo + rbp * 128, nullptr, MAXROWS, bl, ep); }
    }
}
__device__ __forceinline__ void ph_combine(const Params& P) {
    const int lane = TIDX() & 63, w = TIDX() >> 6;
    for (int t = blockIdx.x * (NT / 64) + w; t < T_TOK; t += gridDim.x * (NT / 64)) {
        const float* hr = P.h1 + (size_t)t * DM;
#pragma unroll
        for (int i = 0; i < 8; ++i) { const int c = (i * 64 + lane) * 4;
            f32x4 v = *(const f32x4*)(hr + c);
            const u32x2 a = *(const u32x2*)(P.ymoe + (size_t)(2 * t) * DM + c), b = *(const u32x2*)(P.ymoe + (size_t)(2 * t + 1) * DM + c);
            v[0] += bflo(a[0]) + bflo(b[0]); v[1] += bfhi(a[0]) + bfhi(b[0]); v[2] += bflo(a[1]) + bflo(b[1]); v[3] += bfhi(a[1]) + bfhi(b[1]);
            u32x2 o; o[0] = cvt_pk_bf16(v[0], v[1]); o[1] = cvt_pk_bf16(v[2], v[3]);
            *(u32x2*)(P.h2b + (size_t)t * DM + c) = o; }
    }
}
struct EpiPP { bf16_t* pp; float* prss; int row0, col0;
    __device__ __forceinline__ void operator()(const f32x4 (&acc)[4][2], int wr, int wc, int fr, int fq) const {
        const int ln_ = olane();
#pragma unroll
        for (int m = 0; m < 4; ++m)
#pragma unroll
            for (int j = 0; j < 4; ++j) { const int row = row0 + wr * 64 + m * 16 + fq * 4 + j; float s = 0.f;
#pragma unroll
                for (int n = 0; n < 2; ++n) { const float v = acc[m][n][j]; s += v * v; pp[(size_t)row * DM + col0 + wc * 32 + n * 16 + fr] = f2bf(v); }
                s += shx(s, ln_, 1); s += shx(s, ln_, 2); s += shx(s, ln_, 4); s += shx(s, ln_, 8);
                if (fr == 0) atomicAdd(prss + row, s); }
    }
};
__device__ __forceinline__ void ph_pleproj(const Params& P, char* smem) {
    const int ntn = DM / 128, ntm = T_TOK / 128;
    for (int u = blockIdx.x; u < ntn * ntm; u += gridDim.x) {
        const int tn = u % ntn, tm = u / ntn;
        LoadF32Rows al; al.init(P.p, 256, tm * 128); LoadBf16 bl; bl.init(P.w_pp_t, 256, tn * 128, nullptr);
        EpiPP ep{P.pp, P.prss, tm * 128, tn * 128};
        gemm128(smem, 256 / 64, al, bl, ep);
    }
}
struct EpiGateF {
    static constexpr bool PERM = false, AFTER_DRAIN = false;
    const bf16_t* h2; const bf16_t* pp; const float* prss; const float* ple_g; const float* b_pg; bf16_t* out;
    __device__ __forceinline__ void operator()(const f32x4 (&acc)[2][2][4][2], const pg8::Unit& u, int wr, int wc, int fr, int fq) const {
        const int row0 = u.pm * 256 + wr * 64 + fr, col0 = u.pn * 256 + wc * 32 + 4 * fq;
#pragma unroll
        for (int ai = 0; ai < 2; ++ai)
#pragma unroll
            for (int m = 0; m < 4; ++m) { const int row = row0 + ai * 128 + m * 16; const size_t ro = (size_t)row * DM + col0; const float pr = rsqrtf(prss[row] * (1.f / DM) + EPS);
#pragma unroll
                for (int bj = 0; bj < 2; ++bj)
#pragma unroll
                    for (int n = 0; n < 2; ++n) { const int c = col0 + bj * 128 + n * 16; const size_t o = ro + bj * 128 + n * 16;
                        const f32x4 z = acc[ai][bj][m][n] + *(const f32x4*)(b_pg + c); const u32x2 pq = *(const u32x2*)(pp + o); const f32x4 pl = (f32x4){bflo(pq[0]), bfhi(pq[0]), bflo(pq[1]), bfhi(pq[1])} * pr * *(const f32x4*)(ple_g + c); const u32x2 hq = *(const u32x2*)(h2 + o); const f32x4 hv = (f32x4){bflo(hq[0]), bfhi(hq[0]), bflo(hq[1]), bfhi(hq[1])};
                        f32x4 r;
#pragma unroll
                        for (int j = 0; j < 4; ++j) r[j] = hv[j] + pl[j] / (1.f + __expf(-z[j]));
                        u32x2 ov; ov[0] = cvt_pk_bf16(r[0], r[1]); ov[1] = cvt_pk_bf16(r[2], r[3]); *(u32x2*)(out + o) = ov; } }
    }
};
__device__ __forceinline__ void ph_plegate(const Params& P, char* smem) {
    pg8::Gemm g{P.h2b, P.w_pg_t, T_TOK, DM, DM};
    pg8::StaticOrder S; S.init(T_TOK, DM, gridDim.x, blockIdx.x);
    EpiGateF E{P.h2b, P.pp, P.prss, P.ple_g, P.b_pg, P.h3b};
    pg8::gemm_phase<EpiGateF, pg8::StaticOrder>((PG8_LAS unsigned char*)smem, g, S, E, nullptr);
    __syncthreads();
}
__device__ __forceinline__ void ph_final(const Params& P) {
    const int lane = TIDX() & 63, w = TIDX() >> 6;
    for (int t = blockIdx.x * (NT / 64) + w; t < T_TOK; t += gridDim.x * (NT / 64)) {
        f32x4 v[8]; float ss = 0.f;
#pragma unroll
        for (int i = 0; i < 8; ++i) { const u32x2 q = *(const u32x2*)(P.h3b + (size_t)t * DM + (i * 64 + lane) * 4); v[i] = (f32x4){bflo(q[0]), bfhi(q[0]), bflo(q[1]), bfhi(q[1])};
            ss += v[i][0] * v[i][0] + v[i][1] * v[i][1] + v[i][2] * v[i][2] + v[i][3] * v[i][3]; }
        const float rr = rsqrtf(wave_sum(ss) * (1.f / DM) + EPS);
        float* r = P.out + (size_t)t * DM;
#pragma unroll
        for (int i = 0; i < 8; ++i) { const f32x4 g = *(const f32x4*)(P.final_g + (i * 64 + lane) * 4); *(f32x4*)(r + (i * 64 + lane) * 4) = v[i] * rr * g; }
    }
}

#define LDS_BYTES 148736
#define PARAM_OFF 144000
#define NPW ((int)(sizeof(Params) / 4))
typedef __attribute__((address_space(1))) char gchar_t;
__device__ __forceinline__ Params params_from_lds(const LAS unsigned* src) {
    Params P; void** a = (void**)&P;
#pragma unroll
    for (int i = 0; i < NPW / 2; ++i) { const unsigned lo = (unsigned)__builtin_amdgcn_readfirstlane((int)src[2 * i]), hi = (unsigned)__builtin_amdgcn_readfirstlane((int)src[2 * i + 1]);
        a[i] = (void*)(gchar_t*)(((unsigned long long)hi << 32) | lo); }
    return P;
}
#define GRID_SYNC() do { xcd_barrier(bar); asm volatile("" ::: "memory"); } while (0)
__global__ void __launch_bounds__(NT, 2) hymba_fwd(Params Pk) {
    extern __shared__ __attribute__((aligned(16))) char smem_raw[];
    char* smem = smem_raw + 16;
    LAS unsigned* pl = (LAS unsigned*)(smem_raw + PARAM_OFF);
    if (TIDX() == 0) { *(uint4*)smem_raw = make_uint4(0u, 0u, 0u, 0u);
        const unsigned* s = (const unsigned*)&Pk;
#pragma unroll
        for (int i = 0; i < NPW; ++i) pl[i] = s[i]; }
    __syncthreads();
    XcdBarrier bar = xcd_barrier_post(Pk.bar, (volatile LAS unsigned*)smem_raw);
    {
        const Params P = params_from_lds(pl);
        ph_wt(smem, P.w_in, P.w_in_t, DM, INW, INW_PAD);
        ph_wt(smem, P.w_out, P.w_out_t, DM, DM, DM);
        ph_wt(smem, P.w_pg, P.w_pg_t, DM, DM, DM);
        ph_wt(smem, P.w_pp, P.w_pp_t, 256, DM, DM);
        ph_norm_x(P);
        ph_wcat(P);
        ph_rope_table(P);
        for (int i = blockIdx.x * NT + TIDX(); i < MAXROWS; i += gridDim.x * NT) { P.row_tok[i] = -1; P.row_slot[i] = 0; P.row_w[i] = 0.f; }
        for (int i = blockIdx.x * NT + TIDX(); i < T_TOK; i += gridDim.x * NT) P.prss[i] = 0.f;
        if (blockIdx.x == 0) for (int i = TIDX(); i < DM / 2; i += NT) ((unsigned*)(P.hn + (size_t)T_TOK * DM))[i] = 0u;
    }
    GRID_SYNC();
    { const Params P = params_from_lds(pl); ph_inproj(P, smem); }
    { const Params P = params_from_lds(pl); ph_pleproj(P, smem); }
    GRID_SYNC();
    { const Params P = params_from_lds(pl); ph_conv(P); }
    GRID_SYNC();
    { const Params P = params_from_lds(pl); ph_ssd(P, smem); }
    { const Params P = params_from_lds(pl); ph_attn(P, smem); }
    GRID_SYNC();
    { const Params P = params_from_lds(pl); ph_ssd_gate(P); }
    GRID_SYNC();
    { const Params P = params_from_lds(pl); ph_outproj(P, smem); }
    GRID_SYNC();
    { const Params P = params_from_lds(pl); ph_router(P, smem); }
    GRID_SYNC();
    { const Params P = params_from_lds(pl); ph_moe_scatter(P, smem); }
    GRID_SYNC();
    { const Params P = params_from_lds(pl); ph_moe_gu(P, smem); }
    GRID_SYNC();
    { const Params P = params_from_lds(pl); ph_moe_down(P, smem); }
    GRID_SYNC();
    { const Params P = params_from_lds(pl); ph_combine(P); }
    GRID_SYNC();
    { const Params P = params_from_lds(pl); ph_plegate(P, smem); }
    GRID_SYNC();
    { const Params P = params_from_lds(pl); ph_final(P); }
}

static inline size_t al256(size_t x) { return (x + 255) & ~(size_t)255; }

extern "C" void kernel_launch(void* const* d_in, const int* in_sizes, int n_in, void* d_out, int out_size, void* d_ws, size_t ws_size, hipStream_t stream) {
    Params P{};
    P.x = (const float*)d_in[0]; P.p = (const float*)d_in[1]; P.pos = (const int*)d_in[2]; P.norm_mix_g = (const float*)d_in[3]; P.w_in = (const float*)d_in[4];
    P.conv_w = (const float*)d_in[5]; P.conv_b = (const float*)d_in[6]; P.dt_bias_f = (const float*)d_in[7]; P.dt_bias_b = (const float*)d_in[8];
    P.a_log_f = (const float*)d_in[9]; P.a_log_b = (const float*)d_in[10]; P.d_skip = (const float*)d_in[11]; P.ssd_norm_g = (const float*)d_in[12];
    P.lam_q1 = (const float*)d_in[13]; P.lam_k1 = (const float*)d_in[14]; P.lam_q2 = (const float*)d_in[15]; P.lam_k2 = (const float*)d_in[16];
    P.subln_g = (const float*)d_in[17]; P.w_out = (const float*)d_in[18]; P.norm_ffn_g = (const float*)d_in[19]; P.w_rg = (const float*)d_in[20];
    P.b_rg = (const float*)d_in[21]; P.w_re = (const float*)d_in[22]; P.b_re = (const float*)d_in[23]; P.w_eg = (const float*)d_in[24];
    P.w_eu = (const float*)d_in[25]; P.w_ed = (const float*)d_in[26]; P.w_pp = (const float*)d_in[27]; P.ple_g = (const float*)d_in[28];
    P.w_pg = (const float*)d_in[29]; P.b_pg = (const float*)d_in[30]; P.final_g = (const float*)d_in[31];
    P.out = (float*)d_out;
    char* ws = (char*)d_ws; size_t o = 0;
    auto take = [&](size_t bytes) { char* r = ws + o; o = al256(o + bytes); return r; };
    P.bar = (unsigned*)take(16384);
    P.counts = (int*)(P.bar + 3584); P.cursor = (int*)(P.bar + 3584 + 128);
    P.w_in_t = (bf16_t*)take((size_t)INW_PAD * DM * 2); P.w_out_t = (bf16_t*)take((size_t)DM * DM * 2); P.w_pg_t = (bf16_t*)take((size_t)DM * DM * 2); P.w_pp_t = (bf16_t*)take((size_t)DM * 256 * 2);
    P.nbf = (bf16_t*)take((size_t)T_TOK * DM * 2); P.proj = (bf16_t*)take((size_t)T_TOK * INW * 2); P.dtv = (float*)take((size_t)T_TOK * 32 * 4);
    P.xbc = (bf16_t*)take((size_t)T_TOK * XBCW * 2); P.yf = (float*)take((size_t)T_TOK * SSDW * 4); P.yb = (float*)take((size_t)T_TOK * SSDW * 4);
    P.mix = (bf16_t*)take((size_t)T_TOK * DM * 2); P.h1 = (float*)take((size_t)T_TOK * DM * 4); P.hn = (bf16_t*)take((size_t)(T_TOK + 1) * DM * 2);
    P.tok_e = (int*)take((size_t)T_TOK * 2 * 4); P.tok_w = (float*)take((size_t)T_TOK * 2 * 4);
    P.row_tok = (int*)take((size_t)MAXROWS * 4); P.row_slot = (int*)take((size_t)MAXROWS * 4); P.row_w = (float*)take((size_t)MAXROWS * 4);
    P.act = (bf16_t*)take((size_t)MAXROWS * EFF * 2); P.ymoe = (bf16_t*)take((size_t)T_TOK * 2 * DM * 2); P.h2b = (bf16_t*)take((size_t)T_TOK * DM * 2);
    P.pp = (bf16_t*)take((size_t)T_TOK * DM * 2); P.prss = (float*)take((size_t)T_TOK * 4); P.wcat = (float*)take((size_t)DM * 96 * 4); P.rope = (float*)take((size_t)T_TOK * 16 * 4); P.h3b = (bf16_t*)take((size_t)T_TOK * DM * 2);
    (void)ws_size; (void)in_sizes; (void)n_in; (void)out_size;

    static int grid = 0;
    if (!grid) {
        int dev = 0, cus = 0, per_cu = 0;
        (void)hipGetDevice(&dev);
        (void)hipDeviceGetAttribute(&cus, hipDeviceAttributeMultiprocessorCount, dev);
        (void)hipFuncSetAttribute((const void*)hymba_fwd, hipFuncAttributeMaxDynamicSharedMemorySize, LDS_BYTES);
        (void)hipOccupancyMaxActiveBlocksPerMultiprocessor(&per_cu, hymba_fwd, NT, LDS_BYTES);
        if (cus <= 0) cus = 256;
        grid = cus * (per_cu < 1 ? 1 : 1);
    }
    (void)hipMemsetAsync(P.bar, 0, 16384, stream);
    hipLaunchKernelGGL(hymba_fwd, dim3(grid), dim3(NT), LDS_BYTES, stream, P);
}
```

```cpp
#include <hip/hip_runtime.h>
#include <stdint.h>

typedef unsigned short bf16_t;
typedef short bf16x8 __attribute__((ext_vector_type(8)));
typedef float f32x4 __attribute__((ext_vector_type(4)));
typedef unsigned u32x4 __attribute__((ext_vector_type(4)));
typedef unsigned u32x2 __attribute__((ext_vector_type(2)));

#define NT 512
#define T_TOK 8192
#define DM 2048
#define SEQ 2048
#define NB 4
#define INW 5664
#define INW_PAD 5888
#define OFF_Z 0
#define OFF_XBC 1024
#define OFF_DT 2560
#define OFF_Q 2592
#define OFF_K 3616
#define OFF_V 4640
#define XBCW 1536
#define SSDW 1024
#define NEXP 64
#define EFF 512
#define MAXROWS 24576
#define EPS 1e-6f

__device__ __forceinline__ int TIDX() { int t = (int)__builtin_amdgcn_workitem_id_x(); asm volatile("" : "+v"(t)); return t; }
typedef __bf16 bf16x2_t __attribute__((ext_vector_type(2)));
typedef float f32x2_t __attribute__((ext_vector_type(2)));
__device__ __forceinline__ unsigned cvt_pk_bf16(float lo, float hi) { const f32x2_t v = {lo, hi}; return __builtin_bit_cast(unsigned, __builtin_convertvector(v, bf16x2_t)); }
__device__ __forceinline__ bf16_t f2bf(float x) { return (bf16_t)(cvt_pk_bf16(x, 0.f) & 0xffffu); }
__device__ __forceinline__ float bf2f(bf16_t b) { return __uint_as_float(((unsigned)b) << 16); }
__device__ __forceinline__ float bflo(unsigned u) { return __uint_as_float(u << 16); }
__device__ __forceinline__ float bfhi(unsigned u) { return __uint_as_float(u & 0xffff0000u); }
__device__ __forceinline__ float siluf(float x) { return x / (1.f + expf(-x)); }
__device__ __forceinline__ int olane() { int l = (int)__builtin_amdgcn_mbcnt_hi(~0u, __builtin_amdgcn_mbcnt_lo(~0u, 0u)); asm volatile("" : "+v"(l)); return l; }
__device__ __forceinline__ float shx(float v, int ln, int m) { return __builtin_bit_cast(float, __builtin_amdgcn_ds_bpermute((ln ^ m) << 2, __builtin_bit_cast(int, v))); }
__device__ __forceinline__ float wave_sum(float v) { const int ln = olane(); for (int o = 32; o > 0; o >>= 1) v += shx(v, ln, o); return v; }
__device__ __forceinline__ float wave_max(float v) { const int ln = olane(); for (int o = 32; o > 0; o >>= 1) v = fmaxf(v, shx(v, ln, o)); return v; }
__device__ __forceinline__ float block_sum(float v, float* red) {
    v = wave_sum(v);
    __syncthreads();
    if ((TIDX() & 63) == 0) red[TIDX() >> 6] = v;
    __syncthreads();
    float s = 0.f;
#pragma unroll
    for (int i = 0; i < NT / 64; ++i) s += red[i];
    return s;
}

#define XB_TMO      128
#define XB_XCNT(j)  (256  + 64 * (j))
#define XB_XSUB(j)  (1280 + 64 * (j))
#define XB_XGEN(j)  (2304 + 64 * (j))
#define XB_TOP      3328
#define XB_TOPGEN   3392
#define XCD_BAR_WORDS 3456
#define XB_SPIN_CAP (1u << 18)
#define LAS __attribute__((address_space(3)))

__device__ __forceinline__ unsigned xb_ld(unsigned* p)              { return __hip_atomic_load(p, __ATOMIC_RELAXED, __HIP_MEMORY_SCOPE_AGENT); }
__device__ __forceinline__ unsigned xb_add(unsigned* p, unsigned v) { return __hip_atomic_fetch_add(p, v, __ATOMIC_RELAXED, __HIP_MEMORY_SCOPE_AGENT); }
__device__ __forceinline__ unsigned xb_xcc_id() { return (unsigned)__builtin_amdgcn_s_getreg((3 << 11) | 20) & 0xFu; }
#define XB_SPIN(cond, bar) do { unsigned _sp = 0; while (cond) { __builtin_amdgcn_s_sleep(1); \
    if ((++_sp & 255u) == 0u) { if (xb_ld(&(bar)[XB_TMO])) break; if (_sp > XB_SPIN_CAP) { atomicAdd(&(bar)[XB_TMO], 1u); break; } } } } while (0)

struct XcdBarrier { unsigned* bar; unsigned x; volatile LAS unsigned* st; };

__device__ __forceinline__ XcdBarrier xcd_barrier_post(unsigned* bar, volatile LAS unsigned* st) {
    XcdBarrier b; b.bar = bar; b.x = xb_xcc_id(); b.st = st;
    if (TIDX() == 0) (void)xb_add(&bar[XB_XCNT(b.x)], 1u);
    return b;
}
__device__ __forceinline__ void xcd_barrier_complete(unsigned* bar, unsigned x, unsigned& nloc, unsigned& nx) {
    const unsigned G = gridDim.x * gridDim.y * gridDim.z;
    unsigned sum, cnt, mine, sp = 0u;
    for (;;) {
        sum = 0u; cnt = 0u; mine = 0u;
#pragma unroll
        for (unsigned j = 0; j < 16; ++j) { const unsigned c = xb_ld(&bar[XB_XCNT(j)]); sum += c; cnt += (c > 0u) ? 1u : 0u; mine = (j == x) ? c : mine; }
        if (sum == G) break;
        __builtin_amdgcn_s_sleep(1);
        if ((++sp & 255u) == 0u) { if (xb_ld(&bar[XB_TMO])) break; if (sp > XB_SPIN_CAP) { atomicAdd(&bar[XB_TMO], 1u); break; } }
    }
    nloc = mine > 0u ? mine : 1u; nx = cnt > 0u ? cnt : 1u;
}
__device__ __forceinline__ void xcd_barrier(const XcdBarrier& b) {
    asm volatile("s_waitcnt vmcnt(0)" ::: "memory");
    __syncthreads();
    if (TIDX() == 0) {
        unsigned* bar = b.bar;
        __builtin_amdgcn_s_waitcnt(0);
        unsigned nloc = b.st[0], nx = b.st[1];
        if (nloc == 0u) { xcd_barrier_complete(bar, b.x, nloc, nx); b.st[0] = nloc; b.st[1] = nx; }
        const unsigned old = xb_add(&bar[XB_XSUB(b.x)], 1u);
        const unsigned gen = old / nloc;
        if (old + 1u == (gen + 1u) * nloc) {
            __builtin_amdgcn_fence(__ATOMIC_RELEASE, "agent");
            asm volatile("s_waitcnt vmcnt(0)" ::: "memory");
            const unsigned og = xb_add(&bar[XB_TOP], 1u);
            const unsigned tg = og / nx;
            if (og + 1u == (tg + 1u) * nx) xb_add(&bar[XB_TOPGEN], 1u);
            else XB_SPIN(xb_ld(&bar[XB_TOPGEN]) == tg, bar);
            __builtin_amdgcn_fence(__ATOMIC_ACQUIRE, "agent");
            xb_add(&bar[XB_XGEN(b.x)], 1u);
            asm volatile("s_waitcnt vmcnt(0)" ::: "memory");
        } else {
            XB_SPIN(xb_ld(&bar[XB_XGEN(b.x)]) == gen, bar);
            __builtin_amdgcn_fence(__ATOMIC_ACQUIRE, "agent");
            asm volatile("s_waitcnt vmcnt(0)" ::: "memory");
        }
    }
    __syncthreads();
}

struct Params {
    const float* x; const float* p; const int* pos; const float* norm_mix_g; const float* w_in; const float* conv_w; const float* conv_b;
    const float* dt_bias_f; const float* dt_bias_b; const float* a_log_f; const float* a_log_b; const float* d_skip; const float* ssd_norm_g;
    const float* lam_q1; const float* lam_k1; const float* lam_q2; const float* lam_k2; const float* subln_g; const float* w_out; const float* norm_ffn_g;
    const float* w_rg; const float* b_rg; const float* w_re; const float* b_re; const float* w_eg; const float* w_eu; const float* w_ed;
    const float* w_pp; const float* ple_g; const float* w_pg; const float* b_pg; const float* final_g;
    float* out;
    unsigned* bar; int* counts; int* cursor;
    bf16_t* w_in_t; bf16_t* w_out_t; bf16_t* w_pg_t; bf16_t* w_pp_t;
    bf16_t* nbf; bf16_t* proj; float* dtv; bf16_t* xbc; float* yf; float* yb; bf16_t* mix; float* h1; bf16_t* hn;
    int* tok_e; float* tok_w; int* row_tok; int* row_slot; float* row_w;
    bf16_t* act; bf16_t* ymoe; bf16_t* h2b; bf16_t* pp; float* prss; float* wcat; float* rope; bf16_t* h3b;
};

__device__ __forceinline__ void ph_wt(char* smem, const float* __restrict__ w, bf16_t* __restrict__ wt, int K, int N, int Npad) {
    float* tile = (float*)smem;
    const int tilesK = K / 64, tilesN = Npad / 64, tid = TIDX();
    for (int tI = blockIdx.x; tI < tilesK * tilesN; tI += gridDim.x) {
        const int tk = tI % tilesK, tn = tI / tilesK, k0 = tk * 64, n0 = tn * 64;
#pragma unroll
        for (int j = 0; j < 2; ++j) { const int row = (tid >> 4) + 32 * j, n4 = (tid & 15) * 4, n = n0 + n4;
            f32x4 v = {0.f, 0.f, 0.f, 0.f};
            if (n + 3 < N) v = *(const f32x4*)(w + (size_t)(k0 + row) * N + n);
            else { for (int e = 0; e < 4; ++e) if (n + e < N) v[e] = w[(size_t)(k0 + row) * N + n + e]; }
#pragma unroll
            for (int e = 0; e < 4; ++e) tile[row * 65 + n4 + e] = v[e]; }
        __syncthreads();
#pragma unroll
        for (int j = 0; j < 2; ++j) { const int item = tid + NT * j, kq = item & 15, n = item >> 4;
            u32x2 o; o[0] = cvt_pk_bf16(tile[(4 * kq) * 65 + n], tile[(4 * kq + 1) * 65 + n]); o[1] = cvt_pk_bf16(tile[(4 * kq + 2) * 65 + n], tile[(4 * kq + 3) * 65 + n]);
            *(u32x2*)(wt + (size_t)(n0 + n) * K + k0 + 4 * kq) = o; }
        __syncthreads();
    }
}

__device__ __forceinline__ void row_load(const float* r, f32x4 (&v)[8], int lane) {
#pragma unroll
    for (int i = 0; i < 8; ++i) v[i] = *(const f32x4*)(r + (i * 64 + lane) * 4);
}
__device__ __forceinline__ float row_sumsq(const f32x4 (&v)[8]) {
    float s = 0.f;
#pragma unroll
    for (int i = 0; i < 8; ++i) s += v[i][0] * v[i][0] + v[i][1] * v[i][1] + v[i][2] * v[i][2] + v[i][3] * v[i][3];
    return wave_sum(s);
}

__device__ __forceinline__ void ph_norm_x(const Params& P) {
    const int lane = TIDX() & 63, w = TIDX() >> 6;
    for (int row = blockIdx.x * (NT / 64) + w; row < T_TOK; row += gridDim.x * (NT / 64)) {
        f32x4 v[8]; row_load(P.x + (size_t)row * DM, v, lane);
        const float r = rsqrtf(row_sumsq(v) * (1.f / DM) + EPS);
#pragma unroll
        for (int i = 0; i < 8; ++i) { const f32x4 g = *(const f32x4*)(P.norm_mix_g + (i * 64 + lane) * 4);
            u32x2 o; o[0] = cvt_pk_bf16(v[i][0] * r * g[0], v[i][1] * r * g[1]); o[1] = cvt_pk_bf16(v[i][2] * r * g[2], v[i][3] * r * g[3]);
            *(u32x2*)(P.nbf + (size_t)row * DM + (i * 64 + lane) * 4) = o; }
    }
}

struct LoadBf16 {
    const bf16_t* rp[2]; u32x4 r[2];
    __device__ __forceinline__ void init(const bf16_t* base, size_t ld, int row0, const int* gather) {
#pragma unroll
        for (int i = 0; i < 2; ++i) { const int c = TIDX() + i * NT, row = c >> 3, kc = c & 7;
            if (gather) { const int t = gather[row0 + row]; rp[i] = (t >= 0) ? base + (size_t)t * ld + kc * 8 : nullptr; }
            else rp[i] = base + (size_t)(row0 + row) * ld + kc * 8; }
    }
    __device__ __forceinline__ void fetch(int kt) {
#pragma unroll
        for (int i = 0; i < 2; ++i) r[i] = rp[i] ? *(const u32x4*)(rp[i] + kt * 64) : (u32x4){0u, 0u, 0u, 0u};
    }
    __device__ __forceinline__ void commit(char* lds) {
#pragma unroll
        for (int i = 0; i < 2; ++i) { const int c = TIDX() + i * NT, row = c >> 3, kc = c & 7, kh = kc >> 2, kq = kc & 3;
            *(u32x4*)(lds + ((kh * 128 + row) * 32 + kq * 8) * 2) = r[i]; }
    }
};
struct LoadF32Rows {
    const float* rp[2]; f32x4 r[2][2];
    __device__ __forceinline__ void init(const float* base, size_t ld, int row0) {
#pragma unroll
        for (int i = 0; i < 2; ++i) { const int c = TIDX() + i * NT, row = c >> 3, kc = c & 7; rp[i] = base + (size_t)(row0 + row) * ld + kc * 8; }
    }
    __device__ __forceinline__ void fetch(int kt) {
#pragma unroll
        for (int i = 0; i < 2; ++i) { r[i][0] = *(const f32x4*)(rp[i] + kt * 64); r[i][1] = *(const f32x4*)(rp[i] + kt * 64 + 4); }
    }
    __device__ __forceinline__ void commit(char* lds) {
#pragma unroll
        for (int i = 0; i < 2; ++i) { const int c = TIDX() + i * NT, row = c >> 3, kc = c & 7, kh = kc >> 2, kq = kc & 3;
            u32x4 o; o[0] = cvt_pk_bf16(r[i][0][0], r[i][0][1]); o[1] = cvt_pk_bf16(r[i][0][2], r[i][0][3]); o[2] = cvt_pk_bf16(r[i][1][0], r[i][1][1]); o[3] = cvt_pk_bf16(r[i][1][2], r[i][1][3]);
            *(u32x4*)(lds + ((kh * 128 + row) * 32 + kq * 8) * 2) = o; }
    }
};
template <class AL, class BL, class EP>
__device__ __forceinline__ void gemm128(char* smem, int nk, AL& al, BL& bl, const EP& ep) {
    const int tid = TIDX(), wid = tid >> 6, lane = tid & 63, wr = wid >> 2, wc = wid & 3, fr = lane & 15, fq = lane >> 4;
    char* As = smem; char* Bs = smem + 16384;
    f32x4 acc[4][2];
#pragma unroll
    for (int m = 0; m < 4; ++m)
#pragma unroll
        for (int n = 0; n < 2; ++n) acc[m][n] = (f32x4){0.f, 0.f, 0.f, 0.f};
    al.fetch(0); bl.fetch(0);
    for (int kt = 0; kt < nk; ++kt) {
        __syncthreads();
        al.commit(As); bl.commit(Bs);
        __syncthreads();
        if (kt + 1 < nk) { al.fetch(kt + 1); bl.fetch(kt + 1); }
#pragma unroll
        for (int kh = 0; kh < 2; ++kh) {
            bf16x8 a[4], b[2];
#pragma unroll
            for (int m = 0; m < 4; ++m) a[m] = *(const bf16x8*)(As + ((kh * 128 + wr * 64 + m * 16 + fr) * 32 + fq * 8) * 2);
#pragma unroll
            for (int n = 0; n < 2; ++n) b[n] = *(const bf16x8*)(Bs + ((kh * 128 + wc * 32 + n * 16 + fr) * 32 + fq * 8) * 2);
#pragma unroll
            for (int m = 0; m < 4; ++m)
#pragma unroll
                for (int n = 0; n < 2; ++n) acc[m][n] = __builtin_amdgcn_mfma_f32_16x16x32_bf16(a[m], b[n], acc[m][n], 0, 0, 0);
        }
    }
    ep(acc, wr, wc, fr, fq);
    __syncthreads();
}

namespace pg8 {
#define PG8_LAS __attribute__((address_space(3)))
typedef unsigned short bf16_t;
typedef short bf16x8 __attribute__((ext_vector_type(8)));
typedef float f32x4 __attribute__((ext_vector_type(4)));
typedef unsigned u32x4 __attribute__((ext_vector_type(4)));
constexpr int BM = 256, BK = 64, HALF = 128, HTB = HALF * BK * 2  , STAGE_BYTES = 8 * HTB, NXCD = 8, WGM = 8;

__host__ __device__ __forceinline__ int lds_byte(int r, int c) { const int st = (r >> 4) * 2 + (c >> 5), rr = r & 15, cc = c & 31, ob = rr * 64 + cc * 2; return st * 1024 + (ob ^ (((ob >> 9) & 1) << 5)); }
__host__ __device__ __forceinline__ void stage_rc(int b, int& R, int& C) { const int st = b / 1024, sb = b % 1024, swz = sb ^ (((sb >> 9) & 1) << 5); R = (st >> 1) * 16 + swz / 64; C = (st & 1) * 32 + (swz % 64) / 2; }
__host__ __device__ __forceinline__ int perm32(int rho) { const int n = rho >> 4, i = rho & 15; return 8 * (i >> 2) + 4 * n + (i & 3); }

struct Unit { int pm, pn; };
struct Gemm { const bf16_t* A; const bf16_t* Bt; int M, N, K; };

struct StaticOrder {
    int nM, nN, nwg, G, c;
    __host__ __device__ void init(int M, int N, int G_, int c_) { nM = M / BM; nN = N / BM; nwg = nM * nN; G = G_; c = c_; }
    __host__ __device__ bool next(int i, Unit& u) const {
        const long L = (long)i * G + c; if (L >= nwg) return false;
        int wgid = (int)L; { const int q = nwg / NXCD, r = nwg % NXCD, xcd = wgid % NXCD, off = wgid / NXCD; wgid = (xcd < r ? xcd * (q + 1) : r * (q + 1) + (xcd - r) * q) + off; }
        const int nig = WGM * nN, gid = wgid / nig, fm = gid * WGM, gsz = (nM - fm) < WGM ? (nM - fm) : WGM;
        u.pm = fm + ((wgid % nig) % gsz); u.pn = (wgid % nig) / gsz; return true;
    }
    __device__ __forceinline__ void a_ready(const Unit&) const {}
    __device__ __forceinline__ void done(const Unit&) const {}
};

template <class Epi, class Sched, bool STAMP = false>
__device__ __forceinline__ void gemm_phase(PG8_LAS unsigned char* lds, const Gemm g, const Sched& S, const Epi& E, unsigned long long* stamps) {
    const int tid = TIDX(), wid = __builtin_amdgcn_readfirstlane(tid >> 6), lane = tid & 63, wr = wid >> 2, wc = wid & 3, fr = lane & 15, fq = lane >> 4;
    const int K = g.K, nt = K / BK;
    int ts_lo = 0, ts_hi = 0, nts = 0; const unsigned long long rt_entry = STAMP ? (unsigned long long)wall_clock64() : 0ull;
#define PG8_STAMP() do { if (STAMP && wid == 0 && nts < 64) { const unsigned long long _c = (unsigned long long)clock64(); \
        ts_lo = (lane == nts) ? (int)(unsigned)_c : ts_lo; ts_hi = (lane == nts) ? (int)(unsigned)(_c >> 32) : ts_hi; ++nts; } } while (0)
    PG8_STAMP();
    unsigned voffA[2], voffB[2];
#pragma unroll
    for (int i = 0; i < 2; ++i) { int R, C; stage_rc(tid * 16 + i * 8192, R, C); const int Rb = Epi::PERM ? ((R & ~31) + perm32(R & 31)) : R;
        voffA[i] = (unsigned)(R * K + C) * 2u; voffB[i] = (unsigned)(Rb * K + C) * 2u; }
    const size_t kstep = (size_t)(BK * 2);
    const size_t hstep = (size_t)HALF * K * 2;
    const size_t tstep = 2 * hstep;
    const unsigned ldsw = (unsigned)wid * 1024u;
    const int aoff = lds_byte(wr * 64 + fr, fq * 8), boff = lds_byte(wc * 32 + fr, fq * 8);
#define PG8_SA(b, h) (((b) * 2 + (h)) * HTB)
#define PG8_SB(b, h) ((4 + (b) * 2 + (h)) * HTB)
#define PG8_STAGE(bufoff, gbase, voff) do { _Pragma("unroll") for (int _i = 0; _i < 2; ++_i) \
        __builtin_amdgcn_global_load_lds((const unsigned*)((const char*)(gbase) + (voff)[_i]), (PG8_LAS unsigned*)(lds + (bufoff) + ldsw + _i * 8192), 16, 0, 0); } while (0)
#define PG8_LDA(dst, b, h) do { _Pragma("unroll") for (int m = 0; m < 4; ++m) _Pragma("unroll") for (int k = 0; k < 2; ++k) dst[m][k] = *(const PG8_LAS bf16x8*)(lds + PG8_SA(b, h) + aoff + m * 2048 + k * 1024); } while (0)
#define PG8_LDB(dst, b, h) do { _Pragma("unroll") for (int n = 0; n < 2; ++n) _Pragma("unroll") for (int k = 0; k < 2; ++k) dst[n][k] = *(const PG8_LAS bf16x8*)(lds + PG8_SB(b, h) + boff + n * 2048 + k * 1024); } while (0)
#define PG8_MMA(ai, bj, At, Bt) do { __builtin_amdgcn_s_setprio(1); _Pragma("unroll") for (int m = 0; m < 4; ++m) _Pragma("unroll") for (int n = 0; n < 2; ++n) _Pragma("unroll") for (int k = 0; k < 2; ++k) \
        acc[ai][bj][m][n] = __builtin_amdgcn_mfma_f32_16x16x32_bf16(Bt[n][k], At[m][k], acc[ai][bj][m][n], 0, 0, 0); __builtin_amdgcn_s_setprio(0); } while (0)
#define PG8_WAIT_V(n) asm volatile("s_waitcnt vmcnt(" #n ")" ::: "memory")
#define PG8_WAIT_L(n) asm volatile("s_waitcnt lgkmcnt(" #n ")" ::: "memory")
#define PG8_BAR __builtin_amdgcn_s_barrier()
#define PG8_SCHED __builtin_amdgcn_sched_barrier(0)
    Unit cur, nxt; int ui = 0;
    if (!S.next(0, cur)) return;
    f32x4 acc[2][2][4][2];
#pragma unroll
    for (int a = 0; a < 2; ++a)
#pragma unroll
        for (int b = 0; b < 2; ++b)
#pragma unroll
            for (int m = 0; m < 4; ++m)
#pragma unroll
                for (int n = 0; n < 2; ++n) acc[a][b][m][n] = (f32x4){0.f, 0.f, 0.f, 0.f};
    bf16x8 At[4][2], B0[2][2], B1[2][2];
    const char* cA = (const char*)g.A + (size_t)cur.pm * tstep; const char* cB = (const char*)g.Bt + (size_t)cur.pn * tstep;
    S.a_ready(cur);
    PG8_STAGE(PG8_SB(0, 0), cB, voffB); PG8_STAGE(PG8_SA(0, 0), cA, voffA); PG8_STAGE(PG8_SB(0, 1), cB + hstep, voffB); PG8_STAGE(PG8_SA(0, 1), cA + hstep, voffA);
    if (wr == 1) PG8_BAR;
    PG8_WAIT_V(4); PG8_BAR;
    PG8_STAGE(PG8_SB(1, 0), cB + kstep, voffB); PG8_STAGE(PG8_SA(1, 0), cA + kstep, voffA); PG8_STAGE(PG8_SB(1, 1), cB + hstep + kstep, voffB);
    PG8_WAIT_V(6); PG8_BAR;
    PG8_STAMP();
    for (;;) {
        const bool has_next = S.next(ui + 1, nxt);
        const char* nA = has_next ? (const char*)g.A + (size_t)nxt.pm * tstep : cA; const char* nB = has_next ? (const char*)g.Bt + (size_t)nxt.pn * tstep : cB;
        for (int t = 0; t < nt; t += 2) {
            const bool last = (t == nt - 2);
            const char* a1 = cA + (size_t)(t + 1) * kstep;
            const char* a2 = last ? nA : cA + (size_t)(t + 2) * kstep; const char* b2 = last ? nB : cB + (size_t)(t + 2) * kstep;
            const char* a3 = a2 + kstep; const char* b3 = b2 + kstep;
            if (last && has_next) S.a_ready(nxt);
            PG8_LDB(B0, 0, 0); PG8_SCHED; PG8_LDA(At, 0, 0); PG8_STAGE(PG8_SA(1, 1), a1 + hstep, voffA);
            PG8_WAIT_L(8); PG8_BAR; PG8_WAIT_L(0); PG8_MMA(0, 0, At, B0); PG8_BAR; PG8_SCHED;
            PG8_LDB(B1, 0, 1); PG8_STAGE(PG8_SB(0, 0), b2, voffB);
            PG8_BAR; PG8_WAIT_L(0); PG8_MMA(0, 1, At, B1); PG8_BAR;
            PG8_LDA(At, 0, 1); PG8_STAGE(PG8_SA(0, 0), a2, voffA);
            PG8_BAR; PG8_WAIT_L(0); PG8_MMA(1, 0, At, B0); PG8_BAR; PG8_SCHED;
            PG8_STAGE(PG8_SB(0, 1), b2 + hstep, voffB);
            PG8_WAIT_V(6); PG8_BAR; PG8_MMA(1, 1, At, B1); PG8_BAR;
            PG8_LDB(B0, 1, 0); PG8_SCHED; PG8_LDA(At, 1, 0); PG8_STAGE(PG8_SA(0, 1), a2 + hstep, voffA);
            PG8_WAIT_L(8); PG8_BAR; PG8_WAIT_L(0); PG8_MMA(0, 0, At, B0); PG8_BAR; PG8_SCHED;
            PG8_LDB(B1, 1, 1); PG8_STAGE(PG8_SB(1, 0), b3, voffB);
            PG8_BAR; PG8_WAIT_L(0); PG8_MMA(0, 1, At, B1); PG8_BAR;
            PG8_LDA(At, 1, 1); PG8_STAGE(PG8_SA(1, 0), a3, voffA);
            PG8_BAR; PG8_WAIT_L(0); PG8_MMA(1, 0, At, B0); PG8_BAR; PG8_SCHED;
            PG8_STAGE(PG8_SB(1, 1), b3 + hstep, voffB);
            PG8_WAIT_V(6); PG8_BAR; PG8_MMA(1, 1, At, B1); PG8_BAR;
        }
        PG8_STAMP();
        if constexpr (!Epi::AFTER_DRAIN) { E(acc, cur, wr, wc, fr, fq); S.done(cur); }
        PG8_STAMP();
        if (!has_next) break;
#pragma unroll
        for (int a = 0; a < 2; ++a)
#pragma unroll
            for (int b = 0; b < 2; ++b)
#pragma unroll
                for (int m = 0; m < 4; ++m)
#pragma unroll
                    for (int n = 0; n < 2; ++n) acc[a][b][m][n] = (f32x4){0.f, 0.f, 0.f, 0.f};
        cur = nxt; cA = nA; cB = nB; ++ui;
    }
    PG8_WAIT_V(0);
    if (wr == 0) PG8_BAR;
    PG8_BAR;
    if constexpr (Epi::AFTER_DRAIN) { E.fused(acc, cur, wr, wc, fr, fq, lds, wid, lane); S.done(cur); }
    PG8_STAMP();
    if (STAMP && wid == 0) { stamps[lane] = lane < nts ? (((unsigned long long)(unsigned)ts_hi << 32) | (unsigned)ts_lo) : 0ull;
        if (lane == 62) stamps[62] = rt_entry; if (lane == 63) stamps[63] = (unsigned long long)wall_clock64(); }
#undef PG8_STAMP
#undef PG8_SA
#undef PG8_SB
#undef PG8_STAGE
#undef PG8_LDA
#undef PG8_LDB
#undef PG8_MMA
#undef PG8_WAIT_V
#undef PG8_WAIT_L
#undef PG8_BAR
#undef PG8_SCHED
}
}


struct EpiInProjF {
    static constexpr bool PERM = true, AFTER_DRAIN = false;
    bf16_t* proj; float* dtv; const float* rope; const float* dt_bias_f; const float* dt_bias_b;
    __device__ __forceinline__ void operator()(const f32x4 (&acc)[2][2][4][2], const pg8::Unit& u, int wr, int wc, int fr, int fq) const {
        const int row0 = u.pm * 256 + wr * 64 + fr;
        const bool qk_tile = (u.pn >= 10) && (u.pn <= 18);
#pragma unroll
        for (int ai = 0; ai < 2; ++ai)
#pragma unroll
            for (int m = 0; m < 4; ++m) { const int row = row0 + ai * 128 + m * 16;
                f32x4 c0 = {0.f, 0.f, 0.f, 0.f}, c1 = c0, s0 = c0, s1 = c0;
                if (qk_tile) { const float* rp = rope + (size_t)row * 16; c0 = *(const f32x4*)rp; c1 = *(const f32x4*)(rp + 4); s0 = *(const f32x4*)(rp + 8); s1 = *(const f32x4*)(rp + 12); }
#pragma unroll
                for (int bj = 0; bj < 2; ++bj) { const int col0 = u.pn * 256 + bj * 128 + wc * 32 + 8 * fq;
                    f32x4 v0 = acc[ai][bj][m][0], v1 = acc[ai][bj][m][1];
                    if (qk_tile) {
                        f32x4 p0, p1;
                        const int ln_ = olane();
#pragma unroll
                        for (int j = 0; j < 4; ++j) { p0[j] = shx(v0[j], ln_, 16); p1[j] = shx(v1[j], ln_, 16); }
                        const int d0 = (col0 - OFF_Q) & 63;
                        if (col0 >= OFF_Q && col0 < OFF_V && d0 < 16) {
                            if (d0 == 0) { v0 = v0 * c0 - p0 * s0; v1 = v1 * c1 - p1 * s1; }
                            else         { v0 = v0 * c0 + p0 * s0; v1 = v1 * c1 + p1 * s1; }
                        }
                    }
                    if (col0 < INW) {
                        u32x4 w; w[0] = cvt_pk_bf16(v0[0], v0[1]); w[1] = cvt_pk_bf16(v0[2], v0[3]); w[2] = cvt_pk_bf16(v1[0], v1[1]); w[3] = cvt_pk_bf16(v1[2], v1[3]);
                        *(u32x4*)(proj + (size_t)row * INW + col0) = w;
                        if (col0 >= OFF_DT && col0 < OFF_DT + 32) { const int j0 = col0 - OFF_DT; const float* bp = (j0 < 16) ? (dt_bias_f + j0) : (dt_bias_b + (j0 - 16));
                            f32x4 o0, o1;
#pragma unroll
                            for (int j = 0; j < 4; ++j) { const float a = v0[j] + bp[j], b = v1[j] + bp[4 + j];
                                o0[j] = fmaxf(a, 0.f) + log1pf(expf(-fabsf(a))); o1[j] = fmaxf(b, 0.f) + log1pf(expf(-fabsf(b))); }
                            *(f32x4*)(dtv + (size_t)row * 32 + j0) = o0; *(f32x4*)(dtv + (size_t)row * 32 + j0 + 4) = o1; } } } }
    }
};
__device__ __forceinline__ void ph_inproj(const Params& P, char* smem) {
    pg8::Gemm g{P.nbf, P.w_in_t, T_TOK, INW_PAD, DM};
    pg8::StaticOrder S; S.init(T_TOK, INW_PAD, gridDim.x, blockIdx.x);
    EpiInProjF E{P.proj, P.dtv, P.rope, P.dt_bias_f, P.dt_bias_b};
    pg8::gemm_phase<EpiInProjF, pg8::StaticOrder>((PG8_LAS unsigned char*)smem, g, S, E, nullptr);
    __syncthreads();
}

__device__ __forceinline__ void ph_rope_table(const Params& P) {
    for (int i = blockIdx.x * NT + TIDX(); i < T_TOK * 8; i += gridDim.x * NT) { const int t = i >> 3, f = i & 7;
        const float ang = (float)P.pos[t] * powf(500000.0f, -(float)(2 * f) / 16.0f);
        P.rope[t * 16 + f] = cosf(ang); P.rope[t * 16 + 8 + f] = sinf(ang); }
}
__device__ __forceinline__ void ph_conv(const Params& P) {
    for (int id = blockIdx.x * NT + TIDX(); id < (XBCW / 8) * (T_TOK / 16); id += gridDim.x * NT) {
        const int cg = id % (XBCW / 8), tg = id / (XBCW / 8), c = cg * 8, t0 = tg * 16, s0 = t0 & (SEQ - 1);
        float w[5][8], bias[8];
#pragma unroll
        for (int k = 0; k < 5; ++k) { const f32x4 a = *(const f32x4*)(P.conv_w + k * XBCW + c), b = *(const f32x4*)(P.conv_w + k * XBCW + c + 4);
#pragma unroll
            for (int j = 0; j < 4; ++j) { w[k][j] = a[j]; w[k][4 + j] = b[j]; } }
        { const f32x4 a = *(const f32x4*)(P.conv_b + c), b = *(const f32x4*)(P.conv_b + c + 4);
#pragma unroll
          for (int j = 0; j < 4; ++j) { bias[j] = a[j]; bias[4 + j] = b[j]; } }
        const bf16_t* src = P.proj + (size_t)t0 * INW + OFF_XBC + c;
        u32x4 win[5];
#pragma unroll
        for (int k = 0; k < 4; ++k) { const int ss = s0 + k - 2; win[k + 1] = (ss >= 0) ? *(const u32x4*)(src + (ptrdiff_t)(k - 2) * INW) : (u32x4){0u, 0u, 0u, 0u}; }
#pragma unroll
        for (int r = 0; r < 16; ++r) {
#pragma unroll
            for (int k = 0; k < 4; ++k) win[k] = win[k + 1];
            { const int ss = s0 + r + 2; win[4] = (ss < SEQ) ? *(const u32x4*)(src + (ptrdiff_t)(r + 2) * INW) : (u32x4){0u, 0u, 0u, 0u}; }
            float o[8];
#pragma unroll
            for (int j = 0; j < 8; ++j) o[j] = bias[j];
#pragma unroll
            for (int k = 0; k < 5; ++k)
#pragma unroll
                for (int e = 0; e < 4; ++e) { o[2 * e] += bflo(win[k][e]) * w[k][2 * e]; o[2 * e + 1] += bfhi(win[k][e]) * w[k][2 * e + 1]; }
            u32x4 ov;
#pragma unroll
            for (int e = 0; e < 4; ++e) { const float a = o[2 * e], b = o[2 * e + 1]; ov[e] = cvt_pk_bf16(a / (1.f + __expf(-a)), b / (1.f + __expf(-b))); }
            *(u32x4*)(P.xbc + (size_t)(t0 + r) * XBCW + c) = ov;
        }
    }
}

typedef float f32x16 __attribute__((ext_vector_type(16)));
typedef short s16x4 __attribute__((ext_vector_type(4)));
__device__ __forceinline__ int crow(int r, int hi) { return (r & 3) + 8 * (r >> 2) + 4 * hi; }
__device__ __forceinline__ unsigned off_b(unsigned row, unsigned ch) { return 256u * row + 16u * (ch ^ (((row & 3) << 2) | ((row >> 2) & 3))); }
__device__ __forceinline__ unsigned off_x(unsigned l, unsigned ch) { return 128u * l + 16u * (ch ^ (((l >> 1) & 1) << 2)); }
__device__ __forceinline__ s16x4 tr_read_a(unsigned addr) { s16x4 r; asm volatile("ds_read_b64_tr_b16 %0, %1" : "=&v"(r) : "v"(addr) : "memory"); return r; }
#define SSD_B 0
#define SSD_C 32768
#define SSD_XD 65536
#define SSD_XE 81920
#define SSD_S 98304
#define SSD_ARR 114688
#define SSD_SPLIT 10
__device__ __forceinline__ void ph_ssd(const Params& P, char* smem) {
    const int tid = TIDX(), wid = __builtin_amdgcn_readfirstlane(tid >> 6), lane = tid & 63, r32 = lane & 31, hi = lane >> 5;
    const unsigned lbase = (unsigned)(uintptr_t)smem;
    float* arrA = (float*)(smem + SSD_ARR); float* arrEA = arrA + 128; float* arrDT = arrA + 256; float* arrDTE = arrA + 384; float* arrTOT = arrA + 512;
    const int lt = wid >> 1, pt = wid & 1;
    const int spt = wid >> 2, snt = wid & 3;
    const unsigned tq = (lane & 15) >> 2, tp = lane & 3, tblk = (lane >> 4) & 1;
#pragma unroll 1
    for (int u = blockIdx.x; u < NB * 16 * 2 * 2; u += gridDim.x) {
        const int dir = u & 1, h = (u >> 1) & 15, b = (u >> 5) & 3, hv = u >> 7, g = h >> 3;
        const float a = -expf(dir ? P.a_log_b[h] : P.a_log_f[h]);
        float* y = dir ? P.yb : P.yf;
        f32x16 S = f32x16{};
        __syncthreads();
        for (int i = tid; i < 64 * 128 / 2; i += NT) ((unsigned*)(smem + SSD_S))[i] = 0u;
#pragma unroll 1
        for (int ci = 0; ci < (hv ? SEQ / 128 : SSD_SPLIT); ++ci) {
            const bool full = ci >= (hv ? SSD_SPLIT : 0);
            const int c = dir ? (SEQ / 128 - 1 - ci) : ci;
            const size_t t0 = (size_t)b * SEQ + (size_t)c * 128;
            __syncthreads();
            u32x4 rb[4], rc[4], rx[2];
#pragma unroll
            for (int i = 0; i < 4; ++i) { const int cc = tid + i * NT, l = cc >> 4, ch = cc & 15; const bf16_t* src = P.xbc + (t0 + l) * XBCW + g * 128 + ch * 8;
                rb[i] = *(const u32x4*)(src + 1024); if (full) rc[i] = *(const u32x4*)(src + 1280); }
#pragma unroll
            for (int i = 0; i < 2; ++i) { const int cc = tid + i * NT, l = cc >> 3, ch = cc & 7; rx[i] = *(const u32x4*)(P.xbc + (t0 + l) * XBCW + h * 64 + ch * 8); }
            if (wid == 0) {
                const float dt0 = P.dtv[(t0 + 2 * lane) * 32 + dir * 16 + h], dt1 = P.dtv[(t0 + 2 * lane + 1) * 32 + dir * 16 + h];
                const float da0 = dt0 * a, da1 = dt1 * a;
                float pr = da0 + da1;
#pragma unroll
                for (int o = 1; o < 64; o <<= 1) { const float v = __shfl_up(pr, o); if (lane >= o) pr += v; }
                const float tot = __shfl(pr, 63), acs1 = pr, acs0 = pr - da1;
                const float A0 = dir ? (tot - acs0 + da0) : acs0, A1 = dir ? (tot - acs1 + da1) : acs1;
                arrA[2 * lane] = A0; arrA[2 * lane + 1] = A1; arrEA[2 * lane] = expf(A0); arrEA[2 * lane + 1] = expf(A1);
                arrDT[2 * lane] = dt0; arrDT[2 * lane + 1] = dt1; arrDTE[2 * lane] = dt0 * expf(tot - A0); arrDTE[2 * lane + 1] = dt1 * expf(tot - A1);
                if (lane == 0) arrTOT[0] = expf(tot);
            }
#pragma unroll
            for (int i = 0; i < 4; ++i) { const int cc = tid + i * NT, l = cc >> 4, ch = cc & 15; *(u32x4*)(smem + SSD_B + off_b(l, ch)) = rb[i]; if (full) *(u32x4*)(smem + SSD_C + off_b(l, ch)) = rc[i]; }
            __syncthreads();
#pragma unroll
            for (int i = 0; i < 2; ++i) { const int cc = tid + i * NT, l = cc >> 3, ch = cc & 7; const float dt = arrDT[l], dte = arrDTE[l];
                u32x4 xd, xe;
#pragma unroll
                for (int e = 0; e < 4; ++e) { const float lo = bflo(rx[i][e]), hv = bfhi(rx[i][e]); xd[e] = cvt_pk_bf16(lo * dt, hv * dt); xe[e] = cvt_pk_bf16(lo * dte, hv * dte); }
                if (full) *(u32x4*)(smem + SSD_XD + off_x(l, ch)) = xd; *(u32x4*)(smem + SSD_XE + off_x(l, ch)) = xe; }
            __syncthreads();
            if (full) {
            f32x16 Y = f32x16{};
#define SSD_CF(ks) (*(const bf16x8*)(smem + SSD_C + off_b(32 * lt + r32, 2 * (ks) + hi)))
            if (ci > 0) {
#pragma unroll
                for (int ks = 0; ks < 8; ++ks) { const bf16x8 sf = *(const bf16x8*)(smem + SSD_S + off_b(32 * pt + r32, 2 * ks + hi));
                    Y = __builtin_amdgcn_mfma_f32_32x32x16_bf16(SSD_CF(ks), sf, Y, 0, 0, 0); }
#pragma unroll
                for (int r = 0; r < 16; ++r) Y[r] *= arrEA[32 * lt + crow(r, hi)];
            }
            const float Al = arrA[32 * lt + r32];
            const int j0 = dir ? lt : 0, j1 = dir ? 3 : lt;
#pragma unroll 1
            for (int j = j0; j <= j1; ++j) {
                f32x16 X1 = f32x16{};
#pragma unroll
                for (int ks = 0; ks < 8; ++ks) { const bf16x8 bfr = *(const bf16x8*)(smem + SSD_B + off_b(32 * j + r32, 2 * ks + hi));
                    X1 = __builtin_amdgcn_mfma_f32_32x32x16_bf16(bfr, SSD_CF(ks), X1, 0, 0, 0); }
#pragma unroll
                for (int r = 0; r < 16; ++r) { const int sl = crow(r, hi); const float As = arrA[32 * j + sl];
                    const bool valid = (j != lt) || (dir ? (sl >= r32) : (sl <= r32));
                    X1[r] = valid ? X1[r] * expf(Al - As) : 0.f; }
#pragma unroll
                for (int k2 = 0; k2 < 2; ++k2) {
                    u32x4 aw; aw[0] = cvt_pk_bf16(X1[8 * k2 + 0], X1[8 * k2 + 1]); aw[1] = cvt_pk_bf16(X1[8 * k2 + 2], X1[8 * k2 + 3]);
                    aw[2] = cvt_pk_bf16(X1[8 * k2 + 4], X1[8 * k2 + 5]); aw[3] = cvt_pk_bf16(X1[8 * k2 + 6], X1[8 * k2 + 7]);
                    const unsigned rw0 = 32 * j + 16 * k2 + 4 * hi + tq, rw1 = rw0 + 8;
                    const s16x4 x0 = tr_read_a(lbase + SSD_XD + off_x(rw0, 4 * pt + 2 * tblk + (tp >> 1)) + 8 * (tp & 1));
                    const s16x4 x1 = tr_read_a(lbase + SSD_XD + off_x(rw1, 4 * pt + 2 * tblk + (tp >> 1)) + 8 * (tp & 1));
                    asm volatile("s_waitcnt lgkmcnt(0)" ::: "memory"); __builtin_amdgcn_sched_barrier(0);
                    const bf16x8 xf = (bf16x8){x0[0], x0[1], x0[2], x0[3], x1[0], x1[1], x1[2], x1[3]};
                    Y = __builtin_amdgcn_mfma_f32_32x32x16_bf16(*reinterpret_cast<bf16x8*>(&aw), xf, Y, 0, 0, 0);
                }
            }
            {   int opq = 0; asm volatile("" : "+v"(opq));
                float* yo = y + (t0 + 32 * lt + 4 * hi + opq) * SSDW + h * 64 + 32 * pt + r32;
#pragma unroll
                for (int r = 0; r < 16; ++r) yo[(size_t)((r & 3) + 8 * (r >> 2)) * SSDW] = Y[r]; }
            }
            { const float tot = arrTOT[0];
#pragma unroll
              for (int r = 0; r < 16; ++r) S[r] *= tot; }
#pragma unroll
            for (int ks = 0; ks < 8; ++ks) {
                const unsigned rw0 = 16 * ks + 8 * hi + tq, rw1 = rw0 + 4;
                const s16x4 a0 = tr_read_a(lbase + SSD_XE + off_x(rw0, 4 * spt + 2 * tblk + (tp >> 1)) + 8 * (tp & 1));
                const s16x4 a1 = tr_read_a(lbase + SSD_XE + off_x(rw1, 4 * spt + 2 * tblk + (tp >> 1)) + 8 * (tp & 1));
                const s16x4 b0 = tr_read_a(lbase + SSD_B + off_b(rw0, 4 * snt + 2 * tblk + (tp >> 1)) + 8 * (tp & 1));
                const s16x4 b1 = tr_read_a(lbase + SSD_B + off_b(rw1, 4 * snt + 2 * tblk + (tp >> 1)) + 8 * (tp & 1));
                asm volatile("s_waitcnt lgkmcnt(0)" ::: "memory"); __builtin_amdgcn_sched_barrier(0);
                const bf16x8 af = (bf16x8){a0[0], a0[1], a0[2], a0[3], a1[0], a1[1], a1[2], a1[3]};
                const bf16x8 bfr = (bf16x8){b0[0], b0[1], b0[2], b0[3], b1[0], b1[1], b1[2], b1[3]};
                S = __builtin_amdgcn_mfma_f32_32x32x16_bf16(af, bfr, S, 0, 0, 0);
            }
            __syncthreads();
#pragma unroll
            for (int r = 0; r < 16; ++r) { const unsigned pr = 32 * spt + crow(r, hi), n = 32 * snt + r32;
                *(bf16_t*)(smem + SSD_S + off_b(pr, n >> 3) + (n & 7) * 2) = f2bf(S[r]); }
        }
    }
    __syncthreads();
}

__device__ __forceinline__ void ph_ssd_gate(const Params& P) {
    const int lane = TIDX() & 63, w = TIDX() >> 6;
    for (int t = blockIdx.x * (NT / 64) + w; t < T_TOK; t += gridDim.x * (NT / 64)) {
        float v[16]; float ss = 0.f;
#pragma unroll
        for (int i = 0; i < 4; ++i) { const int c = (i * 64 + lane) * 4;
            const f32x4 a = *(const f32x4*)(P.yf + (size_t)t * SSDW + c), bb = *(const f32x4*)(P.yb + (size_t)t * SSDW + c);
            const u32x2 xs = *(const u32x2*)(P.xbc + (size_t)t * XBCW + c), zz = *(const u32x2*)(P.proj + (size_t)t * INW + OFF_Z + c);
            const float d = P.d_skip[c >> 6];
            const float xv[4] = {bflo(xs[0]), bfhi(xs[0]), bflo(xs[1]), bfhi(xs[1])}, zv[4] = {bflo(zz[0]), bfhi(zz[0]), bflo(zz[1]), bfhi(zz[1])};
#pragma unroll
            for (int j = 0; j < 4; ++j) { const float y = a[j] + bb[j] + xv[j] * d; v[i * 4 + j] = y * siluf(zv[j]); ss += v[i * 4 + j] * v[i * 4 + j]; } }
        ss = wave_sum(ss);
        const float r = rsqrtf(ss * (1.f / SSDW) + EPS);
#pragma unroll
        for (int i = 0; i < 4; ++i) { const int c = (i * 64 + lane) * 4; const f32x4 g = *(const f32x4*)(P.ssd_norm_g + c);
            u32x2 o; o[0] = cvt_pk_bf16(v[i * 4] * r * g[0], v[i * 4 + 1] * r * g[1]); o[1] = cvt_pk_bf16(v[i * 4 + 2] * r * g[2], v[i * 4 + 3] * r * g[3]);
            *(u32x2*)(P.mix + (size_t)t * DM + c) = o; }
    }
}

#define AT_SHM_V 16384
#define AT_SHM_K 8192
#define AT_KVBLK 64
#define AT_THR 8.f
#define AT_SCALE 0.125f
#define KSWZ64(row, colB) ((row) * 128 + ((colB) ^ (((row) & 7) << 4)))
#define SBAR() __builtin_amdgcn_sched_barrier(0)
__device__ __forceinline__ void partialSM(f32x16& p0, f32x16& p1, float& m_reg, float& mn, float& alpha) {
    constexpr float C = AT_SCALE * 1.4426950408889634f;
    float pmax = p0[0];
#pragma unroll
    for (int r = 1; r < 16; ++r) pmax = fmaxf(pmax, p0[r]);
#pragma unroll
    for (int r = 0; r < 16; ++r) pmax = fmaxf(pmax, p1[r]);
    { auto rr = __builtin_amdgcn_permlane32_swap(__float_as_uint(pmax), __float_as_uint(pmax), false, false);
      pmax = fmaxf(__uint_as_float(rr[0]), __uint_as_float(rr[1])); }
    if (__builtin_expect(__all(pmax - m_reg <= AT_THR / AT_SCALE), 1)) { mn = m_reg; alpha = 1.f; }
    else { mn = fmaxf(m_reg, pmax); alpha = __builtin_amdgcn_exp2f((m_reg - mn) * C); m_reg = mn; }
    const float mnC = -mn * C;
#pragma unroll
    for (int r = 0; r < 16; ++r) p0[r] = fmaf(p0[r], C, mnC);
#pragma unroll
    for (int r = 0; r < 16; ++r) p1[r] = fmaf(p1[r], C, mnC);
#pragma unroll
    for (int r = 0; r < 16; ++r) p0[r] = __builtin_amdgcn_exp2f(p0[r]);
}
__device__ __forceinline__ void finishSM(f32x16& p0, f32x16& p1, float alpha, float& l_reg, bf16x8& pa0, bf16x8& pa1, bf16x8& pa2, bf16x8& pa3) {
#pragma unroll
    for (int r = 0; r < 16; ++r) p1[r] = __builtin_amdgcn_exp2f(p1[r]);
    float ps = 0;
#pragma unroll
    for (int r = 0; r < 16; ++r) ps += p0[r];
#pragma unroll
    for (int r = 0; r < 16; ++r) ps += p1[r];
    { auto rr = __builtin_amdgcn_permlane32_swap(__float_as_uint(ps), __float_as_uint(ps), false, false);
      ps = __uint_as_float(rr[0]) + __uint_as_float(rr[1]); }
    l_reg = l_reg * alpha + ps;
#define PK4(P, BASE, OUT) do { unsigned a0 = cvt_pk_bf16(P[BASE + 0], P[BASE + 1]), a1 = cvt_pk_bf16(P[BASE + 2], P[BASE + 3]);   \
    unsigned b0 = cvt_pk_bf16(P[BASE + 4], P[BASE + 5]), b1 = cvt_pk_bf16(P[BASE + 6], P[BASE + 7]);                              \
    auto r0 = __builtin_amdgcn_permlane32_swap(a0, b0, false, false); auto r1 = __builtin_amdgcn_permlane32_swap(a1, b1, false, false); \
    u32x4 w = {r0[0], r1[0], r0[1], r1[1]}; OUT = *reinterpret_cast<bf16x8*>(&w); } while (0)
    PK4(p0, 0, pa0); PK4(p0, 8, pa1); PK4(p1, 0, pa2); PK4(p1, 8, pa3);
#undef PK4
}
__device__ __forceinline__ void qkt64(f32x16& p0, f32x16& p1, const char* Ks, const bf16x8* qr, int r32, int hi) {
    p0 = f32x16{}; p1 = f32x16{};
#pragma unroll
    for (int d0 = 0; d0 < 4; ++d0) { const int cb = (d0 * 16 + hi * 8) * 2;
        const bf16x8 b0 = *reinterpret_cast<const bf16x8*>(Ks + KSWZ64(r32, cb));
        const bf16x8 b1 = *reinterpret_cast<const bf16x8*>(Ks + KSWZ64(32 + r32, cb));
        p0 = __builtin_amdgcn_mfma_f32_32x32x16_bf16(b0, qr[d0], p0, 0, 0, 0);
        p1 = __builtin_amdgcn_mfma_f32_32x32x16_bf16(b1, qr[d0], p1, 0, 0, 0); }
}
__device__ __forceinline__ int v_st(int k, int c) { const int kk = (k & ~0xC) | ((k & 4) << 1) | ((k & 8) >> 1); return ((kk >> 3) * 4 + (c >> 5)) * 512 + ((kk & 7) * 32 + (c & 31)) * 2; }
__device__ __forceinline__ int v_rd_base(int lane) { return ((lane & 3) << 3) | (((lane >> 2) & 3) << 6) | (((lane >> 4) & 1) << 5) | (((lane >> 5) & 1) << 8); }
constexpr int v_rd_off(int d0, int ks, int half) { return d0 * 512 + ks * 4096 + half * 2048; }
template <int OFF> __device__ __forceinline__ s16x4 tr_read(int vb) {
    s16x4 r; asm volatile("ds_read_b64_tr_b16 %0, %1 offset:%2" : "=&v"(r) : "v"(vb), "i"(OFF) : "memory"); return r;
}
template <int D0> __device__ __forceinline__ void pv_one(f32x16& od, int vb, bf16x8 pa0, bf16x8 pa1, bf16x8 pa2, bf16x8 pa3) {
    const s16x4 l0 = tr_read<v_rd_off(D0, 0, 0)>(vb), h0 = tr_read<v_rd_off(D0, 0, 1)>(vb), l1 = tr_read<v_rd_off(D0, 1, 0)>(vb), h1 = tr_read<v_rd_off(D0, 1, 1)>(vb);
    const s16x4 l2 = tr_read<v_rd_off(D0, 2, 0)>(vb), h2 = tr_read<v_rd_off(D0, 2, 1)>(vb), l3 = tr_read<v_rd_off(D0, 3, 0)>(vb), h3 = tr_read<v_rd_off(D0, 3, 1)>(vb);
    asm volatile("s_waitcnt lgkmcnt(0)" ::: "memory"); SBAR();
#define PKV(L, H) (bf16x8){L[0], L[1], L[2], L[3], H[0], H[1], H[2], H[3]}
    od = __builtin_amdgcn_mfma_f32_32x32x16_bf16(pa0, PKV(l0, h0), od, 0, 0, 0);
    od = __builtin_amdgcn_mfma_f32_32x32x16_bf16(pa1, PKV(l1, h1), od, 0, 0, 0);
    od = __builtin_amdgcn_mfma_f32_32x32x16_bf16(pa2, PKV(l2, h2), od, 0, 0, 0);
    od = __builtin_amdgcn_mfma_f32_32x32x16_bf16(pa3, PKV(l3, h3), od, 0, 0, 0);
#undef PKV
}
__device__ __forceinline__ void pv_d0(f32x16* o, int vb, bf16x8 pa0, bf16x8 pa1, bf16x8 pa2, bf16x8 pa3) {
    pv_one<0>(o[0], vb, pa0, pa1, pa2, pa3); pv_one<1>(o[1], vb, pa0, pa1, pa2, pa3); pv_one<2>(o[2], vb, pa0, pa1, pa2, pa3); pv_one<3>(o[3], vb, pa0, pa1, pa2, pa3);
}
__device__ __forceinline__ void attn_pass(const bf16_t* __restrict__ Qb, const bf16_t* __restrict__ Kh, const bf16_t* __restrict__ Vh, char* lds, f32x16 (&o)[4]) {
    const int tid = TIDX(), wid = tid >> 6, lane = tid & 63, r32 = lane & 31, hi = lane >> 5;
    char* V_lds = lds; char* K_lds = lds + 2 * AT_SHM_V;
    float* ws = (float*)(lds + 2 * AT_SHM_V + 2 * AT_SHM_K) + wid * 64; float* li_l = ws; float* al_l = ws + 32;
    float m_reg = -1e30f, l_reg = 0;
#pragma unroll
    for (int d = 0; d < 4; ++d) o[d] = f32x16{};
    bf16x8 qr[4];
    const bf16_t* Qw = Qb + (size_t)(wid * 32 + r32) * INW + hi * 8;
#pragma unroll
    for (int d0 = 0; d0 < 4; ++d0) qr[d0] = *reinterpret_cast<const bf16x8*>(Qw + d0 * 16);
    const int sr = tid >> 4, sc = (tid & 15) * 8, vst0 = v_st(sr, sc), vst1 = v_st(32 + sr, sc);
    const int kr = tid >> 3, kc = (tid & 7) * 8, kst = KSWZ64(kr, kc * 2);
    const int vb0 = (int)(uintptr_t)V_lds + v_rd_base(lane);
    struct { bf16x8 vs0, vs1, ks0; } sr_[2];
    const unsigned voff0 = (unsigned)(sr * INW + sc), voff1 = (unsigned)((32 + sr) * INW + sc), koff = (unsigned)(kr * INW + kc);
#define SLOAD(i, k0) do { const bf16_t* Vt = Vh + (size_t)(k0) * INW; const bf16_t* Kt = Kh + (size_t)(k0) * INW; \
    sr_[i].vs0 = *reinterpret_cast<const bf16x8*>(Vt + voff0); sr_[i].vs1 = *reinterpret_cast<const bf16x8*>(Vt + voff1); sr_[i].ks0 = *reinterpret_cast<const bf16x8*>(Kt + koff); } while (0)
#define SWRITE(b, i) do { *(bf16x8*)(V_lds + (b) * AT_SHM_V + vst0) = sr_[i].vs0; *(bf16x8*)(V_lds + (b) * AT_SHM_V + vst1) = sr_[i].vs1; \
    *(bf16x8*)(K_lds + (b) * AT_SHM_K + kst) = sr_[i].ks0; } while (0)
#define SWAIT() asm volatile("s_waitcnt vmcnt(3)" ::: "memory")
#define RESC(a) do { if (__any((a) < 1.f)) { if (hi == 0) al_l[r32] = (a); asm volatile("s_waitcnt lgkmcnt(0)" ::: "memory"); \
    _Pragma("unroll") for (int d = 0; d < 4; ++d) _Pragma("unroll") for (int r = 0; r < 16; ++r) o[d][r] *= al_l[crow(r, hi)]; } } while (0)
    f32x16 pA0, pA1, pB0, pB1; float mnA, mnB, alA, alB; bf16x8 pa0, pa1, pa2, pa3; const int NTL = SEQ / AT_KVBLK;
    constexpr int SE = 0, SO = 1;
    SLOAD(SE, 0); asm volatile("s_waitcnt vmcnt(0)" ::: "memory"); SWRITE(0, SE); __syncthreads();
    qkt64(pA0, pA1, K_lds, qr, r32, hi); partialSM(pA0, pA1, m_reg, mnA, alA);
    SLOAD(SO, AT_KVBLK); SLOAD(SE, 2 * AT_KVBLK);
    SWAIT(); SWRITE(1, SO); __syncthreads();
#pragma unroll 1
    for (int j = 1; j + 1 < NTL; j += 2) {
        SBAR(); qkt64(pB0, pB1, K_lds + AT_SHM_K, qr, r32, hi);
        finishSM(pA0, pA1, alA, l_reg, pa0, pa1, pa2, pa3); SBAR();
        SLOAD(SO, (j + 2) * AT_KVBLK); SBAR();
        pv_d0(o, vb0, pa0, pa1, pa2, pa3); partialSM(pB0, pB1, m_reg, mnB, alB);
        __syncthreads(); SWAIT(); SWRITE(0, SE);
        RESC(alB); __syncthreads();
        SBAR(); qkt64(pA0, pA1, K_lds, qr, r32, hi);
        finishSM(pB0, pB1, alB, l_reg, pa0, pa1, pa2, pa3); SBAR();
        if (j + 3 < NTL) SLOAD(SE, (j + 3) * AT_KVBLK); SBAR();
        pv_d0(o, vb0 + AT_SHM_V, pa0, pa1, pa2, pa3); partialSM(pA0, pA1, m_reg, mnA, alA);
        __syncthreads(); SWAIT(); SWRITE(1, SO);
        RESC(alA); __syncthreads();
    }
    SBAR(); qkt64(pB0, pB1, K_lds + AT_SHM_K, qr, r32, hi);
    finishSM(pA0, pA1, alA, l_reg, pa0, pa1, pa2, pa3); SBAR();
    pv_d0(o, vb0, pa0, pa1, pa2, pa3); partialSM(pB0, pB1, m_reg, mnB, alB);
    __syncthreads(); RESC(alB);
    finishSM(pB0, pB1, alB, l_reg, pa0, pa1, pa2, pa3); SBAR();
    pv_d0(o, vb0 + AT_SHM_V, pa0, pa1, pa2, pa3);
    if (hi == 0) li_l[r32] = l_reg; asm volatile("s_waitcnt lgkmcnt(0)" ::: "memory");
#pragma unroll
    for (int r = 0; r < 16; ++r) { const float rl = __builtin_amdgcn_rcpf(li_l[crow(r, hi)]);
#pragma unroll
        for (int d0 = 0; d0 < 4; ++d0) o[d0][r] *= rl; }
#undef SLOAD
#undef SWRITE
#undef SWAIT
#undef RESC
}
__device__ __forceinline__ void ph_attn(const Params& P, char* lds) {
    const int tid = TIDX(), wid = tid >> 6, lane = tid & 63, r32 = lane & 31, hi = lane >> 5;
    float lam;
    { float d1 = P.lam_q1[lane] * P.lam_k1[lane], d2 = P.lam_q2[lane] * P.lam_k2[lane]; d1 = wave_sum(d1); d2 = wave_sum(d2); lam = expf(d1) - expf(d2) + 0.2f; }
#pragma unroll 1
    for (int u = blockIdx.x; u < NB * 8 * (SEQ / 256); u += gridDim.x) {
        const int slot = u >> 3, bh = (u & 7) * 4 + (slot >> 3), qblk = slot & 7, b = bh >> 3, h = bh & 7;
        const bf16_t* base = P.proj + (size_t)(b * SEQ) * INW;
        const bf16_t* Qb = base + (size_t)(qblk * 256) * INW + OFF_Q + h * 128;
        const bf16_t* Kh = base + OFF_K + h * 128;
        const bf16_t* Vh = base + OFF_V + h * 128;
        f32x16 o[4];
        attn_pass(Qb, Kh, Vh, lds, o);
        unsigned* park = (unsigned*)(lds + 2 * AT_SHM_V + 2 * AT_SHM_K + 2048) + wid * 2048 + lane;
#pragma unroll
        for (int d0 = 0; d0 < 4; ++d0)
#pragma unroll
            for (int i = 0; i < 8; ++i) park[(d0 * 8 + i) * 64] = cvt_pk_bf16(o[d0][2 * i], o[d0][2 * i + 1]);
        attn_pass(Qb + 64, Kh + 64, Vh, lds, o);
        unsigned o1p[4][8];
#pragma unroll
        for (int d0 = 0; d0 < 4; ++d0)
#pragma unroll
            for (int i = 0; i < 8; ++i) o1p[d0][i] = park[(d0 * 8 + i) * 64];
        float ss[16];
#pragma unroll
        for (int r = 0; r < 16; ++r) { float s = 0.f;
#pragma unroll
            for (int d0 = 0; d0 < 4; ++d0) { const float o1 = (r & 1) ? bfhi(o1p[d0][r >> 1]) : bflo(o1p[d0][r >> 1]); const float v = o1 - lam * o[d0][r]; o[d0][r] = v; s += v * v; }
            ss[r] = s; }
        const int ln_ = olane();
#pragma unroll
        for (int r = 0; r < 16; ++r) { float s = ss[r]; s += shx(s, ln_, 1); s += shx(s, ln_, 2); s += shx(s, ln_, 4); s += shx(s, ln_, 8); s += shx(s, ln_, 16);
            ss[r] = rsqrtf(s * (1.f / 128.f) + EPS) * 0.8f; }
        int opq = 0; asm volatile("" : "+v"(opq));
        bf16_t* mo = P.mix + (size_t)(b * SEQ + qblk * 256 + wid * 32 + 4 * hi + opq) * DM + 1024 + h * 128 + r32;
#pragma unroll
        for (int d0 = 0; d0 < 4; ++d0) { const float g = P.subln_g[d0 * 32 + r32 + opq];
#pragma unroll
            for (int r = 0; r < 16; ++r) mo[(size_t)((r & 3) + 8 * (r >> 2)) * DM + d0 * 32] = f2bf(o[d0][r] * ss[r] * g); }
        __syncthreads();
    }
}

struct EpiOutProjF {
    static constexpr bool PERM = false, AFTER_DRAIN = false;
    const float* x; float* h1;
    __device__ __forceinline__ void operator()(const f32x4 (&acc)[2][2][4][2], const pg8::Unit& u, int wr, int wc, int fr, int fq) const {
        const int row0 = u.pm * 256 + wr * 64 + fr, col0 = u.pn * 256 + wc * 32 + 4 * fq;
#pragma unroll
        for (int ai = 0; ai < 2; ++ai)
#pragma unroll
            for (int m = 0; m < 4; ++m) { const size_t ro = (size_t)(row0 + ai * 128 + m * 16) * DM + col0;
#pragma unroll
                for (int bj = 0; bj < 2; ++bj)
#pragma unroll
                    for (int n = 0; n < 2; ++n) { const size_t o = ro + bj * 128 + n * 16; *(f32x4*)(h1 + o) = *(const f32x4*)(x + o) + acc[ai][bj][m][n]; } }
    }
};
__device__ __forceinline__ void ph_outproj(const Params& P, char* smem) {
    pg8::Gemm g{P.mix, P.w_out_t, T_TOK, DM, DM};
    pg8::StaticOrder S; S.init(T_TOK, DM, gridDim.x, blockIdx.x);
    EpiOutProjF E{P.x, P.h1};
    pg8::gemm_phase<EpiOutProjF, pg8::StaticOrder>((PG8_LAS unsigned char*)smem, g, S, E, nullptr);
    __syncthreads();
}

__device__ __forceinline__ void ph_wcat(const Params& P) {
    for (int i = blockIdx.x * NT + TIDX(); i < DM * 96; i += gridDim.x * NT) { const int k = i / 96, j = i - k * 96;
        const float w = (j < 64) ? P.w_re[(size_t)k * 64 + j] : ((j < 72) ? P.w_rg[(size_t)k * 8 + (j - 64)] : 0.f);
        P.wcat[i] = w * P.norm_ffn_g[k]; }
}
__device__ __forceinline__ void ph_router(const Params& P, char* smem) {
    const int tid = TIDX(), wid = __builtin_amdgcn_readfirstlane(tid >> 6), lane = tid & 63, r32 = lane & 31, hi = lane >> 5;
    float* part = (float*)smem;
    float* ssp = (float*)(smem + 98304);
    float* logit = (float*)(smem + 98304 + 2048);
    float* rinv_s = (float*)(smem + 98304 + 2048 + 32 * 97 * 4);
#pragma unroll 1
    for (int u = blockIdx.x; u < T_TOK / 32; u += gridDim.x) {
        const int t0 = u * 32;
        f32x16 acc0 = f32x16{}, acc1 = f32x16{}, acc2 = f32x16{};
        float ss = 0.f;
        const float* ap = P.h1 + (size_t)(t0 + r32) * DM + wid * 256;
        const float* wp = P.wcat + (size_t)(wid * 256 + hi) * 96 + r32;
#pragma unroll 4
        for (int s = 0; s < 64; ++s) {
            const f32x4 a4 = *(const f32x4*)(ap + 4 * s);
            ss += a4[0] * a4[0] + a4[1] * a4[1] + a4[2] * a4[2] + a4[3] * a4[3];
            const float* w0 = wp + (size_t)(4 * s) * 96; const float* w1 = w0 + 2 * 96;
            const float aA = hi ? a4[1] : a4[0], aB = hi ? a4[3] : a4[2];
            acc0 = __builtin_amdgcn_mfma_f32_32x32x2f32(aA, w0[0], acc0, 0, 0, 0);
            acc1 = __builtin_amdgcn_mfma_f32_32x32x2f32(aA, w0[32], acc1, 0, 0, 0);
            acc2 = __builtin_amdgcn_mfma_f32_32x32x2f32(aA, w0[64], acc2, 0, 0, 0);
            acc0 = __builtin_amdgcn_mfma_f32_32x32x2f32(aB, w1[0], acc0, 0, 0, 0);
            acc1 = __builtin_amdgcn_mfma_f32_32x32x2f32(aB, w1[32], acc1, 0, 0, 0);
            acc2 = __builtin_amdgcn_mfma_f32_32x32x2f32(aB, w1[64], acc2, 0, 0, 0);
        }
        __syncthreads();
#pragma unroll
        for (int r = 0; r < 16; ++r) { part[((wid * 3 + 0) * 16 + r) * 64 + lane] = acc0[r]; part[((wid * 3 + 1) * 16 + r) * 64 + lane] = acc1[r]; part[((wid * 3 + 2) * 16 + r) * 64 + lane] = acc2[r]; }
        ssp[wid * 64 + lane] = ss;
        __syncthreads();
        for (int o = tid; o < 3 * 16 * 64; o += NT) {
            float s = 0.f;
#pragma unroll
            for (int w = 0; w < 8; ++w) s += part[w * 3072 + o];
            const int l = o & 63, r = (o >> 6) & 15, nt = o >> 10;
            logit[crow(r, l >> 5) * 97 + 32 * nt + (l & 31)] = s;
        }
        if (tid < 32) { float s = 0.f;
#pragma unroll
            for (int w = 0; w < 8; ++w) s += ssp[w * 64 + tid] + ssp[w * 64 + 32 + tid];
            rinv_s[tid] = rsqrtf(s * (0.5f / DM) + EPS); }
        __syncthreads();
        if (tid < 32) {
            const int t = t0 + tid; const float rv = rinv_s[tid]; const float* lg = logit + tid * 97;
            float gl[8]; int gs = 0; float gm = -INFINITY;
#pragma unroll
            for (int i = 0; i < 8; ++i) { const float a = lg[64 + i] * rv + P.b_rg[i]; gl[i] = a; if (a > gm) { gm = a; gs = i; } }
            float den = 0.f;
#pragma unroll
            for (int i = 0; i < 8; ++i) den += expf(gl[i] - gm);
            const float p_g = 1.f / den;
            int i0 = 0, i1 = 0; float e0 = -INFINITY, e1 = -INFINITY;
#pragma unroll
            for (int i = 0; i < 8; ++i) { const float a = lg[gs * 8 + i] * rv + P.b_re[gs * 8 + i];
                if (a > e0) { e1 = e0; i1 = i0; e0 = a; i0 = i; } else if (a > e1) { e1 = a; i1 = i; } }
            const float x1 = expf(e1 - e0), w0 = 1.f / (1.f + x1), w1 = x1 / (1.f + x1);
            const int ex0 = gs * 8 + i0, ex1 = gs * 8 + i1;
            P.tok_e[t * 2] = ex0; P.tok_e[t * 2 + 1] = ex1; P.tok_w[t * 2] = p_g * w0; P.tok_w[t * 2 + 1] = p_g * w1;
            atomicAdd(&P.counts[ex0], 1); atomicAdd(&P.counts[ex1], 1);
        }
#pragma unroll 1
        for (int q = 0; q < 4; ++q) { const int ti = wid * 4 + q; const float rv = rinv_s[ti]; const float* hr = P.h1 + (size_t)(t0 + ti) * DM;
#pragma unroll
            for (int i = 0; i < 8; ++i) { const int c = (i * 64 + lane) * 4; const f32x4 v = *(const f32x4*)(hr + c), g = *(const f32x4*)(P.norm_ffn_g + c);
                u32x2 o; o[0] = cvt_pk_bf16(v[0] * rv * g[0], v[1] * rv * g[1]); o[1] = cvt_pk_bf16(v[2] * rv * g[2], v[3] * rv * g[3]);
                *(u32x2*)(P.hn + (size_t)(t0 + ti) * DM + c) = o; } }
        __syncthreads();
    }
}
__device__ __forceinline__ void moe_starts(const Params& P, int* sst) {
    __syncthreads();
    if (TIDX() < 64) { const int lane = TIDX(); const int c = __hip_atomic_load(&P.counts[lane], __ATOMIC_RELAXED, __HIP_MEMORY_SCOPE_AGENT);
        const int p = ((c + 127) >> 7) << 7; int incl = p;
#pragma unroll
        for (int o = 1; o < 64; o <<= 1) { const int v = __shfl_up(incl, o); if (lane >= o) incl += v; }
        sst[lane] = incl - p; if (lane == 63) sst[NEXP] = incl; }
    __syncthreads();
}
__device__ __forceinline__ void ph_moe_scatter(const Params& P, char* smem) {
    int* sst = (int*)smem; int* lcount = (int*)(smem + 512); int* lbase = (int*)(smem + 1024); moe_starts(P, sst);
    const int tid = TIDX();
    for (int a0 = blockIdx.x * 128; a0 < T_TOK * 2; a0 += gridDim.x * 128) {
        const int a = a0 + tid; const bool valid = (tid < 128) && (a < T_TOK * 2);
        __syncthreads();
        if (tid < NEXP) lcount[tid] = 0;
        __syncthreads();
        const int e = valid ? P.tok_e[a] : 0;
        const int rank = valid ? atomicAdd(&lcount[e], 1) : 0;
        __syncthreads();
        if (tid < NEXP) { const int c = lcount[tid]; lbase[tid] = c ? atomicAdd(&P.cursor[tid], c) : 0; }
        __syncthreads();
        if (valid) { const int pos = sst[e] + lbase[e] + rank; P.row_tok[pos] = a >> 1; P.row_slot[pos] = a; P.row_w[pos] = P.tok_w[a]; }
    }
}
#define MG_B 49152
__device__ __forceinline__ int a_swz(int rh) { rh &= 3; return (((rh ^ (rh >> 1)) & 1) << 1) | (rh >> 1); }
template <int NRB> struct MoeALoad {
    const bf16_t* base; unsigned off[NRB][2]; u32x4 r[NRB]; unsigned aw;
    __device__ __forceinline__ void init(char* smem, const bf16_t* b, size_t ld_, int row0, const int* gather, int zrow) { base = b; (void)smem;
        const int tid = TIDX(); { const int row = tid >> 3, kc = tid & 7, kh = kc >> 2, kq = kc & 3; aw = (unsigned)((kh * 128 + row) * 64 + ((kq ^ a_swz(row >> 2)) * 16)); }
#pragma unroll
        for (int rb = 0; rb < NRB; ++rb)
#pragma unroll
            for (int i = 0; i < 2; ++i) { const int c = tid + i * NT, row = row0 + rb * 128 + (c >> 3); const int t = gather ? gather[row] : row;
                off[rb][i] = (unsigned)((t >= 0) ? t : zrow) * (unsigned)(ld_ * 2) + (unsigned)((c & 7) * 16); } }
    __device__ __forceinline__ void fetch1(int rb, int i, int kt) { r[rb] = *(const u32x4*)((const char*)base + (size_t)kt * 128 + off[rb][i]); }
    __device__ __forceinline__ void commit1(int rb, int i, char* lds) { *(u32x4*)(lds + rb * 16384 + i * 4096 + aw) = r[rb]; }
    __device__ __forceinline__ void fetch_half(int i, int kt) {
#pragma unroll
        for (int rb = 0; rb < NRB; ++rb) fetch1(rb, i, kt);
    }
    __device__ __forceinline__ void commit_half(int i, char* lds) {
#pragma unroll
        for (int rb = 0; rb < NRB; ++rb) commit1(rb, i, lds);
    }
};
template <bool GU> struct MoeBLoadT {
    const float* ub[2]; unsigned ldb, voff, bw[2];
    __device__ __forceinline__ void init(const float* b0_, const float* b1_, unsigned ld_) { const unsigned tid = (unsigned)TIDX(); ub[0] = b0_; ub[1] = b1_; ldb = ld_ * 4;
        if (GU) { const unsigned k0 = tid >> 4, ffl4 = (tid & 15) * 4; voff = k0 * ldb + ffl4 * 4;
#pragma unroll
            for (int mat = 0; mat < 2; ++mat) { const unsigned n4 = (ffl4 >> 4) * 32 + mat * 16 + (ffl4 & 15); bw[mat] = off_b(k0, n4 >> 3) + (n4 & 4) * 2; } }
        else { const unsigned k0 = tid >> 5, n4 = (tid & 31) * 4; voff = k0 * ldb + n4 * 4; bw[0] = bw[1] = off_b(k0, n4 >> 3) + (n4 & 4) * 2; } }
    __device__ __forceinline__ void fetch1(f32x4 (&r)[4], int i, int kt) const {
        const char* b = (const char*)(GU ? ub[i >> 1] : ub[0]) + (size_t)((unsigned)kt * 64u + (GU ? (unsigned)(i & 1) * 32u : (unsigned)i * 16u)) * ldb;
        r[i] = __builtin_nontemporal_load((const f32x4*)(b + voff)); }
    __device__ __forceinline__ void commit1(const f32x4 (&r)[4], int i, char* bimg) const { u32x2 v; v[0] = cvt_pk_bf16(r[i][0], r[i][1]); v[1] = cvt_pk_bf16(r[i][2], r[i][3]);
        *(u32x2*)(bimg + (GU ? (i & 1) * 8192 : i * 4096) + (GU ? bw[i >> 1] : bw[0])) = v; }
    __device__ __forceinline__ void fetch(f32x4 (&r)[4], int kt) const {
#pragma unroll
        for (int i = 0; i < 4; ++i) fetch1(r, i, kt);
    }
    __device__ __forceinline__ void commit(const f32x4 (&r)[4], char* bimg) const {
#pragma unroll
        for (int i = 0; i < 4; ++i) commit1(r, i, bimg);
    }
};
typedef LAS s16x4 lds_s16x4_t;
__device__ __forceinline__ s16x4 trb(unsigned addr) { return __builtin_amdgcn_ds_read_tr16_b64_v4i16((lds_s16x4_t*)addr); }
template <int NK, int NRB, class BL, class EP>
__device__ __forceinline__ void moe_gemm_unit(char* smem, MoeALoad<NRB>& al, const BL& bl, const EP& ep) {
    const int tid = TIDX(), wid = __builtin_amdgcn_readfirstlane(tid >> 6), lane = tid & 63, wr = wid >> 2, wc = wid & 3, fr = lane & 15, fq = lane >> 4;
    const unsigned lbase = (unsigned)(uintptr_t)smem + MG_B;
    const unsigned tq = (lane & 15) >> 2, tp = lane & 3;
    f32x4 acc[3][4][2];
#pragma unroll
    for (int rb = 0; rb < 3; ++rb)
#pragma unroll
        for (int m = 0; m < 4; ++m)
#pragma unroll
            for (int n = 0; n < 2; ++n) acc[rb][m][n] = (f32x4){0.f, 0.f, 0.f, 0.f};
    f32x4 b0[4], b1[4];
    bl.fetch(b0, 0); bl.fetch(b1, 1); al.fetch_half(0, 0);
    const unsigned tb00 = lbase + off_b(8 * fq + tq, 2 * (2 * wc) + (tp >> 1)) + 8 * (tp & 1), tb01 = lbase + off_b(8 * fq + 4 + tq, 2 * (2 * wc) + (tp >> 1)) + 8 * (tp & 1);
    const unsigned tb10 = lbase + off_b(8 * fq + tq, 2 * (2 * wc + 1) + (tp >> 1)) + 8 * (tp & 1), tb11 = lbase + off_b(8 * fq + 4 + tq, 2 * (2 * wc + 1) + (tp >> 1)) + 8 * (tp & 1);
    const char* ard = smem + (wr * 64 + fr) * 64 + ((fq ^ a_swz(fr >> 2)) * 16);
    __syncthreads();
    al.commit_half(0, smem); al.fetch_half(1, 0); bl.commit(b0, smem + MG_B); bl.fetch1(b0, 0, 2 < NK ? 2 : NK - 1); bl.fetch1(b0, 1, 2 < NK ? 2 : NK - 1); al.commit_half(1, smem);
    __builtin_amdgcn_sched_barrier(0);
    al.fetch_half(0, 1 < NK ? 1 : NK - 1); __builtin_amdgcn_sched_barrier(0); bl.fetch1(b0, 2, 2 < NK ? 2 : NK - 1); bl.fetch1(b0, 3, 2 < NK ? 2 : NK - 1); __builtin_amdgcn_sched_barrier(0);
    __syncthreads();
#define MG_BF(BUF, KH) do { const s16x4 t00 = trb(tb00 + (BUF) * 65536 + (KH) * 8192), t01 = trb(tb01 + (BUF) * 65536 + (KH) * 8192), t10 = trb(tb10 + (BUF) * 65536 + (KH) * 8192), t11 = trb(tb11 + (BUF) * 65536 + (KH) * 8192); \
        bfr[KH][0] = (bf16x8){t00[0], t00[1], t00[2], t00[3], t01[0], t01[1], t01[2], t01[3]}; bfr[KH][1] = (bf16x8){t10[0], t10[1], t10[2], t10[3], t11[0], t11[1], t11[2], t11[3]}; } while (0)
#define MG_AR(BUF, SET, KH, RB, MH) do { _Pragma("unroll") for (int m_ = 0; m_ < 2; ++m_) a[SET][m_] = *(const bf16x8*)(ard + (BUF) * 65536 + (RB) * 16384 + (KH) * 8192 + ((MH) * 2 + m_) * 1024); } while (0)
#define MG_STEP(BUF, BS, KT1, KT2, KTB) do { constexpr int NH = 4 * NRB, NP = 2 * NRB + 4, NS = 2 * NH, HP = NRB + 2; char* stg = smem + (1 - (BUF)) * 65536; const int kt1_ = (KT1), kt2_ = (KT2), ktb_ = (KTB); \
        bf16x8 a[2][2], bfr[2][2]; MG_BF(BUF, 0); MG_AR(BUF, 0, 0, 0, 0); \
        _Pragma("unroll") for (int h = 0; h < NH; ++h) { const int kh = h / (2 * NRB), rb = (h >> 1) % NRB, mh = h & 1, cur = h & 1; \
            if (h + 1 < NH) { const int kh1 = (h + 1) / (2 * NRB), rb1 = ((h + 1) >> 1) % NRB, mh1 = (h + 1) & 1; if (h + 1 == 2 * NRB) MG_BF(BUF, 1); MG_AR(BUF, cur ^ 1, kh1, rb1, mh1); } \
            __builtin_amdgcn_sched_barrier(0); \
            _Pragma("unroll") for (int mi = 0; mi < 2; ++mi) { const int m = mh * 2 + mi, s = h * 2 + mi; \
                acc[rb][m][0] = __builtin_amdgcn_mfma_f32_16x16x32_bf16(a[cur][mi], bfr[kh][0], acc[rb][m][0], 0, 0, 0); \
                acc[rb][m][1] = __builtin_amdgcn_mfma_f32_16x16x32_bf16(a[cur][mi], bfr[kh][1], acc[rb][m][1], 0, 0, 0); \
                __builtin_amdgcn_sched_barrier(0); \
                _Pragma("unroll") for (int q = 0; q < NP; ++q) if (q * NS / NP == s) { const int hf = q / HP, qq = q % HP; \
                    if (qq < NRB) { al.commit1(qq, hf, stg); al.fetch1(qq, hf ^ 1, hf ? kt2_ : kt1_); } \
                    else { bl.commit1(BS, hf * 2 + qq - NRB, stg + MG_B); bl.fetch1(BS, hf * 2 + qq - NRB, ktb_); } \
                    __builtin_amdgcn_sched_barrier(0); } } } } while (0)
#pragma unroll 1
    for (int kt = 0; kt < NK; kt += 2) {
        MG_STEP(0, b1, kt + 1 < NK ? kt + 1 : NK - 1, kt + 2 < NK ? kt + 2 : NK - 1, kt + 3 < NK ? kt + 3 : NK - 1);
        __syncthreads();
        MG_STEP(1, b0, kt + 2 < NK ? kt + 2 : NK - 1, kt + 3 < NK ? kt + 3 : NK - 1, kt + 4 < NK ? kt + 4 : NK - 1);
        __syncthreads();
    }
#undef MG_STEP
#undef MG_AR
#undef MG_BF
    ep(acc, NRB, wr, wc, fr, fq);
    __syncthreads();
}
template <int NK, class BL, class EP>
__device__ __forceinline__ void moe_gemm_dispatch(char* smem, int nrb, const bf16_t* abase, size_t ald, int row0, const int* gather, int zrow, const BL& bl, const EP& ep) {
    if (nrb == 3)      { MoeALoad<3> al; al.init(smem, abase, ald, row0, gather, zrow); moe_gemm_unit<NK, 3>(smem, al, bl, ep); }
    else if (nrb == 2) { MoeALoad<2> al; al.init(smem, abase, ald, row0, gather, zrow); moe_gemm_unit<NK, 2>(smem, al, bl, ep); }
    else               { MoeALoad<1> al; al.init(smem, abase, ald, row0, gather, zrow); moe_gemm_unit<NK, 1>(smem, al, bl, ep); }
}
struct EpiMoeGU { bf16_t* act; int row0, ff0;
    __device__ __forceinline__ void operator()(const f32x4 (&acc)[3][4][2], int nrb, int wr, int wc, int fr, int fq) const {
#pragma unroll
        for (int rb = 0; rb < 3; ++rb) if (rb < nrb) {
#pragma unroll
            for (int m = 0; m < 4; ++m)
#pragma unroll
                for (int j = 0; j < 4; ++j) { const int row = row0 + rb * 128 + wr * 64 + m * 16 + fq * 4 + j, ff = ff0 + wc * 16 + fr;
                    const float g = acc[rb][m][0][j], u = acc[rb][m][1][j]; act[(size_t)row * EFF + ff] = f2bf(g / (1.f + __expf(-g)) * u); } }
    }
};
__device__ __forceinline__ void ph_moe_gu(const Params& P, char* smem) {
    int* sst = (int*)(smem + 131072); moe_starts(P, sst);
    const int i = blockIdx.x, x = i & 7, slot = i >> 3;
#pragma unroll 1
    for (int rnd = 0; rnd * (int)gridDim.x < NEXP * 8; ++rnd) {
        int e, nt;
        if (gridDim.x == 256) { e = rnd * 32 + x * 4 + (slot >> 3); nt = slot & 7; } else { const int u = rnd * gridDim.x + i; e = u >> 3; nt = u & 7; }
        if (e >= NEXP) break;
        const int r_lo = sst[e], nrb_tot = (sst[e + 1] - r_lo) >> 7;
        MoeBLoadT<true> bl; bl.init(P.w_eg + (size_t)e * DM * EFF + nt * 64, P.w_eu + (size_t)e * DM * EFF + nt * 64, EFF);
#pragma unroll 1
        for (int rbp = 0; rbp < nrb_tot; rbp += 3) { const int nrb = (nrb_tot - rbp) < 3 ? (nrb_tot - rbp) : 3;
            EpiMoeGU ep{P.act, r_lo + rbp * 128, nt * 64};
            moe_gemm_dispatch<DM / 64>(smem, nrb, P.hn, DM, r_lo + rbp * 128, P.row_tok, T_TOK, bl, ep); }
    }
}
struct EpiMoeDown { bf16_t* ymoe; const int* s_slot; const float* s_w; int col0; char* lds;
    __device__ __forceinline__ void operator()(const f32x4 (&acc)[3][4][2], int nrb, int wr, int wc, int fr, int fq) const {
        const int lane = fq * 16 + fr, wid = wr * 4 + wc; char* patch = lds + wid * 5120;
#pragma unroll
        for (int rb = 0; rb < 3; ++rb) if (rb < nrb) {
#pragma unroll
            for (int m = 0; m < 4; ++m)
#pragma unroll
                for (int j = 0; j < 4; ++j) { const int r = m * 16 + fq * 4 + j; const float w = s_w[rb * 128 + wr * 64 + r];
#pragma unroll
                    for (int n = 0; n < 2; ++n) *(bf16_t*)(patch + r * 80 + (n * 16 + fr) * 2) = f2bf(acc[rb][m][n][j] * w); }
#pragma unroll
            for (int it = 0; it < 4; ++it) { const int r = it * 16 + (lane >> 2), c = lane & 3; const int sl = s_slot[rb * 128 + wr * 64 + r];
                const u32x4 v = *(const u32x4*)(patch + r * 80 + c * 16);
                if (sl >= 0) *(u32x4*)(ymoe + (size_t)sl * DM + col0 + wc * 32 + c * 8) = v; }
        }
    }
};
__device__ __forceinline__ void ph_moe_down(const Params& P, char* smem) {
    int* sst = (int*)(smem + 131072); moe_starts(P, sst);
    const int i = blockIdx.x, x = i & 7, slot = i >> 3;
#pragma unroll 1
    for (int rnd = 0; rnd * (int)gridDim.x < NEXP * 16; ++rnd) {
        int e, ct;
        if (gridDim.x == 256) { e = rnd * 16 + x * 2 + (slot >> 4); ct = slot & 15; } else { const int u = rnd * gridDim.x + i; e = u >> 4; ct = u & 15; }
        if (e >= NEXP) break;
        const int r_lo = sst[e], nrb_tot = (sst[e + 1] - r_lo) >> 7;
        MoeBLoadT<false> bl; { const float* b = P.w_ed + (size_t)e * EFF * DM + ct * 128; bl.init(b, b, DM); }
#pragma unroll 1
        for (int rbp = 0; rbp < nrb_tot; rbp += 3) { const int nrb = (nrb_tot - rbp) < 3 ? (nrb_tot - rbp) : 3;
            int* s_slot = (int*)(smem + 145408); float* s_w = (float*)(smem + 145408 + 1536);
            __syncthreads();
            if (TIDX() < 384) { const int rl = TIDX(); int row = r_lo + rbp * 128 + rl; row = row < MAXROWS ? row : MAXROWS - 1;
                const bool ok = (rl < nrb * 128) && (P.row_tok[row] >= 0); s_slot[rl] = ok ? P.row_slot[row] : -1; s_w[rl] = ok ? P.row_w[row] : 0.f; }
            EpiMoeDown ep{P.ymoe, s_slot, s_w, ct * 128, smem};
            moe_gemm_dispatch<EFF / 64>(smem, nrb, P.act, EFF, r_lo + rbp * 128, nullptr, MAXROWS, bl, ep); }
    }
}
__device__ __forceinline__ void ph_combine(const Params& P) {
    const int lane = TIDX() & 63, w = TIDX() >> 6;
    for (int t = blockIdx.x * (NT / 64) + w; t < T_TOK; t += gridDim.x * (NT / 64)) {
        const float* hr = P.h1 + (size_t)t * DM;
#pragma unroll
        for (int i = 0; i < 8; ++i) { const int c = (i * 64 + lane) * 4;
            f32x4 v = *(const f32x4*)(hr + c);
            const u32x2 a = *(const u32x2*)(P.ymoe + (size_t)(2 * t) * DM + c), b = *(const u32x2*)(P.ymoe + (size_t)(2 * t + 1) * DM + c);
            v[0] += bflo(a[0]) + bflo(b[0]); v[1] += bfhi(a[0]) + bfhi(b[0]); v[2] += bflo(a[1]) + bflo(b[1]); v[3] += bfhi(a[1]) + bfhi(b[1]);
            u32x2 o; o[0] = cvt_pk_bf16(v[0], v[1]); o[1] = cvt_pk_bf16(v[2], v[3]);
            *(u32x2*)(P.h2b + (size_t)t * DM + c) = o; }
    }
}
struct EpiPP { bf16_t* pp; float* prss; int row0, col0;
    __device__ __forceinline__ void operator()(const f32x4 (&acc)[4][2], int wr, int wc, int fr, int fq) const {
        const int ln_ = olane();
#pragma unroll
        for (int m = 0; m < 4; ++m)
#pragma unroll
            for (int j = 0; j < 4; ++j) { const int row = row0 + wr * 64 + m * 16 + fq * 4 + j; float s = 0.f;
#pragma unroll
                for (int n = 0; n < 2; ++n) { const float v = acc[m][n][j]; s += v * v; pp[(size_t)row * DM + col0 + wc * 32 + n * 16 + fr] = f2bf(v); }
                s += shx(s, ln_, 1); s += shx(s, ln_, 2); s += shx(s, ln_, 4); s += shx(s, ln_, 8);
                if (fr == 0) atomicAdd(prss + row, s); }
    }
};
__device__ __forceinline__ void ph_pleproj(const Params& P, char* smem) {
    const int ntn = DM / 128, ntm = T_TOK / 128;
    for (int u = blockIdx.x; u < ntn * ntm; u += gridDim.x) {
        const int tn = u % ntn, tm = u / ntn;
        LoadF32Rows al; al.init(P.p, 256, tm * 128); LoadBf16 bl; bl.init(P.w_pp_t, 256, tn * 128, nullptr);
        EpiPP ep{P.pp, P.prss, tm * 128, tn * 128};
        gemm128(smem, 256 / 64, al, bl, ep);
    }
}
struct EpiGateF {
    static constexpr bool PERM = false, AFTER_DRAIN = false;
    const bf16_t* h2; const bf16_t* pp; const float* prss; const float* ple_g; const float* b_pg; bf16_t* out;
    __device__ __forceinline__ void operator()(const f32x4 (&acc)[2][2][4][2], const pg8::Unit& u, int wr, int wc, int fr, int fq) const {
        const int row0 = u.pm * 256 + wr * 64 + fr, col0 = u.pn * 256 + wc * 32 + 4 * fq;
#pragma unroll
        for (int ai = 0; ai < 2; ++ai)
#pragma unroll
            for (int m = 0; m < 4; ++m) { const int row = row0 + ai * 128 + m * 16; const size_t ro = (size_t)row * DM + col0; const float pr = rsqrtf(prss[row] * (1.f / DM) + EPS);
#pragma unroll
                for (int bj = 0; bj < 2; ++bj)
#pragma unroll
                    for (int n = 0; n < 2; ++n) { const int c = col0 + bj * 128 + n * 16; const size_t o = ro + bj * 128 + n * 16;
                        const f32x4 z = acc[ai][bj][m][n] + *(const f32x4*)(b_pg + c); const u32x2 pq = *(const u32x2*)(pp + o); const f32x4 pl = (f32x4){bflo(pq[0]), bfhi(pq[0]), bflo(pq[1]), bfhi(pq[1])} * pr * *(const f32x4*)(ple_g + c); const u32x2 hq = *(const u32x2*)(h2 + o); const f32x4 hv = (f32x4){bflo(hq[0]), bfhi(hq[0]), bflo(hq[1]), bfhi(hq[1])};
                        f32x4 r;
#pragma unroll
                        for (int j = 0; j < 4; ++j) r[j] = hv[j] + pl[j] / (1.f + __expf(-z[j]));
                        u32x2 ov; ov[0] = cvt_pk_bf16(r[0], r[1]); ov[1] = cvt_pk_bf16(r[2], r[3]); *(u32x2*)(out + o) = ov; } }
    }
};
__device__ __forceinline__ void ph_plegate(const Params& P, char* smem) {
    pg8::Gemm g{P.h2b, P.w_pg_t, T_TOK, DM, DM};
    pg8::StaticOrder S; S.init(T_TOK, DM, gridDim.x, blockIdx.x);
    EpiGateF E{P.h2b, P.pp, P.prss, P.ple_g, P.b_pg, P.h3b};
    pg8::gemm_phase<EpiGateF, pg8::StaticOrder>((PG8_LAS unsigned char*)smem, g, S, E, nullptr);
    __syncthreads();
}
__device__ __forceinline__ void ph_final(const Params& P) {
    const int lane = TIDX() & 63, w = TIDX() >> 6;
    for (int t = blockIdx.x * (NT / 64) + w; t < T_TOK; t += gridDim.x * (NT / 64)) {
        f32x4 v[8]; float ss = 0.f;
#pragma unroll
        for (int i = 0; i < 8; ++i) { const u32x2 q = *(const u32x2*)(P.h3b + (size_t)t * DM + (i * 64 + lane) * 4); v[i] = (f32x4){bflo(q[0]), bfhi(q[0]), bflo(q[1]), bfhi(q[1])};
            ss += v[i][0] * v[i][0] + v[i][1] * v[i][1] + v[i][2] * v[i][2] + v[i][3] * v[i][3]; }
        const float rr = rsqrtf(wave_sum(ss) * (1.f / DM) + EPS);
        float* r = P.out + (size_t)t * DM;
#pragma unroll
        for (int i = 0; i < 8; ++i) { const f32x4 g = *(const f32x4*)(P.final_g + (i * 64 + lane) * 4); *(f32x4*)(r + (i * 64 + lane) * 4) = v[i] * rr * g; }
    }
}

#define LDS_BYTES 148736
#define PARAM_OFF 144000
#define NPW ((int)(sizeof(Params) / 4))
typedef __attribute__((address_space(1))) char gchar_t;
__device__ __forceinline__ Params params_from_lds(const LAS unsigned* src) {
    Params P; void** a = (void**)&P;
#pragma unroll
    for (int i = 0; i < NPW / 2; ++i) { const unsigned lo = (unsigned)__builtin_amdgcn_readfirstlane((int)src[2 * i]), hi = (unsigned)__builtin_amdgcn_readfirstlane((int)src[2 * i + 1]);
        a[i] = (void*)(gchar_t*)(((unsigned long long)hi << 32) | lo); }
    return P;
}
#define GRID_SYNC() do { xcd_barrier(bar); asm volatile("" ::: "memory"); } while (0)
__global__ void __launch_bounds__(NT, 2) hymba_fwd(Params Pk) {
    extern __shared__ __attribute__((aligned(16))) char smem_raw[];
    char* smem = smem_raw + 16;
    LAS unsigned* pl = (LAS unsigned*)(smem_raw + PARAM_OFF);
    if (TIDX() == 0) { *(uint4*)smem_raw = make_uint4(0u, 0u, 0u, 0u);
        const unsigned* s = (const unsigned*)&Pk;
#pragma unroll
        for (int i = 0; i < NPW; ++i) pl[i] = s[i]; }
    __syncthreads();
    XcdBarrier bar = xcd_barrier_post(Pk.bar, (volatile LAS unsigned*)smem_raw);
    {
        const Params P = params_from_lds(pl);
        ph_wt(smem, P.w_in, P.w_in_t, DM, INW, INW_PAD);
        ph_wt(smem, P.w_out, P.w_out_t, DM, DM, DM);
        ph_wt(smem, P.w_pg, P.w_pg_t, DM, DM, DM);
        ph_wt(smem, P.w_pp, P.w_pp_t, 256, DM, DM);
        ph_norm_x(P);
        ph_wcat(P);
        ph_rope_table(P);
        for (int i = blockIdx.x * NT + TIDX(); i < MAXROWS; i += gridDim.x * NT) { P.row_tok[i] = -1; P.row_slot[i] = 0; P.row_w[i] = 0.f; }
        for (int i = blockIdx.x * NT + TIDX(); i < T_TOK; i += gridDim.x * NT) P.prss[i] = 0.f;
        if (blockIdx.x == 0) for (int i = TIDX(); i < DM / 2; i += NT) ((unsigned*)(P.hn + (size_t)T_TOK * DM))[i] = 0u;
    }
    GRID_SYNC();
    { const Params P = params_from_lds(pl); ph_inproj(P, smem); }
    { const Params P = params_from_lds(pl); ph_pleproj(P, smem); }
    GRID_SYNC();
    { const Params P = params_from_lds(pl); ph_conv(P); }
    GRID_SYNC();
    { const Params P = params_from_lds(pl); ph_ssd(P, smem); }
    { const Params P = params_from_lds(pl); ph_attn(P, smem); }
    GRID_SYNC();
    { const Params P = params_from_lds(pl); ph_ssd_gate(P); }
    GRID_SYNC();
    { const Params P = params_from_lds(pl); ph_outproj(P, smem); }
    GRID_SYNC();
    { const Params P = params_from_lds(pl); ph_router(P, smem); }
    GRID_SYNC();
    { const Params P = params_from_lds(pl); ph_moe_scatter(P, smem); }
    GRID_SYNC();
    { const Params P = params_from_lds(pl); ph_moe_gu(P, smem); }
    GRID_SYNC();
    { const Params P = params_from_lds(pl); ph_moe_down(P, smem); }
    GRID_SYNC();
    { const Params P = params_from_lds(pl); ph_combine(P); }
    GRID_SYNC();
    { const Params P = params_from_lds(pl); ph_plegate(P, smem); }
    GRID_SYNC();
    { const Params P = params_from_lds(pl); ph_final(P); }
}

static inline size_t al256(size_t x) { return (x + 255) & ~(size_t)255; }

extern "C" void kernel_launch(void* const* d_in, const int* in_sizes, int n_in, void* d_out, int out_size, void* d_ws, size_t ws_size, hipStream_t stream) {
    Params P{};
    P.x = (const float*)d_in[0]; P.p = (const float*)d_in[1]; P.pos = (const int*)d_in[2]; P.norm_mix_g = (const float*)d_in[3]; P.w_in = (const float*)d_in[4];
    P.conv_w = (const float*)d_in[5]; P.conv_b = (const float*)d_in[6]; P.dt_bias_f = (const float*)d_in[7]; P.dt_bias_b = (const float*)d_in[8];
    P.a_log_f = (const float*)d_in[9]; P.a_log_b = (const float*)d_in[10]; P.d_skip = (const float*)d_in[11]; P.ssd_norm_g = (const float*)d_in[12];
    P.lam_q1 = (const float*)d_in[13]; P.lam_k1 = (const float*)d_in[14]; P.lam_q2 = (const float*)d_in[15]; P.lam_k2 = (const float*)d_in[16];
    P.subln_g = (const float*)d_in[17]; P.w_out = (const float*)d_in[18]; P.norm_ffn_g = (const float*)d_in[19]; P.w_rg = (const float*)d_in[20];
    P.b_rg = (const float*)d_in[21]; P.w_re = (const float*)d_in[22]; P.b_re = (const float*)d_in[23]; P.w_eg = (const float*)d_in[24];
    P.w_eu = (const float*)d_in[25]; P.w_ed = (const float*)d_in[26]; P.w_pp = (const float*)d_in[27]; P.ple_g = (const float*)d_in[28];
    P.w_pg = (const float*)d_in[29]; P.b_pg = (const float*)d_in[30]; P.final_g = (const float*)d_in[31];
    P.out = (float*)d_out;
    char* ws = (char*)d_ws; size_t o = 0;
    auto take = [&](size_t bytes) { char* r = ws + o; o = al256(o + bytes); return r; };
    P.bar = (unsigned*)take(16384);
    P.counts = (int*)(P.bar + 3584); P.cursor = (int*)(P.bar + 3584 + 128);
    P.w_in_t = (bf16_t*)take((size_t)INW_PAD * DM * 2); P.w_out_t = (bf16_t*)take((size_t)DM * DM * 2); P.w_pg_t = (bf16_t*)take((size_t)DM * DM * 2); P.w_pp_t = (bf16_t*)take((size_t)DM * 256 * 2);
    P.nbf = (bf16_t*)take((size_t)T_TOK * DM * 2); P.proj = (bf16_t*)take((size_t)T_TOK * INW * 2); P.dtv = (float*)take((size_t)T_TOK * 32 * 4);
    P.xbc = (bf16_t*)take((size_t)T_TOK * XBCW * 2); P.yf = (float*)take((size_t)T_TOK * SSDW * 4); P.yb = (float*)take((size_t)T_TOK * SSDW * 4);
    P.mix = (bf16_t*)take((size_t)T_TOK * DM * 2); P.h1 = (float*)take((size_t)T_TOK * DM * 4); P.hn = (bf16_t*)take((size_t)(T_TOK + 1) * DM * 2);
    P.tok_e = (int*)take((size_t)T_TOK * 2 * 4); P.tok_w = (float*)take((size_t)T_TOK * 2 * 4);
    P.row_tok = (int*)take((size_t)MAXROWS * 4); P.row_slot = (int*)take((size_t)MAXROWS * 4); P.row_w = (float*)take((size_t)MAXROWS * 4);
    P.act = (bf16_t*)take((size_t)MAXROWS * EFF * 2); P.ymoe = (bf16_t*)take((size_t)T_TOK * 2 * DM * 2); P.h2b = (bf16_t*)take((size_t)T_TOK * DM * 2);
    P.pp = (bf16_t*)take((size_t)T_TOK * DM * 2); P.prss = (float*)take((size_t)T_TOK * 4); P.wcat = (float*)take((size_t)DM * 96 * 4); P.rope = (float*)take((size_t)T_TOK * 16 * 4); P.h3b = (bf16_t*)take((size_t)T_TOK * DM * 2);
    (void)ws_size; (void)in_sizes; (void)n_in; (void)out_size;

    static int grid = 0;
    if (!grid) {
        int dev = 0, cus = 0, per_cu = 0;
        (void)hipGetDevice(&dev);
        (void)hipDeviceGetAttribute(&cus, hipDeviceAttributeMultiprocessorCount, dev);
        (void)hipFuncSetAttribute((const void*)hymba_fwd, hipFuncAttributeMaxDynamicSharedMemorySize, LDS_BYTES);
        (void)hipOccupancyMaxActiveBlocksPerMultiprocessor(&per_cu, hymba_fwd, NT, LDS_BYTES);
        if (cus <= 0) cus = 256;
        grid = cus * (per_cu < 1 ? 1 : 1);
    }
    (void)hipMemsetAsync(P.bar, 0, 16384, stream);
    hipLaunchKernelGGL(hymba_fwd, dim3(grid), dim3(NT), LDS_BYTES, stream, P);
}
```

```cpp
#include <hip/hip_runtime.h>
#include <stdint.h>

typedef unsigned short bf16_t;
typedef short bf16x8 __attribute__((ext_vector_type(8)));
typedef float f32x4 __attribute__((ext_vector_type(4)));
typedef unsigned u32x4 __attribute__((ext_vector_type(4)));
typedef unsigned u32x2 __attribute__((ext_vector_type(2)));

#define NT 512
#define T_TOK 8192
#define DM 2048
#define SEQ 2048
#define NB 4
#define INW 5664
#define INW_PAD 5888
#define OFF_Z 0
#define OFF_XBC 1024
#define OFF_DT 2560
#define OFF_Q 2592
#define OFF_K 3616
#define OFF_V 4640
#define XBCW 1536
#define SSDW 1024
#define NEXP 64
#define EFF 512
#define MAXROWS 24576
#define EPS 1e-6f

__device__ __forceinline__ int opq(int x) { asm volatile("" : "+v"(x)); return x; }
__device__ __forceinline__ int TIDX() { int t = (int)__builtin_amdgcn_workitem_id_x(); asm volatile("" : "+v"(t)); return t; }
typedef __bf16 bf16x2_t __attribute__((ext_vector_type(2)));
typedef float f32x2_t __attribute__((ext_vector_type(2)));
__device__ __forceinline__ unsigned cvt_pk_bf16(float lo, float hi) { const f32x2_t v = {lo, hi}; return __builtin_bit_cast(unsigned, __builtin_convertvector(v, bf16x2_t)); }
__device__ __forceinline__ bf16_t f2bf(float x) { return (bf16_t)(cvt_pk_bf16(x, 0.f) & 0xffffu); }
__device__ __forceinline__ float bf2f(bf16_t b) { return __uint_as_float(((unsigned)b) << 16); }
__device__ __forceinline__ float bflo(unsigned u) { return __uint_as_float(u << 16); }
__device__ __forceinline__ float bfhi(unsigned u) { return __uint_as_float(u & 0xffff0000u); }
__device__ __forceinline__ float sigmf(float x) { return __builtin_amdgcn_rcpf(1.f + __expf(-x)); }
__device__ __forceinline__ float siluf(float x) { return x * sigmf(x); }
__device__ __forceinline__ int olane() { int l = (int)__builtin_amdgcn_mbcnt_hi(~0u, __builtin_amdgcn_mbcnt_lo(~0u, 0u)); asm volatile("" : "+v"(l)); return l; }
__device__ __forceinline__ float shx(float v, int ln, int m) { return __builtin_bit_cast(float, __builtin_amdgcn_ds_bpermute((ln ^ m) << 2, __builtin_bit_cast(int, v))); }
__device__ __forceinline__ float wave_sum(float v) { const int ln = olane(); for (int o = 32; o > 0; o >>= 1) v += shx(v, ln, o); return v; }
__device__ __forceinline__ float wave_max(float v) { const int ln = olane(); for (int o = 32; o > 0; o >>= 1) v = fmaxf(v, shx(v, ln, o)); return v; }
__device__ __forceinline__ float block_sum(float v, float* red) {
    v = wave_sum(v);
    __syncthreads();
    if ((TIDX() & 63) == 0) red[TIDX() >> 6] = v;
    __syncthreads();
    float s = 0.f;
#pragma unroll
    for (int i = 0; i < NT / 64; ++i) s += red[i];
    return s;
}

#define XB_TMO      128
#define XB_XCNT(j)  (256  + 64 * (j))
#define XB_XSUB(j)  (1280 + 64 * (j))
#define XB_XGEN(j)  (2304 + 64 * (j))
#define XB_TOP      3328
#define XB_TOPGEN   3392
#define XCD_BAR_WORDS 3456
#define XB_SPIN_CAP (1u << 18)
#define LAS __attribute__((address_space(3)))

__device__ __forceinline__ unsigned xb_ld(unsigned* p)              { return __hip_atomic_load(p, __ATOMIC_RELAXED, __HIP_MEMORY_SCOPE_AGENT); }
__device__ __forceinline__ unsigned xb_add(unsigned* p, unsigned v) { return __hip_atomic_fetch_add(p, v, __ATOMIC_RELAXED, __HIP_MEMORY_SCOPE_AGENT); }
__device__ __forceinline__ unsigned xb_xcc_id() { return (unsigned)__builtin_amdgcn_s_getreg((3 << 11) | 20) & 0xFu; }
#define XB_SPIN(cond, bar) do { unsigned _sp = 0; while (cond) { __builtin_amdgcn_s_sleep(1); \
    if ((++_sp & 255u) == 0u) { if (xb_ld(&(bar)[XB_TMO])) break; if (_sp > XB_SPIN_CAP) { atomicAdd(&(bar)[XB_TMO], 1u); break; } } } } while (0)

struct XcdBarrier { unsigned* bar; unsigned x; volatile LAS unsigned* st; };

__device__ __forceinline__ XcdBarrier xcd_barrier_post(unsigned* bar, volatile LAS unsigned* st) {
    XcdBarrier b; b.bar = bar; b.x = xb_xcc_id(); b.st = st;
    if (TIDX() == 0) (void)xb_add(&bar[XB_XCNT(b.x)], 1u);
    return b;
}
__device__ __forceinline__ void xcd_barrier_complete(unsigned* bar, unsigned x, unsigned& nloc, unsigned& nx) {
    const unsigned G = gridDim.x * gridDim.y * gridDim.z;
    unsigned sum, cnt, mine, sp = 0u;
    for (;;) {
        sum = 0u; cnt = 0u; mine = 0u;
#pragma unroll
        for (unsigned j = 0; j < 16; ++j) { const unsigned c = xb_ld(&bar[XB_XCNT(j)]); sum += c; cnt += (c > 0u) ? 1u : 0u; mine = (j == x) ? c : mine; }
        if (sum == G) break;
        __builtin_amdgcn_s_sleep(1);
        if ((++sp & 255u) == 0u) { if (xb_ld(&bar[XB_TMO])) break; if (sp > XB_SPIN_CAP) { atomicAdd(&bar[XB_TMO], 1u); break; } }
    }
    nloc = mine > 0u ? mine : 1u; nx = cnt > 0u ? cnt : 1u;
}
__device__ __forceinline__ void xcd_barrier(const XcdBarrier& b) {
    asm volatile("s_waitcnt vmcnt(0)" ::: "memory");
    __syncthreads();
    if (TIDX() == 0) {
        unsigned* bar = b.bar;
        __builtin_amdgcn_s_waitcnt(0);
        unsigned nloc = b.st[0], nx = b.st[1];
        if (nloc == 0u) { xcd_barrier_complete(bar, b.x, nloc, nx); b.st[0] = nloc; b.st[1] = nx; }
        const unsigned old = xb_add(&bar[XB_XSUB(b.x)], 1u);
        const unsigned gen = old / nloc;
        if (old + 1u == (gen + 1u) * nloc) {
            __builtin_amdgcn_fence(__ATOMIC_RELEASE, "agent");
            asm volatile("s_waitcnt vmcnt(0)" ::: "memory");
            const unsigned og = xb_add(&bar[XB_TOP], 1u);
            const unsigned tg = og / nx;
            if (og + 1u == (tg + 1u) * nx) xb_add(&bar[XB_TOPGEN], 1u);
            else XB_SPIN(xb_ld(&bar[XB_TOPGEN]) == tg, bar);
            __builtin_amdgcn_fence(__ATOMIC_ACQUIRE, "agent");
            xb_add(&bar[XB_XGEN(b.x)], 1u);
            asm volatile("s_waitcnt vmcnt(0)" ::: "memory");
        } else {
            XB_SPIN(xb_ld(&bar[XB_XGEN(b.x)]) == gen, bar);
            __builtin_amdgcn_fence(__ATOMIC_ACQUIRE, "agent");
            asm volatile("s_waitcnt vmcnt(0)" ::: "memory");
        }
    }
    __syncthreads();
}

struct Params {
    const float* x; const float* p; const int* pos; const float* norm_mix_g; const float* w_in; const float* conv_w; const float* conv_b;
    const float* dt_bias_f; const float* dt_bias_b; const float* a_log_f; const float* a_log_b; const float* d_skip; const float* ssd_norm_g;
    const float* lam_q1; const float* lam_k1; const float* lam_q2; const float* lam_k2; const float* subln_g; const float* w_out; const float* norm_ffn_g;
    const float* w_rg; const float* b_rg; const float* w_re; const float* b_re; const float* w_eg; const float* w_eu; const float* w_ed;
    const float* w_pp; const float* ple_g; const float* w_pg; const float* b_pg; const float* final_g;
    float* out;
    unsigned* bar; int* counts; int* cursor;
    bf16_t* w_in_t; bf16_t* w_out_t; bf16_t* w_pg_t; bf16_t* w_pp_t;
    bf16_t* nbf; bf16_t* proj; float* dtv; bf16_t* xbc; float* yf; float* yb; bf16_t* mix; float* h1; bf16_t* hn;
    int* tok_e; float* tok_w; int* row_tok; int* row_slot; float* row_w;
    bf16_t* act; bf16_t* ymoe; bf16_t* h2b; bf16_t* pp; float* prss; float* wcat; float* rope; bf16_t* h3b;
};

__device__ __forceinline__ void ph_wt(char* smem, const float* __restrict__ w, bf16_t* __restrict__ wt, int K, int N, int Npad) {
    const int tilesK = K / 64, tilesN = Npad / 64, total = tilesK * tilesN, tid = TIDX();
    for (int base = blockIdx.x; base < total; base += 4 * gridDim.x) {
        f32x4 v[4][2];
#pragma unroll
        for (int q = 0; q < 4; ++q) { const int tI = base + q * gridDim.x;
            if (tI < total) { const int tk = tI % tilesK, tn = tI / tilesK, k0 = tk * 64, n0 = tn * 64;
#pragma unroll
                for (int j = 0; j < 2; ++j) { const int row = (tid >> 4) + 32 * j, n = n0 + (tid & 15) * 4;
                    f32x4 t = {0.f, 0.f, 0.f, 0.f};
                    if (n + 3 < N) t = *(const f32x4*)(w + (size_t)(k0 + row) * N + n);
                    else { for (int e = 0; e < 4; ++e) if (n + e < N) t[e] = w[(size_t)(k0 + row) * N + n + e]; }
                    v[q][j] = t; } } }
#pragma unroll
        for (int q = 0; q < 4; ++q) { const int tI = base + q * gridDim.x; float* tile = (float*)(smem + q * 16640);
            if (tI < total) {
#pragma unroll
                for (int j = 0; j < 2; ++j) { const int row = (tid >> 4) + 32 * j, n4 = (tid & 15) * 4;
#pragma unroll
                    for (int e = 0; e < 4; ++e) tile[row * 65 + n4 + e] = v[q][j][e]; } } }
        __syncthreads();
#pragma unroll
        for (int q = 0; q < 4; ++q) { const int tI = base + q * gridDim.x; const float* tile = (const float*)(smem + q * 16640);
            if (tI < total) { const int tk = tI % tilesK, tn = tI / tilesK, k0 = tk * 64, n0 = tn * 64;
#pragma unroll
                for (int j = 0; j < 2; ++j) { const int item = tid + NT * j, kq = item & 15, n = item >> 4;
                    u32x2 o; o[0] = cvt_pk_bf16(tile[(4 * kq) * 65 + n], tile[(4 * kq + 1) * 65 + n]); o[1] = cvt_pk_bf16(tile[(4 * kq + 2) * 65 + n], tile[(4 * kq + 3) * 65 + n]);
                    *(u32x2*)(wt + (size_t)(n0 + n) * K + k0 + 4 * kq) = o; } } }
        __syncthreads();
    }
}

__device__ __forceinline__ void row_load(const float* r, f32x4 (&v)[8], int lane) {
#pragma unroll
    for (int i = 0; i < 8; ++i) v[i] = *(const f32x4*)(r + (i * 64 + lane) * 4);
}
__device__ __forceinline__ float row_sumsq(const f32x4 (&v)[8]) {
    float s = 0.f;
#pragma unroll
    for (int i = 0; i < 8; ++i) s += v[i][0] * v[i][0] + v[i][1] * v[i][1] + v[i][2] * v[i][2] + v[i][3] * v[i][3];
    return wave_sum(s);
}

__device__ __forceinline__ void ph_norm_x(const Params& P) {
    const int lane = TIDX() & 63, w = TIDX() >> 6;
    for (int row = blockIdx.x * (NT / 64) + w; row < T_TOK; row += gridDim.x * (NT / 64)) {
        const float* xr = P.x + (size_t)row * DM; f32x4 v[8]; float ss = 0.f;
#pragma unroll
        for (int i = 0; i < 4; ++i) { const int c = (i * 64 + lane) * 8; v[2 * i] = *(const f32x4*)(xr + c); v[2 * i + 1] = *(const f32x4*)(xr + c + 4); }
#pragma unroll
        for (int i = 0; i < 8; ++i) ss += v[i][0] * v[i][0] + v[i][1] * v[i][1] + v[i][2] * v[i][2] + v[i][3] * v[i][3];
        const float r = rsqrtf(wave_sum(ss) * (1.f / DM) + EPS);
#pragma unroll
        for (int i = 0; i < 4; ++i) { const int c = (i * 64 + lane) * 8; const f32x4 g0 = *(const f32x4*)(P.norm_mix_g + c), g1 = *(const f32x4*)(P.norm_mix_g + c + 4);
            u32x4 o; o[0] = cvt_pk_bf16(v[2 * i][0] * r * g0[0], v[2 * i][1] * r * g0[1]); o[1] = cvt_pk_bf16(v[2 * i][2] * r * g0[2], v[2 * i][3] * r * g0[3]);
            o[2] = cvt_pk_bf16(v[2 * i + 1][0] * r * g1[0], v[2 * i + 1][1] * r * g1[1]); o[3] = cvt_pk_bf16(v[2 * i + 1][2] * r * g1[2], v[2 * i + 1][3] * r * g1[3]);
            *(u32x4*)(P.nbf + (size_t)row * DM + c) = o; }
    }
}

struct LoadBf16 {
    const bf16_t* rp[2]; u32x4 r[2];
    __device__ __forceinline__ void init(const bf16_t* base, size_t ld, int row0, const int* gather) {
#pragma unroll
        for (int i = 0; i < 2; ++i) { const int c = TIDX() + i * NT, row = c >> 3, kc = c & 7;
            if (gather) { const int t = gather[row0 + row]; rp[i] = (t >= 0) ? base + (size_t)t * ld + kc * 8 : nullptr; }
            else rp[i] = base + (size_t)(row0 + row) * ld + kc * 8; }
    }
    __device__ __forceinline__ void fetch(int kt) {
#pragma unroll
        for (int i = 0; i < 2; ++i) r[i] = rp[i] ? *(const u32x4*)(rp[i] + kt * 64) : (u32x4){0u, 0u, 0u, 0u};
    }
    __device__ __forceinline__ void commit(char* lds) {
#pragma unroll
        for (int i = 0; i < 2; ++i) { const int c = TIDX() + i * NT, row = c >> 3, kc = c & 7, kh = kc >> 2, kq = kc & 3;
            *(u32x4*)(lds + ((kh * 128 + row) * 32 + kq * 8) * 2) = r[i]; }
    }
};
struct LoadF32Rows {
    const float* rp[2]; f32x4 r[2][2];
    __device__ __forceinline__ void init(const float* base, size_t ld, int row0) {
#pragma unroll
        for (int i = 0; i < 2; ++i) { const int c = TIDX() + i * NT, row = c >> 3, kc = c & 7; rp[i] = base + (size_t)(row0 + row) * ld + kc * 8; }
    }
    __device__ __forceinline__ void fetch(int kt) {
#pragma unroll
        for (int i = 0; i < 2; ++i) { r[i][0] = *(const f32x4*)(rp[i] + kt * 64); r[i][1] = *(const f32x4*)(rp[i] + kt * 64 + 4); }
    }
    __device__ __forceinline__ void commit(char* lds) {
#pragma unroll
        for (int i = 0; i < 2; ++i) { const int c = TIDX() + i * NT, row = c >> 3, kc = c & 7, kh = kc >> 2, kq = kc & 3;
            u32x4 o; o[0] = cvt_pk_bf16(r[i][0][0], r[i][0][1]); o[1] = cvt_pk_bf16(r[i][0][2], r[i][0][3]); o[2] = cvt_pk_bf16(r[i][1][0], r[i][1][1]); o[3] = cvt_pk_bf16(r[i][1][2], r[i][1][3]);
            *(u32x4*)(lds + ((kh * 128 + row) * 32 + kq * 8) * 2) = o; }
    }
};
template <class AL, class BL, class EP>
__device__ __forceinline__ void gemm128(char* smem, int nk, AL& al, BL& bl, const EP& ep) {
    const int tid = TIDX(), wid = tid >> 6, lane = tid & 63, wr = wid >> 2, wc = wid & 3, fr = lane & 15, fq = lane >> 4;
    char* As = smem; char* Bs = smem + 16384;
    f32x4 acc[4][2];
#pragma unroll
    for (int m = 0; m < 4; ++m)
#pragma unroll
        for (int n = 0; n < 2; ++n) acc[m][n] = (f32x4){0.f, 0.f, 0.f, 0.f};
    al.fetch(0); bl.fetch(0);
    for (int kt = 0; kt < nk; ++kt) {
        __syncthreads();
        al.commit(As); bl.commit(Bs);
        __syncthreads();
        if (kt + 1 < nk) { al.fetch(kt + 1); bl.fetch(kt + 1); }
#pragma unroll
        for (int kh = 0; kh < 2; ++kh) {
            bf16x8 a[4], b[2];
#pragma unroll
            for (int m = 0; m < 4; ++m) a[m] = *(const bf16x8*)(As + ((kh * 128 + wr * 64 + m * 16 + fr) * 32 + fq * 8) * 2);
#pragma unroll
            for (int n = 0; n < 2; ++n) b[n] = *(const bf16x8*)(Bs + ((kh * 128 + wc * 32 + n * 16 + fr) * 32 + fq * 8) * 2);
#pragma unroll
            for (int m = 0; m < 4; ++m)
#pragma unroll
                for (int n = 0; n < 2; ++n) acc[m][n] = __builtin_amdgcn_mfma_f32_16x16x32_bf16(a[m], b[n], acc[m][n], 0, 0, 0);
        }
    }
    ep(acc, wr, wc, fr, fq);
    __syncthreads();
}

namespace pg8 {
#define PG8_LAS __attribute__((address_space(3)))
typedef unsigned short bf16_t;
typedef short bf16x8 __attribute__((ext_vector_type(8)));
typedef float f32x4 __attribute__((ext_vector_type(4)));
typedef unsigned u32x4 __attribute__((ext_vector_type(4)));
constexpr int BM = 256, BK = 64, HALF = 128, HTB = HALF * BK * 2  , STAGE_BYTES = 8 * HTB, NXCD = 8, WGM = 8;

__host__ __device__ __forceinline__ int lds_byte(int r, int c) { const int st = (r >> 4) * 2 + (c >> 5), rr = r & 15, cc = c & 31, ob = rr * 64 + cc * 2; return st * 1024 + (ob ^ (((ob >> 9) & 1) << 5)); }
__host__ __device__ __forceinline__ void stage_rc(int b, int& R, int& C) { const int st = b / 1024, sb = b % 1024, swz = sb ^ (((sb >> 9) & 1) << 5); R = (st >> 1) * 16 + swz / 64; C = (st & 1) * 32 + (swz % 64) / 2; }
__host__ __device__ __forceinline__ int perm32(int rho) { const int n = rho >> 4, i = rho & 15; return 8 * (i >> 2) + 4 * n + (i & 3); }

struct Unit { int pm, pn; };
struct Gemm { const bf16_t* A; const bf16_t* Bt; int M, N, K; };

struct StaticOrder {
    int nM, nN, nwg, G, c;
    __host__ __device__ void init(int M, int N, int G_, int c_) { nM = M / BM; nN = N / BM; nwg = nM * nN; G = G_; c = c_; }
    __host__ __device__ bool next(int i, Unit& u) const {
        const long L = (long)i * G + c; if (L >= nwg) return false;
        int wgid = (int)L; { const int q = nwg / NXCD, r = nwg % NXCD, xcd = wgid % NXCD, off = wgid / NXCD; wgid = (xcd < r ? xcd * (q + 1) : r * (q + 1) + (xcd - r) * q) + off; }
        const int nig = WGM * nN, gid = wgid / nig, fm = gid * WGM, gsz = (nM - fm) < WGM ? (nM - fm) : WGM;
        u.pm = fm + ((wgid % nig) % gsz); u.pn = (wgid % nig) / gsz; return true;
    }
    __device__ __forceinline__ void a_ready(const Unit&) const {}
    __device__ __forceinline__ void done(const Unit&) const {}
};

template <class Epi, class Sched, bool STAMP = false>
__device__ __forceinline__ void gemm_phase(PG8_LAS unsigned char* lds, const Gemm g, const Sched& S, const Epi& E, unsigned long long* stamps) {
    const int tid = TIDX(), wid = __builtin_amdgcn_readfirstlane(tid >> 6), lane = tid & 63, wr = wid >> 2, wc = wid & 3, fr = lane & 15, fq = lane >> 4;
    const int K = g.K, nt = K / BK;
    int ts_lo = 0, ts_hi = 0, nts = 0; const unsigned long long rt_entry = STAMP ? (unsigned long long)wall_clock64() : 0ull;
#define PG8_STAMP() do { if (STAMP && wid == 0 && nts < 64) { const unsigned long long _c = (unsigned long long)clock64(); \
        ts_lo = (lane == nts) ? (int)(unsigned)_c : ts_lo; ts_hi = (lane == nts) ? (int)(unsigned)(_c >> 32) : ts_hi; ++nts; } } while (0)
    PG8_STAMP();
    unsigned voffA[2], voffB[2];
#pragma unroll
    for (int i = 0; i < 2; ++i) { int R, C; stage_rc(tid * 16 + i * 8192, R, C); const int Rb = Epi::PERM ? ((R & ~31) + perm32(R & 31)) : R;
        voffA[i] = (unsigned)(R * K + C) * 2u; voffB[i] = (unsigned)(Rb * K + C) * 2u; }
    const size_t kstep = (size_t)(BK * 2);
    const size_t hstep = (size_t)HALF * K * 2;
    const size_t tstep = 2 * hstep;
    const unsigned ldsw = (unsigned)wid * 1024u;
    const int aoff = lds_byte(wr * 64 + fr, fq * 8), boff = lds_byte(wc * 32 + fr, fq * 8);
#define PG8_SA(b, h) (((b) * 2 + (h)) * HTB)
#define PG8_SB(b, h) ((4 + (b) * 2 + (h)) * HTB)
#define PG8_STAGE(bufoff, gbase, voff) do { _Pragma("unroll") for (int _i = 0; _i < 2; ++_i) \
        __builtin_amdgcn_global_load_lds((const unsigned*)((const char*)(gbase) + (voff)[_i]), (PG8_LAS unsigned*)(lds + (bufoff) + ldsw + _i * 8192), 16, 0, 0); } while (0)
#define PG8_LDA(dst, b, h) do { _Pragma("unroll") for (int m = 0; m < 4; ++m) _Pragma("unroll") for (int k = 0; k < 2; ++k) dst[m][k] = *(const PG8_LAS bf16x8*)(lds + PG8_SA(b, h) + aoff + m * 2048 + k * 1024); } while (0)
#define PG8_LDB(dst, b, h) do { _Pragma("unroll") for (int n = 0; n < 2; ++n) _Pragma("unroll") for (int k = 0; k < 2; ++k) dst[n][k] = *(const PG8_LAS bf16x8*)(lds + PG8_SB(b, h) + boff + n * 2048 + k * 1024); } while (0)
#define PG8_MMA(ai, bj, At, Bt) do { __builtin_amdgcn_s_setprio(1); _Pragma("unroll") for (int m = 0; m < 4; ++m) _Pragma("unroll") for (int n = 0; n < 2; ++n) _Pragma("unroll") for (int k = 0; k < 2; ++k) \
        acc[ai][bj][m][n] = __builtin_amdgcn_mfma_f32_16x16x32_bf16(Bt[n][k], At[m][k], acc[ai][bj][m][n], 0, 0, 0); __builtin_amdgcn_s_setprio(0); } while (0)
#define PG8_WAIT_V(n) asm volatile("s_waitcnt vmcnt(" #n ")" ::: "memory")
#define PG8_WAIT_L(n) asm volatile("s_waitcnt lgkmcnt(" #n ")" ::: "memory")
#define PG8_BAR __builtin_amdgcn_s_barrier()
#define PG8_SCHED __builtin_amdgcn_sched_barrier(0)
    Unit cur, nxt; int ui = 0;
    if (!S.next(0, cur)) return;
    f32x4 acc[2][2][4][2];
#pragma unroll
    for (int a = 0; a < 2; ++a)
#pragma unroll
        for (int b = 0; b < 2; ++b)
#pragma unroll
            for (int m = 0; m < 4; ++m)
#pragma unroll
                for (int n = 0; n < 2; ++n) acc[a][b][m][n] = (f32x4){0.f, 0.f, 0.f, 0.f};
    bf16x8 At[4][2], B0[2][2], B1[2][2];
    const char* cA = (const char*)g.A + (size_t)cur.pm * tstep; const char* cB = (const char*)g.Bt + (size_t)cur.pn * tstep;
    S.a_ready(cur);
    PG8_STAGE(PG8_SB(0, 0), cB, voffB); PG8_STAGE(PG8_SA(0, 0), cA, voffA); PG8_STAGE(PG8_SB(0, 1), cB + hstep, voffB); PG8_STAGE(PG8_SA(0, 1), cA + hstep, voffA);
    if (wr == 1) PG8_BAR;
    PG8_WAIT_V(4); PG8_BAR;
    PG8_STAGE(PG8_SB(1, 0), cB + kstep, voffB); PG8_STAGE(PG8_SA(1, 0), cA + kstep, voffA); PG8_STAGE(PG8_SB(1, 1), cB + hstep + kstep, voffB);
    PG8_WAIT_V(6); PG8_BAR;
    PG8_STAMP();
    for (;;) {
        const bool has_next = S.next(ui + 1, nxt);
        const char* nA = has_next ? (const char*)g.A + (size_t)nxt.pm * tstep : cA; const char* nB = has_next ? (const char*)g.Bt + (size_t)nxt.pn * tstep : cB;
        for (int t = 0; t < nt; t += 2) {
            const bool last = (t == nt - 2);
            const char* a1 = cA + (size_t)(t + 1) * kstep;
            const char* a2 = last ? nA : cA + (size_t)(t + 2) * kstep; const char* b2 = last ? nB : cB + (size_t)(t + 2) * kstep;
            const char* a3 = a2 + kstep; const char* b3 = b2 + kstep;
            if (last && has_next) S.a_ready(nxt);
            PG8_LDB(B0, 0, 0); PG8_SCHED; PG8_LDA(At, 0, 0); PG8_STAGE(PG8_SA(1, 1), a1 + hstep, voffA);
            PG8_WAIT_L(8); PG8_BAR; PG8_WAIT_L(0); PG8_MMA(0, 0, At, B0); PG8_BAR; PG8_SCHED;
            PG8_LDB(B1, 0, 1); PG8_STAGE(PG8_SB(0, 0), b2, voffB);
            PG8_BAR; PG8_WAIT_L(0); PG8_MMA(0, 1, At, B1); PG8_BAR;
            PG8_LDA(At, 0, 1); PG8_STAGE(PG8_SA(0, 0), a2, voffA);
            PG8_BAR; PG8_WAIT_L(0); PG8_MMA(1, 0, At, B0); PG8_BAR; PG8_SCHED;
            PG8_STAGE(PG8_SB(0, 1), b2 + hstep, voffB);
            PG8_WAIT_V(6); PG8_BAR; PG8_MMA(1, 1, At, B1); PG8_BAR;
            PG8_LDB(B0, 1, 0); PG8_SCHED; PG8_LDA(At, 1, 0); PG8_STAGE(PG8_SA(0, 1), a2 + hstep, voffA);
            PG8_WAIT_L(8); PG8_BAR; PG8_WAIT_L(0); PG8_MMA(0, 0, At, B0); PG8_BAR; PG8_SCHED;
            PG8_LDB(B1, 1, 1); PG8_STAGE(PG8_SB(1, 0), b3, voffB);
            PG8_BAR; PG8_WAIT_L(0); PG8_MMA(0, 1, At, B1); PG8_BAR;
            PG8_LDA(At, 1, 1); PG8_STAGE(PG8_SA(1, 0), a3, voffA);
            PG8_BAR; PG8_WAIT_L(0); PG8_MMA(1, 0, At, B0); PG8_BAR; PG8_SCHED;
            PG8_STAGE(PG8_SB(1, 1), b3 + hstep, voffB);
            PG8_WAIT_V(6); PG8_BAR; PG8_MMA(1, 1, At, B1); PG8_BAR;
        }
        PG8_STAMP();
        if constexpr (!Epi::AFTER_DRAIN) { E(acc, cur, wr, wc, fr, fq); S.done(cur); }
        PG8_STAMP();
        if (!has_next) break;
#pragma unroll
        for (int a = 0; a < 2; ++a)
#pragma unroll
            for (int b = 0; b < 2; ++b)
#pragma unroll
                for (int m = 0; m < 4; ++m)
#pragma unroll
                    for (int n = 0; n < 2; ++n) acc[a][b][m][n] = (f32x4){0.f, 0.f, 0.f, 0.f};
        cur = nxt; cA = nA; cB = nB; ++ui;
    }
    PG8_WAIT_V(0);
    if (wr == 0) PG8_BAR;
    PG8_BAR;
    if constexpr (Epi::AFTER_DRAIN) { E.fused(acc, cur, wr, wc, fr, fq, lds, wid, lane); S.done(cur); }
    PG8_STAMP();
    if (STAMP && wid == 0) { stamps[lane] = lane < nts ? (((unsigned long long)(unsigned)ts_hi << 32) | (unsigned)ts_lo) : 0ull;
        if (lane == 62) stamps[62] = rt_entry; if (lane == 63) stamps[63] = (unsigned long long)wall_clock64(); }
#undef PG8_STAMP
#undef PG8_SA
#undef PG8_SB
#undef PG8_STAGE
#undef PG8_LDA
#undef PG8_LDB
#undef PG8_MMA
#undef PG8_WAIT_V
#undef PG8_WAIT_L
#undef PG8_BAR
#undef PG8_SCHED
}
}


struct EpiInProjF {
    static constexpr bool PERM = true, AFTER_DRAIN = false;
    bf16_t* proj; float* dtv; const float* rope; const float* dt_bias_f; const float* dt_bias_b;
    __device__ __forceinline__ void operator()(const f32x4 (&acc)[2][2][4][2], const pg8::Unit& u, int wr, int wc, int fr, int fq) const {
        const int row0 = u.pm * 256 + wr * 64 + fr;
        const bool qk_tile = (u.pn >= 10) && (u.pn <= 18);
#pragma unroll
        for (int ai = 0; ai < 2; ++ai)
#pragma unroll
            for (int m = 0; m < 4; ++m) { const int row = row0 + ai * 128 + m * 16;
                f32x4 c0 = {0.f, 0.f, 0.f, 0.f}, c1 = c0, s0 = c0, s1 = c0;
                if (qk_tile) { const float* rp = rope + (size_t)row * 16; c0 = *(const f32x4*)rp; c1 = *(const f32x4*)(rp + 4); s0 = *(const f32x4*)(rp + 8); s1 = *(const f32x4*)(rp + 12); }
#pragma unroll
                for (int bj = 0; bj < 2; ++bj) { const int col0 = u.pn * 256 + bj * 128 + wc * 32 + 8 * fq;
                    f32x4 v0 = acc[ai][bj][m][0], v1 = acc[ai][bj][m][1];
                    if (qk_tile) {
                        f32x4 p0, p1;
                        const int ln_ = olane();
#pragma unroll
                        for (int j = 0; j < 4; ++j) { p0[j] = shx(v0[j], ln_, 16); p1[j] = shx(v1[j], ln_, 16); }
                        const int d0 = (col0 - OFF_Q) & 63;
                        if (col0 >= OFF_Q && col0 < OFF_V && d0 < 16) {
                            if (d0 == 0) { v0 = v0 * c0 - p0 * s0; v1 = v1 * c1 - p1 * s1; }
                            else         { v0 = v0 * c0 + p0 * s0; v1 = v1 * c1 + p1 * s1; }
                        }
                    }
                    if (col0 < INW) {
                        u32x4 w; w[0] = cvt_pk_bf16(v0[0], v0[1]); w[1] = cvt_pk_bf16(v0[2], v0[3]); w[2] = cvt_pk_bf16(v1[0], v1[1]); w[3] = cvt_pk_bf16(v1[2], v1[3]);
                        *(u32x4*)(proj + (size_t)row * INW + col0) = w;
                        if (col0 >= OFF_DT && col0 < OFF_DT + 32) { const int j0 = col0 - OFF_DT; const float* bp = (j0 < 16) ? (dt_bias_f + j0) : (dt_bias_b + (j0 - 16));
                            f32x4 o0, o1;
#pragma unroll
                            for (int j = 0; j < 4; ++j) { const float a = v0[j] + bp[j], b = v1[j] + bp[4 + j];
                                o0[j] = fmaxf(a, 0.f) + log1pf(expf(-fabsf(a))); o1[j] = fmaxf(b, 0.f) + log1pf(expf(-fabsf(b))); }
                            *(f32x4*)(dtv + (size_t)row * 32 + j0) = o0; *(f32x4*)(dtv + (size_t)row * 32 + j0 + 4) = o1; } } } }
    }
};
__device__ __forceinline__ void ph_inproj(const Params& P, char* smem) {
    pg8::Gemm g{P.nbf, P.w_in_t, T_TOK, INW_PAD, DM};
    pg8::StaticOrder S; S.init(T_TOK, INW_PAD, gridDim.x, blockIdx.x);
    EpiInProjF E{P.proj, P.dtv, P.rope, P.dt_bias_f, P.dt_bias_b};
    pg8::gemm_phase<EpiInProjF, pg8::StaticOrder>((PG8_LAS unsigned char*)smem, g, S, E, nullptr);
    __syncthreads();
}

__device__ __forceinline__ void ph_rope_table(const Params& P) {
    for (int i = blockIdx.x * NT + TIDX(); i < T_TOK * 8; i += gridDim.x * NT) { const int t = i >> 3, f = i & 7;
        const float ang = (float)P.pos[t] * powf(500000.0f, -(float)(2 * f) / 16.0f);
        P.rope[t * 16 + f] = cosf(ang); P.rope[t * 16 + 8 + f] = sinf(ang); }
}
__device__ __forceinline__ void ph_conv(const Params& P) {
    const bool even = (gridDim.x * 320 == (XBCW / 8) * (T_TOK / 16));
    for (int id = even ? (TIDX() < 320 ? (int)blockIdx.x * 320 + TIDX() : (XBCW / 8) * (T_TOK / 16)) : (int)blockIdx.x * NT + TIDX(); id < (XBCW / 8) * (T_TOK / 16); id += even ? (XBCW / 8) * (T_TOK / 16) : gridDim.x * NT) {
        const int cg = id % (XBCW / 8), tg = id / (XBCW / 8), c = cg * 8, t0 = tg * 16, s0 = t0 & (SEQ - 1);
        float w[5][8], bias[8];
#pragma unroll
        for (int k = 0; k < 5; ++k) { const f32x4 a = *(const f32x4*)(P.conv_w + k * XBCW + c), b = *(const f32x4*)(P.conv_w + k * XBCW + c + 4);
#pragma unroll
            for (int j = 0; j < 4; ++j) { w[k][j] = a[j]; w[k][4 + j] = b[j]; } }
        { const f32x4 a = *(const f32x4*)(P.conv_b + c), b = *(const f32x4*)(P.conv_b + c + 4);
#pragma unroll
          for (int j = 0; j < 4; ++j) { bias[j] = a[j]; bias[4 + j] = b[j]; } }
        const bf16_t* src = P.proj + (size_t)t0 * INW + OFF_XBC + c;
        u32x4 raw[20];
#pragma unroll
        for (int j = 0; j < 20; ++j) { const int ss = s0 + j - 2; raw[j] = (ss >= 0 && ss < SEQ) ? *(const u32x4*)(src + (ptrdiff_t)(j - 2) * INW) : (u32x4){0u, 0u, 0u, 0u}; }
#pragma unroll
        for (int r = 0; r < 16; ++r) {
            float o[8];
#pragma unroll
            for (int j = 0; j < 8; ++j) o[j] = bias[j];
#pragma unroll
            for (int k = 0; k < 5; ++k)
#pragma unroll
                for (int e = 0; e < 4; ++e) { o[2 * e] += bflo(raw[r + k][e]) * w[k][2 * e]; o[2 * e + 1] += bfhi(raw[r + k][e]) * w[k][2 * e + 1]; }
            u32x4 ov;
#pragma unroll
            for (int e = 0; e < 4; ++e) ov[e] = cvt_pk_bf16(siluf(o[2 * e]), siluf(o[2 * e + 1]));
            *(u32x4*)(P.xbc + (size_t)(t0 + r) * XBCW + c) = ov;
        }
    }
}

typedef float f32x16 __attribute__((ext_vector_type(16)));
typedef short s16x4 __attribute__((ext_vector_type(4)));
__device__ __forceinline__ int crow(int r, int hi) { return (r & 3) + 8 * (r >> 2) + 4 * hi; }
__device__ __forceinline__ unsigned off_b(unsigned row, unsigned ch) { return 256u * row + 16u * (ch ^ (((row & 3) << 2) | ((row >> 2) & 3))); }
__device__ __forceinline__ unsigned off_x(unsigned l, unsigned ch) { return 128u * l + 16u * (ch ^ (((l >> 1) & 1) << 2)); }
__device__ __forceinline__ s16x4 tr_read_a(unsigned addr) { s16x4 r; asm volatile("ds_read_b64_tr_b16 %0, %1" : "=&v"(r) : "v"(addr) : "memory"); return r; }
#define SSD_B 0
#define SSD_C 32768
#define SSD_XD 65536
#define SSD_XE 81920
#define SSD_S 98304
#define SSD_ARR 114688
#define SSD_SPLIT 9
__device__ __forceinline__ void ph_ssd(const Params& P, char* smem) {
    const int tid = TIDX(), wid = __builtin_amdgcn_readfirstlane(tid >> 6), lane = tid & 63, r32 = lane & 31, hi = lane >> 5;
    const unsigned lbase = (unsigned)(uintptr_t)smem;
    float* arrBase = (float*)(smem + SSD_ARR);
    const int lt = wid >> 1, pt = wid & 1;
    const int spt = wid >> 2, snt = wid & 3;
    const unsigned tq = (lane & 15) >> 2, tp = lane & 3, tblk = (lane >> 4) & 1;
#pragma unroll 1
    for (int u = blockIdx.x; u < NB * 16 * 2 * 2; u += gridDim.x) {
        const int dir = u & 1, h = (u >> 1) & 15, b = (u >> 5) & 3, hv = u >> 7, g = h >> 3;
        const float a = -expf(dir ? P.a_log_b[h] : P.a_log_f[h]);
        bf16_t* y = (bf16_t*)(dir ? P.yb : P.yf);
        f32x16 S = f32x16{};
        __syncthreads();
        for (int i = tid; i < 64 * 128 / 2; i += NT) ((unsigned*)(smem + SSD_S))[i] = 0u;
        const int nci = hv ? SEQ / 128 : SSD_SPLIT, cfull0 = hv ? SSD_SPLIT : 0;
        u32x4 rb[4], rc[4], rx[2]; float dt0 = 0.f, dt1 = 0.f;
#define SSD_T0(ci_) ((unsigned)b * SEQ + (unsigned)(dir ? (SEQ / 128 - 1 - (ci_)) : (ci_)) * 128u)
#define SSD_LD_BC(ci_) do { const unsigned t0n_ = SSD_T0(ci_); const bool fulln_ = (ci_) >= cfull0; _Pragma("unroll") for (int i = 0; i < 4; ++i) { const int cc = tid + i * NT, l = cc >> 4, ch = cc & 15; \
            const char* src = (const char*)P.xbc + (unsigned)(((t0n_ + l) * XBCW + g * 128 + ch * 8) * 2u); rb[i] = *(const u32x4*)(src + 2048); if (fulln_) rc[i] = *(const u32x4*)(src + 2560); } } while (0)
#define SSD_LD_X(ci_) do { const unsigned t0n_ = SSD_T0(ci_); _Pragma("unroll") for (int i = 0; i < 2; ++i) { const int cc = tid + i * NT, l = cc >> 3, ch = cc & 7; rx[i] = *(const u32x4*)((const char*)P.xbc + (unsigned)(((t0n_ + l) * XBCW + h * 64 + ch * 8) * 2u)); } } while (0)
#define SSD_LD_DT(ci_) do { const unsigned t0n_ = SSD_T0(ci_); dt0 = P.dtv[(unsigned)((t0n_ + 2 * lane) * 32 + dir * 16 + h)]; dt1 = P.dtv[(unsigned)((t0n_ + 2 * lane + 1) * 32 + dir * 16 + h)]; } while (0)
        const int swid = dir ? 7 : 0;
#define SSD_SCAN(q_) do { float* sA_ = arrBase + (q_) * 640; const float da0 = dt0 * a, da1 = dt1 * a; float pr = da0 + da1; \
            _Pragma("unroll") for (int o = 1; o < 64; o <<= 1) { const float v = __shfl_up(pr, o); if (lane >= o) pr += v; } \
            const float tot = __shfl(pr, 63), acs1 = pr, acs0 = pr - da1; \
            const float A0 = dir ? (tot - acs0 + da0) : acs0, A1 = dir ? (tot - acs1 + da1) : acs1; \
            sA_[2 * lane] = A0; sA_[2 * lane + 1] = A1; sA_[128 + 2 * lane] = __expf(A0); sA_[128 + 2 * lane + 1] = __expf(A1); \
            sA_[256 + 2 * lane] = dt0; sA_[256 + 2 * lane + 1] = dt1; sA_[384 + 2 * lane] = dt0 * __expf(tot - A0); sA_[384 + 2 * lane + 1] = dt1 * __expf(tot - A1); \
            if (lane == 0) sA_[512] = __expf(tot); } while (0)
        SSD_LD_BC(0); SSD_LD_X(0);
        if (wid == swid) { SSD_LD_DT(0); SSD_SCAN(0); SSD_LD_DT(1 < nci ? 1 : 0); }
#pragma unroll 1
        for (int ci = 0; ci < nci; ++ci) {
            const bool full = ci >= cfull0;
            const int cn = ci + 1 < nci ? ci + 1 : ci;
            const unsigned t0 = SSD_T0(ci);
            float* arrA = arrBase + (ci & 1) * 640; float* arrEA = arrA + 128; float* arrDT = arrA + 256; float* arrDTE = arrA + 384; float* arrTOT = arrA + 512;
            __syncthreads();
#pragma unroll
            for (int i = 0; i < 4; ++i) { const int cc = tid + i * NT, l = cc >> 4, ch = cc & 15; *(u32x4*)(smem + SSD_B + off_b(l, ch)) = rb[i]; if (full) *(u32x4*)(smem + SSD_C + off_b(l, ch)) = rc[i]; }
            SSD_LD_BC(cn);
#pragma unroll
            for (int i = 0; i < 2; ++i) { const int cc = tid + i * NT, l = cc >> 3, ch = cc & 7; const float dt = arrDT[l], dte = arrDTE[l];
                u32x4 xd, xe;
#pragma unroll
                for (int e = 0; e < 4; ++e) { const float lo = bflo(rx[i][e]), hv = bfhi(rx[i][e]); xd[e] = cvt_pk_bf16(lo * dt, hv * dt); xe[e] = cvt_pk_bf16(lo * dte, hv * dte); }
                if (full) *(u32x4*)(smem + SSD_XD + off_x(l, ch)) = xd; *(u32x4*)(smem + SSD_XE + off_x(l, ch)) = xe; }
            SSD_LD_X(cn);
            __syncthreads();
            if (full) {
            f32x16 Y = f32x16{};
#define SSD_CF(ks) (*(const bf16x8*)(smem + SSD_C + off_b(32 * lt + r32, 2 * (ks) + hi)))
            if (ci > 0) {
#pragma unroll
                for (int ks = 0; ks < 8; ++ks) { const bf16x8 sf = *(const bf16x8*)(smem + SSD_S + off_b(32 * pt + r32, 2 * ks + hi));
                    Y = __builtin_amdgcn_mfma_f32_32x32x16_bf16(SSD_CF(ks), sf, Y, 0, 0, 0); }
#pragma unroll
                for (int r = 0; r < 16; ++r) Y[r] *= arrEA[32 * lt + crow(r, hi)];
            }
            const float Al = arrA[32 * lt + r32];
            const int j0 = dir ? lt : 0, j1 = dir ? 3 : lt;
#pragma unroll 1
            for (int j = j0; j <= j1; ++j) {
                const unsigned rwa = 32 * j + 4 * hi + tq;
                const s16x4 x00 = tr_read_a(lbase + SSD_XD + off_x(rwa, 4 * pt + 2 * tblk + (tp >> 1)) + 8 * (tp & 1)), x01 = tr_read_a(lbase + SSD_XD + off_x(rwa + 8, 4 * pt + 2 * tblk + (tp >> 1)) + 8 * (tp & 1));
                const s16x4 x10 = tr_read_a(lbase + SSD_XD + off_x(rwa + 16, 4 * pt + 2 * tblk + (tp >> 1)) + 8 * (tp & 1)), x11 = tr_read_a(lbase + SSD_XD + off_x(rwa + 24, 4 * pt + 2 * tblk + (tp >> 1)) + 8 * (tp & 1));
                f32x16 X1 = f32x16{};
#pragma unroll
                for (int ks = 0; ks < 8; ++ks) { const bf16x8 bfr = *(const bf16x8*)(smem + SSD_B + off_b(32 * j + r32, 2 * ks + hi));
                    X1 = __builtin_amdgcn_mfma_f32_32x32x16_bf16(bfr, SSD_CF(ks), X1, 0, 0, 0); }
#pragma unroll
                for (int r = 0; r < 16; ++r) { const int sl = crow(r, hi); const float As = arrA[32 * j + sl];
                    const bool valid = (j != lt) || (dir ? (sl >= r32) : (sl <= r32));
                    X1[r] = valid ? X1[r] * __expf(Al - As) : 0.f; }
                u32x4 aw0, aw1;
                aw0[0] = cvt_pk_bf16(X1[0], X1[1]); aw0[1] = cvt_pk_bf16(X1[2], X1[3]); aw0[2] = cvt_pk_bf16(X1[4], X1[5]); aw0[3] = cvt_pk_bf16(X1[6], X1[7]);
                aw1[0] = cvt_pk_bf16(X1[8], X1[9]); aw1[1] = cvt_pk_bf16(X1[10], X1[11]); aw1[2] = cvt_pk_bf16(X1[12], X1[13]); aw1[3] = cvt_pk_bf16(X1[14], X1[15]);
                asm volatile("s_waitcnt lgkmcnt(0)" ::: "memory"); __builtin_amdgcn_sched_barrier(0);
                const bf16x8 xf0 = (bf16x8){x00[0], x00[1], x00[2], x00[3], x01[0], x01[1], x01[2], x01[3]}, xf1 = (bf16x8){x10[0], x10[1], x10[2], x10[3], x11[0], x11[1], x11[2], x11[3]};
                Y = __builtin_amdgcn_mfma_f32_32x32x16_bf16(*reinterpret_cast<bf16x8*>(&aw0), xf0, Y, 0, 0, 0);
                Y = __builtin_amdgcn_mfma_f32_32x32x16_bf16(*reinterpret_cast<bf16x8*>(&aw1), xf1, Y, 0, 0, 0);
            }
            {   int opq = 0; asm volatile("" : "+v"(opq));
                bf16_t* yo = y + (unsigned)(((unsigned)t0 + 32u * lt + 4u * hi + (unsigned)opq) * SSDW + h * 64 + 32 * pt + r32);
#pragma unroll
                for (int r = 0; r < 16; ++r) yo[(unsigned)(((r & 3) + 8 * (r >> 2)) * SSDW)] = f2bf(Y[r]); }
            }
            { const float tot = arrTOT[0];
#pragma unroll
              for (int r = 0; r < 16; ++r) S[r] *= tot; }
#pragma unroll
            for (int ks = 0; ks < 8; ++ks) {
                const unsigned rw0 = 16 * ks + 8 * hi + tq, rw1 = rw0 + 4;
                const s16x4 a0 = tr_read_a(lbase + SSD_XE + off_x(rw0, 4 * spt + 2 * tblk + (tp >> 1)) + 8 * (tp & 1));
                const s16x4 a1 = tr_read_a(lbase + SSD_XE + off_x(rw1, 4 * spt + 2 * tblk + (tp >> 1)) + 8 * (tp & 1));
                const s16x4 b0 = tr_read_a(lbase + SSD_B + off_b(rw0, 4 * snt + 2 * tblk + (tp >> 1)) + 8 * (tp & 1));
                const s16x4 b1 = tr_read_a(lbase + SSD_B + off_b(rw1, 4 * snt + 2 * tblk + (tp >> 1)) + 8 * (tp & 1));
                asm volatile("s_waitcnt lgkmcnt(0)" ::: "memory"); __builtin_amdgcn_sched_barrier(0);
                const bf16x8 af = (bf16x8){a0[0], a0[1], a0[2], a0[3], a1[0], a1[1], a1[2], a1[3]};
                const bf16x8 bfr = (bf16x8){b0[0], b0[1], b0[2], b0[3], b1[0], b1[1], b1[2], b1[3]};
                S = __builtin_amdgcn_mfma_f32_32x32x16_bf16(af, bfr, S, 0, 0, 0);
            }
            if (wid == swid && ci + 1 < nci) { SSD_SCAN((ci + 1) & 1); SSD_LD_DT(ci + 2 < nci ? ci + 2 : nci - 1); }
            __syncthreads();
#pragma unroll
            for (int r = 0; r < 16; ++r) { const unsigned pr = 32 * spt + crow(r, hi), n = 32 * snt + r32;
                *(bf16_t*)(smem + SSD_S + off_b(pr, n >> 3) + (n & 7) * 2) = f2bf(S[r]); }
        }
#undef SSD_SCAN
#undef SSD_LD_DT
#undef SSD_LD_X
#undef SSD_LD_BC
#undef SSD_T0
    }
    __syncthreads();
}

__device__ __forceinline__ void ph_ssd_gate(const Params& P) {
    const int lane = TIDX() & 63, w = TIDX() >> 6;
    for (int t = blockIdx.x * (NT / 64) + w; t < T_TOK; t += gridDim.x * (NT / 64)) {
        float v[16]; float ss = 0.f;
#pragma unroll
        for (int i = 0; i < 2; ++i) { const int c = (i * 64 + lane) * 8;
            const u32x4 ya = *(const u32x4*)((const bf16_t*)P.yf + (size_t)t * SSDW + c), yb2 = *(const u32x4*)((const bf16_t*)P.yb + (size_t)t * SSDW + c);
            const u32x4 xs = *(const u32x4*)(P.xbc + (size_t)t * XBCW + c), zz = *(const u32x4*)(P.proj + (size_t)t * INW + OFF_Z + c);
            const float d = P.d_skip[c >> 6];
#pragma unroll
            for (int e = 0; e < 4; ++e) {
                const float y0 = bflo(ya[e]) + bflo(yb2[e]) + bflo(xs[e]) * d, y1 = bfhi(ya[e]) + bfhi(yb2[e]) + bfhi(xs[e]) * d;
                const float o0 = y0 * siluf(bflo(zz[e])), o1 = y1 * siluf(bfhi(zz[e]));
                v[i * 8 + 2 * e] = o0; v[i * 8 + 2 * e + 1] = o1; ss += o0 * o0 + o1 * o1; } }
        ss = wave_sum(ss);
        const float r = rsqrtf(ss * (1.f / SSDW) + EPS);
#pragma unroll
        for (int i = 0; i < 2; ++i) { const int c = (i * 64 + lane) * 8; const f32x4 g0 = *(const f32x4*)(P.ssd_norm_g + c), g1 = *(const f32x4*)(P.ssd_norm_g + c + 4);
            u32x4 o; o[0] = cvt_pk_bf16(v[i * 8] * r * g0[0], v[i * 8 + 1] * r * g0[1]); o[1] = cvt_pk_bf16(v[i * 8 + 2] * r * g0[2], v[i * 8 + 3] * r * g0[3]);
            o[2] = cvt_pk_bf16(v[i * 8 + 4] * r * g1[0], v[i * 8 + 5] * r * g1[1]); o[3] = cvt_pk_bf16(v[i * 8 + 6] * r * g1[2], v[i * 8 + 7] * r * g1[3]);
            *(u32x4*)(P.mix + (size_t)t * DM + c) = o; }
    }
}

#define AT_SHM_V 16384
#define AT_SHM_K 8192
#define AT_KVBLK 64
#define AT_THR 8.f
#define AT_SCALE 0.125f
#define KSWZ64(row, colB) ((row) * 128 + ((colB) ^ (((row) & 7) << 4)))
#define SBAR() __builtin_amdgcn_sched_barrier(0)
__device__ __forceinline__ void partialSM(f32x16& p0, f32x16& p1, float& m_reg, float& mn, float& alpha) {
    constexpr float C = AT_SCALE * 1.4426950408889634f;
    float pmax = p0[0];
#pragma unroll
    for (int r = 1; r < 16; ++r) pmax = fmaxf(pmax, p0[r]);
#pragma unroll
    for (int r = 0; r < 16; ++r) pmax = fmaxf(pmax, p1[r]);
    { auto rr = __builtin_amdgcn_permlane32_swap(__float_as_uint(pmax), __float_as_uint(pmax), false, false);
      pmax = fmaxf(__uint_as_float(rr[0]), __uint_as_float(rr[1])); }
    if (__builtin_expect(__all(pmax - m_reg <= AT_THR / AT_SCALE), 1)) { mn = m_reg; alpha = 1.f; }
    else { mn = fmaxf(m_reg, pmax); alpha = __builtin_amdgcn_exp2f((m_reg - mn) * C); m_reg = mn; }
    const float mnC = -mn * C;
#pragma unroll
    for (int r = 0; r < 16; ++r) p0[r] = fmaf(p0[r], C, mnC);
#pragma unroll
    for (int r = 0; r < 16; ++r) p1[r] = fmaf(p1[r], C, mnC);
#pragma unroll
    for (int r = 0; r < 16; ++r) p0[r] = __builtin_amdgcn_exp2f(p0[r]);
}
__device__ __forceinline__ void finishSM(f32x16& p0, f32x16& p1, float alpha, float& l_reg, bf16x8& pa0, bf16x8& pa1, bf16x8& pa2, bf16x8& pa3) {
#pragma unroll
    for (int r = 0; r < 16; ++r) p1[r] = __builtin_amdgcn_exp2f(p1[r]);
    float ps = 0;
#pragma unroll
    for (int r = 0; r < 16; ++r) ps += p0[r];
#pragma unroll
    for (int r = 0; r < 16; ++r) ps += p1[r];
    { auto rr = __builtin_amdgcn_permlane32_swap(__float_as_uint(ps), __float_as_uint(ps), false, false);
      ps = __uint_as_float(rr[0]) + __uint_as_float(rr[1]); }
    l_reg = l_reg * alpha + ps;
#define PK4(P, BASE, OUT) do { unsigned a0 = cvt_pk_bf16(P[BASE + 0], P[BASE + 1]), a1 = cvt_pk_bf16(P[BASE + 2], P[BASE + 3]);   \
    unsigned b0 = cvt_pk_bf16(P[BASE + 4], P[BASE + 5]), b1 = cvt_pk_bf16(P[BASE + 6], P[BASE + 7]);                              \
    auto r0 = __builtin_amdgcn_permlane32_swap(a0, b0, false, false); auto r1 = __builtin_amdgcn_permlane32_swap(a1, b1, false, false); \
    u32x4 w = {r0[0], r1[0], r0[1], r1[1]}; OUT = *reinterpret_cast<bf16x8*>(&w); } while (0)
    PK4(p0, 0, pa0); PK4(p0, 8, pa1); PK4(p1, 0, pa2); PK4(p1, 8, pa3);
#undef PK4
}
__device__ __forceinline__ void qkt64(f32x16& p0, f32x16& p1, const char* Ks, const bf16x8* qr, int r32, int hi) {
    p0 = f32x16{}; p1 = f32x16{};
#pragma unroll
    for (int d0 = 0; d0 < 4; ++d0) { const int cb = (d0 * 16 + hi * 8) * 2;
        const bf16x8 b0 = *reinterpret_cast<const bf16x8*>(Ks + KSWZ64(r32, cb));
        const bf16x8 b1 = *reinterpret_cast<const bf16x8*>(Ks + KSWZ64(32 + r32, cb));
        p0 = __builtin_amdgcn_mfma_f32_32x32x16_bf16(b0, qr[d0], p0, 0, 0, 0);
        p1 = __builtin_amdgcn_mfma_f32_32x32x16_bf16(b1, qr[d0], p1, 0, 0, 0); }
}
__device__ __forceinline__ int v_st(int k, int c) { const int kk = (k & ~0xC) | ((k & 4) << 1) | ((k & 8) >> 1); return ((kk >> 3) * 4 + (c >> 5)) * 512 + ((kk & 7) * 32 + (c & 31)) * 2; }
__device__ __forceinline__ int v_rd_base(int lane) { return ((lane & 3) << 3) | (((lane >> 2) & 3) << 6) | (((lane >> 4) & 1) << 5) | (((lane >> 5) & 1) << 8); }
constexpr int v_rd_off(int d0, int ks, int half) { return d0 * 512 + ks * 4096 + half * 2048; }
template <int OFF> __device__ __forceinline__ s16x4 tr_read(int vb) {
    s16x4 r; asm volatile("ds_read_b64_tr_b16 %0, %1 offset:%2" : "=&v"(r) : "v"(vb), "i"(OFF) : "memory"); return r;
}
template <int D0> __device__ __forceinline__ void pv_one(f32x16& od, int vb, bf16x8 pa0, bf16x8 pa1, bf16x8 pa2, bf16x8 pa3) {
    const s16x4 l0 = tr_read<v_rd_off(D0, 0, 0)>(vb), h0 = tr_read<v_rd_off(D0, 0, 1)>(vb), l1 = tr_read<v_rd_off(D0, 1, 0)>(vb), h1 = tr_read<v_rd_off(D0, 1, 1)>(vb);
    const s16x4 l2 = tr_read<v_rd_off(D0, 2, 0)>(vb), h2 = tr_read<v_rd_off(D0, 2, 1)>(vb), l3 = tr_read<v_rd_off(D0, 3, 0)>(vb), h3 = tr_read<v_rd_off(D0, 3, 1)>(vb);
    asm volatile("s_waitcnt lgkmcnt(0)" ::: "memory"); SBAR();
#define PKV(L, H) (bf16x8){L[0], L[1], L[2], L[3], H[0], H[1], H[2], H[3]}
    od = __builtin_amdgcn_mfma_f32_32x32x16_bf16(pa0, PKV(l0, h0), od, 0, 0, 0);
    od = __builtin_amdgcn_mfma_f32_32x32x16_bf16(pa1, PKV(l1, h1), od, 0, 0, 0);
    od = __builtin_amdgcn_mfma_f32_32x32x16_bf16(pa2, PKV(l2, h2), od, 0, 0, 0);
    od = __builtin_amdgcn_mfma_f32_32x32x16_bf16(pa3, PKV(l3, h3), od, 0, 0, 0);
#undef PKV
}
__device__ __forceinline__ void pv_d0(f32x16* o, int vb, bf16x8 pa0, bf16x8 pa1, bf16x8 pa2, bf16x8 pa3) {
    pv_one<0>(o[0], vb, pa0, pa1, pa2, pa3); pv_one<1>(o[1], vb, pa0, pa1, pa2, pa3); pv_one<2>(o[2], vb, pa0, pa1, pa2, pa3); pv_one<3>(o[3], vb, pa0, pa1, pa2, pa3);
}
__device__ __forceinline__ void attn_pass(const bf16_t* __restrict__ Qb, const bf16_t* __restrict__ Kh, const bf16_t* __restrict__ Vh, char* lds, f32x16 (&o)[4]) {
    const int tid = TIDX(), wid = tid >> 6, lane = tid & 63, r32 = lane & 31, hi = lane >> 5;
    char* V_lds = lds; char* K_lds = lds + 2 * AT_SHM_V;
    float* ws = (float*)(lds + 2 * AT_SHM_V + 2 * AT_SHM_K) + wid * 64; float* li_l = ws; float* al_l = ws + 32;
    float m_reg = -1e30f, l_reg = 0;
#pragma unroll
    for (int d = 0; d < 4; ++d) o[d] = f32x16{};
    bf16x8 qr[4];
    const bf16_t* Qw = Qb + (size_t)(wid * 32 + r32) * INW + hi * 8;
#pragma unroll
    for (int d0 = 0; d0 < 4; ++d0) qr[d0] = *reinterpret_cast<const bf16x8*>(Qw + d0 * 16);
    const int sr = tid >> 4, sc = (tid & 15) * 8, vst0 = v_st(sr, sc), vst1 = v_st(32 + sr, sc);
    const int kr = tid >> 3, kc = (tid & 7) * 8, kst = KSWZ64(kr, kc * 2);
    const int vb0 = (int)(uintptr_t)V_lds + v_rd_base(lane);
    struct { bf16x8 vs0, vs1, ks0; } sr_[2];
    const unsigned voff0 = (unsigned)(sr * INW + sc), voff1 = (unsigned)((32 + sr) * INW + sc), koff = (unsigned)(kr * INW + kc);
#define SLOAD(i, k0) do { const bf16_t* Vt = Vh + (size_t)(k0) * INW; const bf16_t* Kt = Kh + (size_t)(k0) * INW; \
    sr_[i].vs0 = *reinterpret_cast<const bf16x8*>(Vt + voff0); sr_[i].vs1 = *reinterpret_cast<const bf16x8*>(Vt + voff1); sr_[i].ks0 = *reinterpret_cast<const bf16x8*>(Kt + koff); } while (0)
#define SWRITE(b, i) do { *(bf16x8*)(V_lds + (b) * AT_SHM_V + vst0) = sr_[i].vs0; *(bf16x8*)(V_lds + (b) * AT_SHM_V + vst1) = sr_[i].vs1; \
    *(bf16x8*)(K_lds + (b) * AT_SHM_K + kst) = sr_[i].ks0; } while (0)
#define SWAIT() asm volatile("s_waitcnt vmcnt(3)" ::: "memory")
#define RESC(a) do { if (__any((a) < 1.f)) { if (hi == 0) al_l[r32] = (a); asm volatile("s_waitcnt lgkmcnt(0)" ::: "memory"); \
    _Pragma("unroll") for (int d = 0; d < 4; ++d) _Pragma("unroll") for (int r = 0; r < 16; ++r) o[d][r] *= al_l[crow(r, hi)]; } } while (0)
    f32x16 pA0, pA1, pB0, pB1; float mnA, mnB, alA, alB; bf16x8 pa0, pa1, pa2, pa3; const int NTL = SEQ / AT_KVBLK;
    constexpr int SE = 0, SO = 1;
    SLOAD(SE, 0); asm volatile("s_waitcnt vmcnt(0)" ::: "memory"); SWRITE(0, SE); __syncthreads();
    qkt64(pA0, pA1, K_lds, qr, r32, hi); partialSM(pA0, pA1, m_reg, mnA, alA);
    SLOAD(SO, AT_KVBLK); SLOAD(SE, 2 * AT_KVBLK);
    SWAIT(); SWRITE(1, SO); __syncthreads();
#pragma unroll 1
    for (int j = 1; j + 1 < NTL; j += 2) {
        SBAR(); qkt64(pB0, pB1, K_lds + AT_SHM_K, qr, r32, hi);
        finishSM(pA0, pA1, alA, l_reg, pa0, pa1, pa2, pa3); SBAR();
        SLOAD(SO, (j + 2) * AT_KVBLK); SBAR();
        pv_d0(o, vb0, pa0, pa1, pa2, pa3); partialSM(pB0, pB1, m_reg, mnB, alB);
        __syncthreads(); SWAIT(); SWRITE(0, SE);
        RESC(alB); __syncthreads();
        SBAR(); qkt64(pA0, pA1, K_lds, qr, r32, hi);
        finishSM(pB0, pB1, alB, l_reg, pa0, pa1, pa2, pa3); SBAR();
        if (j + 3 < NTL) SLOAD(SE, (j + 3) * AT_KVBLK); SBAR();
        pv_d0(o, vb0 + AT_SHM_V, pa0, pa1, pa2, pa3); partialSM(pA0, pA1, m_reg, mnA, alA);
        __syncthreads(); SWAIT(); SWRITE(1, SO);
        RESC(alA); __syncthreads();
    }
    SBAR(); qkt64(pB0, pB1, K_lds + AT_SHM_K, qr, r32, hi);
    finishSM(pA0, pA1, alA, l_reg, pa0, pa1, pa2, pa3); SBAR();
    pv_d0(o, vb0, pa0, pa1, pa2, pa3); partialSM(pB0, pB1, m_reg, mnB, alB);
    __syncthreads(); RESC(alB);
    finishSM(pB0, pB1, alB, l_reg, pa0, pa1, pa2, pa3); SBAR();
    pv_d0(o, vb0 + AT_SHM_V, pa0, pa1, pa2, pa3);
    if (hi == 0) li_l[r32] = l_reg; asm volatile("s_waitcnt lgkmcnt(0)" ::: "memory");
#pragma unroll
    for (int r = 0; r < 16; ++r) { const float rl = __builtin_amdgcn_rcpf(li_l[crow(r, hi)]);
#pragma unroll
        for (int d0 = 0; d0 < 4; ++d0) o[d0][r] *= rl; }
#undef SLOAD
#undef SWRITE
#undef SWAIT
#undef RESC
}
__device__ __forceinline__ void ph_attn(const Params& P, char* lds) {
    const int tid = TIDX(), wid = tid >> 6, lane = tid & 63, r32 = lane & 31, hi = lane >> 5;
    float lam;
    { float d1 = P.lam_q1[lane] * P.lam_k1[lane], d2 = P.lam_q2[lane] * P.lam_k2[lane]; d1 = wave_sum(d1); d2 = wave_sum(d2); lam = expf(d1) - expf(d2) + 0.2f; }
#pragma unroll 1
    for (int u = blockIdx.x; u < NB * 8 * (SEQ / 256); u += gridDim.x) {
        const int slot = u >> 3, bh = (u & 7) * 4 + (slot >> 3), qblk = slot & 7, b = bh >> 3, h = bh & 7;
        const bf16_t* base = P.proj + (size_t)(b * SEQ) * INW;
        const bf16_t* Qb = base + (size_t)(qblk * 256) * INW + OFF_Q + h * 128;
        const bf16_t* Kh = base + OFF_K + h * 128;
        const bf16_t* Vh = base + OFF_V + h * 128;
        f32x16 o[4];
        attn_pass(Qb, Kh, Vh, lds, o);
        unsigned* park = (unsigned*)(lds + 2 * AT_SHM_V + 2 * AT_SHM_K + 2048) + wid * 2048 + lane;
#pragma unroll
        for (int d0 = 0; d0 < 4; ++d0)
#pragma unroll
            for (int i = 0; i < 8; ++i) park[(d0 * 8 + i) * 64] = cvt_pk_bf16(o[d0][2 * i], o[d0][2 * i + 1]);
        attn_pass(Qb + 64, Kh + 64, Vh, lds, o);
        unsigned o1p[4][8];
#pragma unroll
        for (int d0 = 0; d0 < 4; ++d0)
#pragma unroll
            for (int i = 0; i < 8; ++i) o1p[d0][i] = park[(d0 * 8 + i) * 64];
        float ss[16];
#pragma unroll
        for (int r = 0; r < 16; ++r) { float s = 0.f;
#pragma unroll
            for (int d0 = 0; d0 < 4; ++d0) { const float o1 = (r & 1) ? bfhi(o1p[d0][r >> 1]) : bflo(o1p[d0][r >> 1]); const float v = o1 - lam * o[d0][r]; o[d0][r] = v; s += v * v; }
            ss[r] = s; }
        const int ln_ = olane();
#pragma unroll
        for (int r = 0; r < 16; ++r) { float s = ss[r]; s += shx(s, ln_, 1); s += shx(s, ln_, 2); s += shx(s, ln_, 4); s += shx(s, ln_, 8); s += shx(s, ln_, 16);
            ss[r] = rsqrtf(s * (1.f / 128.f) + EPS) * 0.8f; }
        int opq = 0; asm volatile("" : "+v"(opq));
        char* patch = lds + 2 * AT_SHM_V + 2 * AT_SHM_K + 2048 + wid * 8192 + opq;
#pragma unroll
        for (int d0 = 0; d0 < 4; ++d0) { const float g = P.subln_g[d0 * 32 + r32 + opq];
#pragma unroll
            for (int r = 0; r < 16; ++r) *(bf16_t*)(patch + ((r & 3) + 8 * (r >> 2) + 4 * hi) * 256 + (d0 * 32 + r32) * 2) = f2bf(o[d0][r] * ss[r] * g); }
        bf16_t* mrow = P.mix + (size_t)(b * SEQ + qblk * 256 + wid * 32 + opq) * DM + 1024 + h * 128;
#pragma unroll
        for (int it = 0; it < 8; ++it) { const int row = it * 4 + (lane >> 4), ch = lane & 15;
            *(u32x4*)(mrow + (size_t)row * DM + ch * 8) = *(const u32x4*)(patch + row * 256 + ch * 16); }
        __syncthreads();
    }
}

struct EpiOutProjF {
    static constexpr bool PERM = true, AFTER_DRAIN = false;
    bf16_t* dmix;
    __device__ __forceinline__ void operator()(const f32x4 (&acc)[2][2][4][2], const pg8::Unit& u, int wr, int wc, int fr, int fq) const {
        const int row0 = u.pm * 256 + wr * 64 + fr;
#pragma unroll
        for (int ai = 0; ai < 2; ++ai)
#pragma unroll
            for (int m = 0; m < 4; ++m) { const int row = row0 + ai * 128 + m * 16;
#pragma unroll
                for (int bj = 0; bj < 2; ++bj) { const int col0 = u.pn * 256 + bj * 128 + wc * 32 + 8 * fq;
                    const f32x4 v0 = acc[ai][bj][m][0], v1 = acc[ai][bj][m][1];
                    u32x4 w; w[0] = cvt_pk_bf16(v0[0], v0[1]); w[1] = cvt_pk_bf16(v0[2], v0[3]); w[2] = cvt_pk_bf16(v1[0], v1[1]); w[3] = cvt_pk_bf16(v1[2], v1[3]);
                    *(u32x4*)(dmix + (size_t)row * DM + col0) = w; } }
    }
};
__device__ __forceinline__ void ph_outproj(const Params& P, char* smem) {
    pg8::Gemm g{P.mix, P.w_out_t, T_TOK, DM, DM};
    pg8::StaticOrder S; S.init(T_TOK, DM, gridDim.x, blockIdx.x);
    EpiOutProjF E{(bf16_t*)P.h1};
    pg8::gemm_phase<EpiOutProjF, pg8::StaticOrder>((PG8_LAS unsigned char*)smem, g, S, E, nullptr);
    __syncthreads();
}

__device__ __forceinline__ void ph_wcat(const Params& P) {
    for (int i = blockIdx.x * NT + TIDX(); i < DM * 96; i += gridDim.x * NT) { const int k = i / 96, j = i - k * 96;
        const float w = (j < 64) ? P.w_re[(size_t)k * 64 + j] : ((j < 72) ? P.w_rg[(size_t)k * 8 + (j - 64)] : 0.f);
        P.wcat[i] = w * P.norm_ffn_g[k]; }
}
__device__ __forceinline__ void ph_router(const Params& P, char* smem) {
    const int tid = TIDX(), wid = __builtin_amdgcn_readfirstlane(tid >> 6), lane = tid & 63, r32 = lane & 31, hi = lane >> 5;
    float* part = (float*)smem;
    float* ssp = (float*)(smem + 98304);
    float* logit = (float*)(smem + 98304 + 2048);
    float* rinv_s = (float*)(smem + 98304 + 2048 + 32 * 97 * 4);
#pragma unroll 1
    for (int u = blockIdx.x; u < T_TOK / 32; u += gridDim.x) {
        const int t0 = u * 32;
        f32x16 acc0 = f32x16{}, acc1 = f32x16{}, acc2 = f32x16{};
        float ss = 0.f;
        const float* ap = P.x + (size_t)(t0 + r32) * DM + wid * 256; const bf16_t* dp = (const bf16_t*)P.h1 + (size_t)(t0 + r32) * DM + wid * 256;
        const float* wp = P.wcat + (size_t)(wid * 256 + hi) * 96 + r32;
#pragma unroll 4
        for (int s = 0; s < 64; ++s) {
            f32x4 a4 = *(const f32x4*)(ap + 4 * s); { const u32x2 dq = *(const u32x2*)(dp + 4 * s); a4[0] += bflo(dq[0]); a4[1] += bfhi(dq[0]); a4[2] += bflo(dq[1]); a4[3] += bfhi(dq[1]); }
            ss += a4[0] * a4[0] + a4[1] * a4[1] + a4[2] * a4[2] + a4[3] * a4[3];
            const float* w0 = wp + (size_t)(4 * s) * 96; const float* w1 = w0 + 2 * 96;
            const float aA = hi ? a4[1] : a4[0], aB = hi ? a4[3] : a4[2];
            acc0 = __builtin_amdgcn_mfma_f32_32x32x2f32(aA, w0[0], acc0, 0, 0, 0);
            acc1 = __builtin_amdgcn_mfma_f32_32x32x2f32(aA, w0[32], acc1, 0, 0, 0);
            acc2 = __builtin_amdgcn_mfma_f32_32x32x2f32(aA, w0[64], acc2, 0, 0, 0);
            acc0 = __builtin_amdgcn_mfma_f32_32x32x2f32(aB, w1[0], acc0, 0, 0, 0);
            acc1 = __builtin_amdgcn_mfma_f32_32x32x2f32(aB, w1[32], acc1, 0, 0, 0);
            acc2 = __builtin_amdgcn_mfma_f32_32x32x2f32(aB, w1[64], acc2, 0, 0, 0);
        }
        __syncthreads();
#pragma unroll
        for (int r = 0; r < 16; ++r) { part[((wid * 3 + 0) * 16 + r) * 64 + lane] = acc0[r]; part[((wid * 3 + 1) * 16 + r) * 64 + lane] = acc1[r]; part[((wid * 3 + 2) * 16 + r) * 64 + lane] = acc2[r]; }
        ssp[wid * 64 + lane] = ss;
        __syncthreads();
        for (int o = tid; o < 3 * 16 * 64; o += NT) {
            float s = 0.f;
#pragma unroll
            for (int w = 0; w < 8; ++w) s += part[w * 3072 + o];
            const int l = o & 63, r = (o >> 6) & 15, nt = o >> 10;
            logit[crow(r, l >> 5) * 97 + 32 * nt + (l & 31)] = s;
        }
        if (tid < 32) { float s = 0.f;
#pragma unroll
            for (int w = 0; w < 8; ++w) s += ssp[w * 64 + tid] + ssp[w * 64 + 32 + tid];
            const float rv_ = rsqrtf(s * (0.5f / DM) + EPS); rinv_s[tid] = rv_; P.dtv[t0 + tid] = rv_; }
        __syncthreads();
        if (tid < 32) {
            const int t = t0 + tid; const float rv = rinv_s[tid]; const float* lg = logit + tid * 97;
            float gl[8]; int gs = 0; float gm = -INFINITY;
#pragma unroll
            for (int i = 0; i < 8; ++i) { const float a = lg[64 + i] * rv + P.b_rg[i]; gl[i] = a; if (a > gm) { gm = a; gs = i; } }
            float den = 0.f;
#pragma unroll
            for (int i = 0; i < 8; ++i) den += expf(gl[i] - gm);
            const float p_g = 1.f / den;
            int i0 = 0, i1 = 0; float e0 = -INFINITY, e1 = -INFINITY;
#pragma unroll
            for (int i = 0; i < 8; ++i) { const float a = lg[gs * 8 + i] * rv + P.b_re[gs * 8 + i];
                if (a > e0) { e1 = e0; i1 = i0; e0 = a; i0 = i; } else if (a > e1) { e1 = a; i1 = i; } }
            const float x1 = expf(e1 - e0), w0 = 1.f / (1.f + x1), w1 = x1 / (1.f + x1);
            const int ex0 = gs * 8 + i0, ex1 = gs * 8 + i1;
            P.tok_e[t * 2] = ex0; P.tok_e[t * 2 + 1] = ex1; P.tok_w[t * 2] = p_g * w0; P.tok_w[t * 2 + 1] = p_g * w1;
            atomicAdd(&P.counts[ex0], 1); atomicAdd(&P.counts[ex1], 1);
        }
#pragma unroll 1
        for (int q = 0; q < 4; ++q) { const int ti = wid * 4 + q; const float rv = rinv_s[ti]; const float* hr = P.x + (size_t)(t0 + ti) * DM; const bf16_t* dr = (const bf16_t*)P.h1 + (size_t)(t0 + ti) * DM;
#pragma unroll
            for (int i = 0; i < 4; ++i) { const int c = (i * 64 + lane) * 8;
                const f32x4 v0 = *(const f32x4*)(hr + c), v1 = *(const f32x4*)(hr + c + 4), g0 = *(const f32x4*)(P.norm_ffn_g + c), g1 = *(const f32x4*)(P.norm_ffn_g + c + 4); const u32x4 dq = *(const u32x4*)(dr + c);
                u32x4 o; o[0] = cvt_pk_bf16((v0[0] + bflo(dq[0])) * rv * g0[0], (v0[1] + bfhi(dq[0])) * rv * g0[1]); o[1] = cvt_pk_bf16((v0[2] + bflo(dq[1])) * rv * g0[2], (v0[3] + bfhi(dq[1])) * rv * g0[3]);
                o[2] = cvt_pk_bf16((v1[0] + bflo(dq[2])) * rv * g1[0], (v1[1] + bfhi(dq[2])) * rv * g1[1]); o[3] = cvt_pk_bf16((v1[2] + bflo(dq[3])) * rv * g1[2], (v1[3] + bfhi(dq[3])) * rv * g1[3]);
                *(u32x4*)(P.hn + (size_t)(t0 + ti) * DM + c) = o; } }
        __syncthreads();
    }
}
__device__ __forceinline__ void moe_starts(const Params& P, int* sst) {
    __syncthreads();
    if (TIDX() < 64) { const int lane = TIDX(); const int c = __hip_atomic_load(&P.counts[lane], __ATOMIC_RELAXED, __HIP_MEMORY_SCOPE_AGENT);
        const int p = ((c + 127) >> 7) << 7; int incl = p;
#pragma unroll
        for (int o = 1; o < 64; o <<= 1) { const int v = __shfl_up(incl, o); if (lane >= o) incl += v; }
        sst[lane] = incl - p; if (lane == 63) sst[NEXP] = incl; sst[80 + lane] = p; }
    __syncthreads();
    if (TIDX() < 64) { const int lane = TIDX(), mine = sst[80 + lane]; int rank = 0;
        for (int j = 0; j < 64; ++j) { const int o = sst[80 + j]; rank += (o > mine || (o == mine && j < lane)) ? 1 : 0; }
        sst[160 + rank] = lane; }
    __syncthreads();
}
__device__ __forceinline__ void moe_starts_cached(const Params& P, int* sst) {
    const int* gsrc = (const int*)(P.bar + 3840);
    __syncthreads();
    if (TIDX() < 65) sst[TIDX()] = gsrc[TIDX()];
    else if (TIDX() >= 128 && TIDX() < 192) sst[160 + TIDX() - 128] = gsrc[128 + TIDX() - 128];
    __syncthreads();
}
__device__ __forceinline__ void ph_moe_scatter(const Params& P, char* smem) {
    int* sst = (int*)smem; int* lcount = (int*)(smem + 512); int* lbase = (int*)(smem + 1024); moe_starts(P, sst);
    if (blockIdx.x == 0) { int* gdst = (int*)(P.bar + 3840); if (TIDX() < 65) gdst[TIDX()] = sst[TIDX()]; else if (TIDX() >= 128 && TIDX() < 192) gdst[TIDX()] = sst[160 + TIDX() - 128]; }
    const int tid = TIDX();
    for (int a0 = blockIdx.x * 128; a0 < T_TOK * 2; a0 += gridDim.x * 128) {
        const int a = a0 + tid; const bool valid = (tid < 128) && (a < T_TOK * 2);
        __syncthreads();
        if (tid < NEXP) lcount[tid] = 0;
        __syncthreads();
        const int e = valid ? P.tok_e[a] : 0;
        const int rank = valid ? atomicAdd(&lcount[e], 1) : 0;
        __syncthreads();
        if (tid < NEXP) { const int c = lcount[tid]; lbase[tid] = c ? atomicAdd(&P.cursor[tid], c) : 0; }
        __syncthreads();
        if (valid) { const int pos = sst[e] + lbase[e] + rank; P.row_tok[pos] = a >> 1; P.row_slot[pos] = a; P.row_w[pos] = P.tok_w[a]; }
    }
}
#define MG_B 49152
__device__ __forceinline__ int a_swz(int rh) { rh &= 3; return (((rh ^ (rh >> 1)) & 1) << 1) | (rh >> 1); }
template <int NRB> struct MoeALoadR {
    const bf16_t* base; unsigned off[NRB][4]; u32x4 r[NRB][4]; unsigned aw;
    __device__ __forceinline__ void init(const bf16_t* b, size_t ld_, int row0, const int* gather, int zrow, int tl) { base = b;
        { const int row = tl >> 3, kc = tl & 7, kh = kc >> 2, kq = kc & 3; aw = (unsigned)((kh * 128 + row) * 64 + ((kq ^ a_swz(row >> 2)) * 16)); }
#pragma unroll
        for (int rb = 0; rb < NRB; ++rb)
#pragma unroll
            for (int i = 0; i < 4; ++i) { const int row = row0 + rb * 128 + i * 32 + (tl >> 3); const int t = gather ? gather[row] : row;
                off[rb][i] = (unsigned)((t >= 0) ? t : zrow) * (unsigned)(ld_ * 2) + (unsigned)((tl & 7) * 16); } }
    __device__ __forceinline__ void fetch1(int rb, int i, int kt) { r[rb][i] = *(const u32x4*)((const char*)base + (size_t)kt * 128 + (unsigned)opq((int)off[rb][i])); }
    __device__ __forceinline__ void commit1(int rb, int i, char* lds) { *(u32x4*)(lds + rb * 16384 + i * 2048 + aw) = r[rb][i]; }
    __device__ __forceinline__ void fetch(int kt) {
#pragma unroll
        for (int rb = 0; rb < NRB; ++rb)
#pragma unroll
            for (int i = 0; i < 4; ++i) fetch1(rb, i, kt);
    }
    __device__ __forceinline__ void commit(char* lds) {
#pragma unroll
        for (int rb = 0; rb < NRB; ++rb)
#pragma unroll
            for (int i = 0; i < 4; ++i) commit1(rb, i, lds);
    }
};
template <bool GU> struct MoeBLoadR {
    const float* ub[2]; unsigned ldb, voff, bw[2];
    __device__ __forceinline__ void init(const float* b0_, const float* b1_, unsigned ld_, int tl) { ub[0] = b0_; ub[1] = b1_; ldb = ld_ * 4;
        if (GU) { const unsigned k0 = (unsigned)tl >> 4, ffl4 = ((unsigned)tl & 15) * 4; voff = k0 * ldb + ffl4 * 4;
#pragma unroll
            for (int mat = 0; mat < 2; ++mat) { const unsigned n4 = (ffl4 >> 4) * 32 + mat * 16 + (ffl4 & 15); bw[mat] = off_b(k0, n4 >> 3) + (n4 & 4) * 2; } }
        else { const unsigned k0 = (unsigned)tl >> 5, n4 = ((unsigned)tl & 31) * 4; voff = k0 * ldb + n4 * 4;
#pragma unroll
            for (int hf = 0; hf < 2; ++hf) bw[hf] = off_b(k0 + 8 * hf, n4 >> 3) + (n4 & 4) * 2; } }
    __device__ __forceinline__ void fetch1(f32x4 (&r)[8], int i, int kt) const {
        const char* b = (const char*)(GU ? ub[i >> 2] : ub[0]) + (size_t)((unsigned)kt * 64u + (GU ? 0u : (unsigned)(i >> 2) * 8u) + (unsigned)(i & 3) * 16u) * ldb;
        r[i] = __builtin_nontemporal_load((const f32x4*)(b + (unsigned)opq((int)voff))); }
    __device__ __forceinline__ void commit1(const f32x4 (&r)[8], int i, char* bimg) const { u32x2 v; v[0] = cvt_pk_bf16(r[i][0], r[i][1]); v[1] = cvt_pk_bf16(r[i][2], r[i][3]);
        *(u32x2*)(bimg + (i & 3) * 4096 + bw[i >> 2]) = v; }
    __device__ __forceinline__ void fetch(f32x4 (&r)[8], int kt) const {
#pragma unroll
        for (int i = 0; i < 8; ++i) fetch1(r, i, kt);
    }
    __device__ __forceinline__ void commit(const f32x4 (&r)[8], char* bimg) const {
#pragma unroll
        for (int i = 0; i < 8; ++i) commit1(r, i, bimg);
    }
};
typedef LAS s16x4 lds_s16x4_t;
__device__ __forceinline__ s16x4 trb(unsigned addr) { return __builtin_amdgcn_ds_read_tr16_b64_v4i16((lds_s16x4_t*)addr); }
struct MoeNoPre { __device__ __forceinline__ void store() const {} };
template <int NK, int NRB, bool GU, class EP, class PRE>
__device__ __forceinline__ void moe_gemm_unit(char* smem, const bf16_t* abase, size_t ald, int row0, const int* gather, int zrow, const float* ub0, const float* ub1, unsigned ldw, const EP& ep, const PRE& pre) {
    const int tid = TIDX(), wid = __builtin_amdgcn_readfirstlane(tid >> 6), lane = tid & 63, wr = wid >> 2, wc = wid & 3, fr = lane & 15, fq = lane >> 4;
    const bool arole = wid < 4;
    const unsigned lbase = (unsigned)(uintptr_t)smem + MG_B;
    const unsigned tq = (lane & 15) >> 2, tp = lane & 3;
    f32x4 acc[3][4][2];
#pragma unroll
    for (int rb = 0; rb < 3; ++rb)
#pragma unroll
        for (int m = 0; m < 4; ++m)
#pragma unroll
            for (int n = 0; n < 2; ++n) acc[rb][m][n] = (f32x4){0.f, 0.f, 0.f, 0.f};
    const unsigned tb00 = lbase + off_b(8 * fq + tq, 2 * (2 * wc) + (tp >> 1)) + 8 * (tp & 1), tb01 = lbase + off_b(8 * fq + 4 + tq, 2 * (2 * wc) + (tp >> 1)) + 8 * (tp & 1);
    const unsigned tb10 = lbase + off_b(8 * fq + tq, 2 * (2 * wc + 1) + (tp >> 1)) + 8 * (tp & 1), tb11 = lbase + off_b(8 * fq + 4 + tq, 2 * (2 * wc + 1) + (tp >> 1)) + 8 * (tp & 1);
    const char* ard = smem + (wr * 64 + fr) * 64 + ((fq ^ a_swz(fr >> 2)) * 16);
#define MG_BF(BUF, KH) do { const s16x4 t00 = trb(tb00 + (BUF) * 65536 + (KH) * 8192), t01 = trb(tb01 + (BUF) * 65536 + (KH) * 8192), t10 = trb(tb10 + (BUF) * 65536 + (KH) * 8192), t11 = trb(tb11 + (BUF) * 65536 + (KH) * 8192); \
        bfr[KH][0] = (bf16x8){t00[0], t00[1], t00[2], t00[3], t01[0], t01[1], t01[2], t01[3]}; bfr[KH][1] = (bf16x8){t10[0], t10[1], t10[2], t10[3], t11[0], t11[1], t11[2], t11[3]}; } while (0)
#define MG_AR(BUF, SET, KH, RB, MH) do { _Pragma("unroll") for (int m_ = 0; m_ < 2; ++m_) a[SET][m_] = *(const bf16x8*)(ard + (BUF) * 65536 + (RB) * 16384 + (KH) * 8192 + ((MH) * 2 + m_) * 1024); } while (0)
#define MG_STEP(ROLE, BUF, BS, KTN) do { constexpr int NH = 4 * NRB, NP = (ROLE) ? 8 : 4 * NRB, NS = 2 * NH; char* stg = smem + (1 - (BUF)) * 65536; const int ktn_ = (KTN); \
        bf16x8 a[2][2], bfr[2][2]; MG_BF(BUF, 0); MG_AR(BUF, 0, 0, 0, 0); \
        _Pragma("unroll") for (int h = 0; h < NH; ++h) { const int kh = h / (2 * NRB), rb = (h >> 1) % NRB, mh = h & 1, cur = h & 1; \
            if (h + 1 < NH) { const int kh1 = (h + 1) / (2 * NRB), rb1 = ((h + 1) >> 1) % NRB, mh1 = (h + 1) & 1; if (h + 1 == 2 * NRB) MG_BF(BUF, 1); MG_AR(BUF, cur ^ 1, kh1, rb1, mh1); } \
            __builtin_amdgcn_sched_barrier(0); \
            _Pragma("unroll") for (int mi = 0; mi < 2; ++mi) { const int m = mh * 2 + mi, s = h * 2 + mi; \
                acc[rb][m][0] = __builtin_amdgcn_mfma_f32_16x16x32_bf16(a[cur][mi], bfr[kh][0], acc[rb][m][0], 0, 0, 0); \
                acc[rb][m][1] = __builtin_amdgcn_mfma_f32_16x16x32_bf16(a[cur][mi], bfr[kh][1], acc[rb][m][1], 0, 0, 0); \
                __builtin_amdgcn_sched_barrier(0); \
                _Pragma("unroll") for (int q = 0; q < NP; ++q) if (q * NS / NP == s) { \
                    if (ROLE) { bl.commit1(BS, q, stg + MG_B); bl.fetch1(BS, q, ktn_); } \
                    else { al.commit1(q >> 2, q & 3, stg); al.fetch1(q >> 2, q & 3, ktn_); } \
                    __builtin_amdgcn_sched_barrier(0); } } } } while (0)
    if (arole) {
        MoeALoadR<NRB> al; f32x4 b0[8]; MoeBLoadR<GU> bl;
        al.init(abase, ald, row0, gather, zrow, tid); al.fetch(0);
        __syncthreads();
        al.commit(smem); al.fetch(1 < NK ? 1 : NK - 1);
        pre.store();
        __syncthreads();
#pragma unroll 1
        for (int kt = 0; kt < NK; kt += 2) {
            MG_STEP(0, 0, b0, kt + 2 < NK ? kt + 2 : NK - 1);
            __syncthreads();
            MG_STEP(0, 1, b0, kt + 3 < NK ? kt + 3 : NK - 1);
            __syncthreads();
        }
    } else {
        MoeBLoadR<GU> bl; MoeALoadR<NRB> al;
        bl.init(ub0, ub1, ldw, tid - 256);
#define KC(x) ((x) < NK ? (x) : NK - 1)
        if constexpr (NRB == 3) {
            f32x4 b0[8], b1[8];
            bl.fetch(b0, 0); bl.fetch(b1, KC(1));
            __syncthreads();
            bl.commit(b0, smem + MG_B); bl.fetch(b0, KC(2));
            pre.store();
            __syncthreads();
#pragma unroll 1
            for (int kt = 0; kt < NK; kt += 2) {
                MG_STEP(1, 0, b1, KC(kt + 3)); __syncthreads();
                MG_STEP(1, 1, b0, KC(kt + 4)); __syncthreads();
            }
        } else {
            static_assert(NK % 6 == 2, "the 3-set weight loop is unrolled over 6 steps (2 LDS buffers x 3 register sets) with a 2-step tail");
            f32x4 b0[8], b1[8], b2[8];
            bl.fetch(b0, 0); bl.fetch(b1, KC(1)); bl.fetch(b2, KC(2));
            __syncthreads();
            bl.commit(b0, smem + MG_B); bl.fetch(b0, KC(3));
            pre.store();
            __syncthreads();
#pragma unroll 1
            for (int kt = 0; kt + 6 <= NK; kt += 6) {
                MG_STEP(1, 0, b1, KC(kt + 4)); __syncthreads();
                MG_STEP(1, 1, b2, KC(kt + 5)); __syncthreads();
                MG_STEP(1, 0, b0, KC(kt + 6)); __syncthreads();
                MG_STEP(1, 1, b1, KC(kt + 7)); __syncthreads();
                MG_STEP(1, 0, b2, KC(kt + 8)); __syncthreads();
                MG_STEP(1, 1, b0, KC(kt + 9)); __syncthreads();
            }
            MG_STEP(1, 0, b1, NK - 1); __syncthreads();
            MG_STEP(1, 1, b2, NK - 1); __syncthreads();
        }
#undef KC
    }
#undef MG_STEP
#undef MG_AR
#undef MG_BF
    ep(acc, NRB, wr, wc, fr, fq);
    __syncthreads();
}
template <int NK, bool GU, class EP, class PRE>
__device__ __forceinline__ void moe_gemm_dispatch(char* smem, int nrb, const bf16_t* abase, size_t ald, int row0, const int* gather, int zrow, const float* ub0, const float* ub1, unsigned ldw, const EP& ep, const PRE& pre) {
    if (nrb == 3)      moe_gemm_unit<NK, 3, GU>(smem, abase, ald, row0, gather, zrow, ub0, ub1, ldw, ep, pre);
    else if (nrb == 2) moe_gemm_unit<NK, 2, GU>(smem, abase, ald, row0, gather, zrow, ub0, ub1, ldw, ep, pre);
    else               moe_gemm_unit<NK, 1, GU>(smem, abase, ald, row0, gather, zrow, ub0, ub1, ldw, ep, pre);
}
struct EpiMoeGU { bf16_t* act; int row0, ff0; char* lds;
    __device__ __forceinline__ void operator()(const f32x4 (&acc)[3][4][2], int nrb, int wr, int wc, int fr, int fq) const {
#pragma unroll
        for (int rb = 0; rb < 3; ++rb) if (rb < nrb) {
#pragma unroll
            for (int m = 0; m < 4; ++m)
#pragma unroll
                for (int j = 0; j < 4; ++j) { const int row = rb * 128 + wr * 64 + m * 16 + fq * 4 + j;
                    const float g = acc[rb][m][0][j], u = acc[rb][m][1][j]; *(bf16_t*)(lds + row * 144 + (wc * 16 + fr) * 2) = f2bf(siluf(g) * u); } }
        __syncthreads();
        const int tid = TIDX();
#pragma unroll
        for (int it = 0; it < 6; ++it) if (it < 2 * nrb) { const int c = it * NT + tid, row = c >> 3, ch = c & 7;
            *(u32x4*)(act + (size_t)(row0 + row) * EFF + ff0 + ch * 8) = *(const u32x4*)(lds + row * 144 + ch * 16); }
    }
};
__device__ __forceinline__ void ph_moe_gu(const Params& P, char* smem) {
    int* sst = (int*)(smem + 131072); moe_starts_cached(P, sst);
    const int i = blockIdx.x, x = i & 7, slot = i >> 3;
#pragma unroll 1
    for (int rnd = 0; rnd * (int)gridDim.x < NEXP * 8; ++rnd) {
        int e, nt;
        if (gridDim.x == 256) { const int g = x * 4 + (slot >> 3); e = sst[160 + (rnd ? 63 - g : g)]; nt = slot & 7; }
        if (e >= NEXP) break;
        const int r_lo = sst[e], nrb_tot = (sst[e + 1] - r_lo) >> 7;
#pragma unroll 1
        for (int rbp = 0; rbp < nrb_tot; rbp += 3) { const int nrb = (nrb_tot - rbp) < 3 ? (nrb_tot - rbp) : 3;
            EpiMoeGU ep{P.act, r_lo + rbp * 128, nt * 64, smem};
            moe_gemm_dispatch<DM / 64, true>(smem, nrb, P.hn, DM, r_lo + rbp * 128, P.row_tok, T_TOK, P.w_eg + (size_t)e * DM * EFF + nt * 64, P.w_eu + (size_t)e * DM * EFF + nt * 64, EFF, ep, MoeNoPre{}); }
    }
}
struct EpiMoeDown { bf16_t* ymoe; const int* s_slot; const float* s_w; int col0; char* lds;
    __device__ __forceinline__ void operator()(const f32x4 (&acc)[3][4][2], int nrb, int wr, int wc, int fr, int fq) const {
        const int lane = fq * 16 + fr, wid = wr * 4 + wc; char* patch = lds + wid * 5120;
#pragma unroll
        for (int rb = 0; rb < 3; ++rb) if (rb < nrb) {
#pragma unroll
            for (int m = 0; m < 4; ++m)
#pragma unroll
                for (int j = 0; j < 4; ++j) { const int r = m * 16 + fq * 4 + j; const float w = s_w[rb * 128 + wr * 64 + r];
#pragma unroll
                    for (int n = 0; n < 2; ++n) *(bf16_t*)(patch + r * 80 + (n * 16 + fr) * 2) = f2bf(acc[rb][m][n][j] * w); }
#pragma unroll
            for (int it = 0; it < 4; ++it) { const int r = it * 16 + (lane >> 2), c = lane & 3; const int sl = s_slot[rb * 128 + wr * 64 + r];
                const u32x4 v = *(const u32x4*)(patch + r * 80 + c * 16);
                if (sl >= 0) *(u32x4*)(ymoe + (size_t)sl * DM + col0 + wc * 32 + c * 8) = v; }
        }
    }
};
__device__ __forceinline__ void ph_moe_down(const Params& P, char* smem) {
    int* sst = (int*)(smem + 131072); moe_starts_cached(P, sst);
    const int i = blockIdx.x, x = i & 7, slot = i >> 3;
#pragma unroll 1
    for (int rnd = 0; rnd * (int)gridDim.x < NEXP * 16; ++rnd) {
        int e, ct;
        if (gridDim.x == 256) { const int g = x * 2 + (slot >> 4); e = sst[160 + (rnd == 0 ? g : rnd == 1 ? 31 - g : rnd == 2 ? 32 + g : 63 - g)]; ct = slot & 15; }
        if (e >= NEXP) break;
        const int r_lo = sst[e], nrb_tot = (sst[e + 1] - r_lo) >> 7;
        const float* wdb = P.w_ed + (size_t)e * EFF * DM + ct * 128;
#pragma unroll 1
        for (int rbp = 0; rbp < nrb_tot; rbp += 3) { const int nrb = (nrb_tot - rbp) < 3 ? (nrb_tot - rbp) : 3;
            int* s_slot = (int*)(smem + 145408); float* s_w = (float*)(smem + 145408 + 1536);
            __syncthreads();
            if (TIDX() < 384) { const int rl = TIDX(); int row = r_lo + rbp * 128 + rl; row = row < MAXROWS ? row : MAXROWS - 1;
                const bool ok = (rl < nrb * 128) && (P.row_tok[row] >= 0); s_slot[rl] = ok ? P.row_slot[row] : -1; s_w[rl] = ok ? P.row_w[row] : 0.f; }
            EpiMoeDown ep{P.ymoe, s_slot, s_w, ct * 128, smem};
            moe_gemm_dispatch<EFF / 64, false>(smem, nrb, P.act, EFF, r_lo + rbp * 128, nullptr, MAXROWS, wdb, wdb, DM, ep, MoeNoPre{}); }
    }
}
__device__ __forceinline__ void ph_combine(const Params& P) {
    const int lane = TIDX() & 63, w = TIDX() >> 6;
    for (int t = blockIdx.x * (NT / 64) + w; t < T_TOK; t += gridDim.x * (NT / 64)) {
        const bf16_t* hr = P.hn + (size_t)t * DM; const float rms = __builtin_amdgcn_rcpf(P.dtv[t]);
#pragma unroll
        for (int i = 0; i < 4; ++i) { const int c = (i * 64 + lane) * 8;
            const u32x4 hb = *(const u32x4*)(hr + c); const f32x4 g0 = *(const f32x4*)(P.norm_ffn_g + c), g1 = *(const f32x4*)(P.norm_ffn_g + c + 4);
            const u32x4 a = *(const u32x4*)(P.ymoe + (size_t)(2 * t) * DM + c), b = *(const u32x4*)(P.ymoe + (size_t)(2 * t + 1) * DM + c);
            float gg[8] = {g0[0], g0[1], g0[2], g0[3], g1[0], g1[1], g1[2], g1[3]}, v[8]; bool tiny = false;
#pragma unroll
            for (int e = 0; e < 4; ++e) { v[2 * e] = bflo(hb[e]) * rms * __builtin_amdgcn_rcpf(gg[2 * e]); v[2 * e + 1] = bfhi(hb[e]) * rms * __builtin_amdgcn_rcpf(gg[2 * e + 1]); }
#pragma unroll
            for (int e = 0; e < 8; ++e) tiny = tiny || (fabsf(gg[e]) < 1e-3f);
            if (tiny) {
                const f32x4 x0 = *(const f32x4*)(P.x + (size_t)t * DM + c), x1 = *(const f32x4*)(P.x + (size_t)t * DM + c + 4); const u32x4 dq = *(const u32x4*)((const bf16_t*)P.h1 + (size_t)t * DM + c);
                v[0] = x0[0] + bflo(dq[0]); v[1] = x0[1] + bfhi(dq[0]); v[2] = x0[2] + bflo(dq[1]); v[3] = x0[3] + bfhi(dq[1]); v[4] = x1[0] + bflo(dq[2]); v[5] = x1[1] + bfhi(dq[2]); v[6] = x1[2] + bflo(dq[3]); v[7] = x1[3] + bfhi(dq[3]); }
            u32x4 o;
#pragma unroll
            for (int e = 0; e < 4; ++e) o[e] = cvt_pk_bf16(v[2 * e] + bflo(a[e]) + bflo(b[e]), v[2 * e + 1] + bfhi(a[e]) + bfhi(b[e]));
            *(u32x4*)(P.h2b + (size_t)t * DM + c) = o; }
    }
}
struct EpiPP { bf16_t* pp; float* prss; int row0, col0;
    __device__ __forceinline__ void operator()(const f32x4 (&acc)[4][2], int wr, int wc, int fr, int fq) const {
        const int ln_ = olane();
#pragma unroll
        for (int m = 0; m < 4; ++m)
#pragma unroll
            for (int j = 0; j < 4; ++j) { const int row = row0 + wr * 64 + m * 16 + fq * 4 + j; float s = 0.f;
#pragma unroll
                for (int n = 0; n < 2; ++n) { const float v = acc[m][n][j]; s += v * v; pp[(size_t)row * DM + col0 + wc * 32 + n * 16 + fr] = f2bf(v); }
                s += shx(s, ln_, 1); s += shx(s, ln_, 2); s += shx(s, ln_, 4); s += shx(s, ln_, 8);
                if (fr == 0) atomicAdd(prss + row, s); }
    }
};
struct PleOrder { int c, G;
    __device__ __forceinline__ bool next(int i, pg8::Unit& u) const { int idx;
        if (G == 256) { if (c < 224 || i >= 8) return false; idx = (c - 224) * 8 + i; } else { idx = i * G + c; if (idx >= 256) return false; }
        u.pm = idx >> 3; u.pn = idx & 7; return true; }
    __device__ __forceinline__ void a_ready(const pg8::Unit&) const {}
    __device__ __forceinline__ void done(const pg8::Unit&) const {}
};
struct EpiPLE {
    static constexpr bool PERM = true, AFTER_DRAIN = false;
    bf16_t* pp; float* prss;
    __device__ __forceinline__ void operator()(const f32x4 (&acc)[2][2][4][2], const pg8::Unit& u, int wr, int wc, int fr, int fq) const {
        const int row0 = u.pm * 256 + wr * 64 + fr; const int ln_ = olane();
#pragma unroll
        for (int ai = 0; ai < 2; ++ai)
#pragma unroll
            for (int m = 0; m < 4; ++m) { const int row = row0 + ai * 128 + m * 16; float s = 0.f;
#pragma unroll
                for (int bj = 0; bj < 2; ++bj) { const int col0 = u.pn * 256 + bj * 128 + wc * 32 + 8 * fq;
                    const f32x4 v0 = acc[ai][bj][m][0], v1 = acc[ai][bj][m][1];
                    s += v0[0] * v0[0] + v0[1] * v0[1] + v0[2] * v0[2] + v0[3] * v0[3] + v1[0] * v1[0] + v1[1] * v1[1] + v1[2] * v1[2] + v1[3] * v1[3];
                    u32x4 w; w[0] = cvt_pk_bf16(v0[0], v0[1]); w[1] = cvt_pk_bf16(v0[2], v0[3]); w[2] = cvt_pk_bf16(v1[0], v1[1]); w[3] = cvt_pk_bf16(v1[2], v1[3]);
                    *(u32x4*)(pp + (size_t)row * DM + col0) = w; }
                s += shx(s, ln_, 16); s += shx(s, ln_, 32);
                if (fq == 0) atomicAdd(prss + row, s); }
    }
};
__device__ __forceinline__ void ph_pleproj(const Params& P, char* smem) {
    pg8::Gemm g{P.h3b, P.w_pp_t, T_TOK, DM, 256};
    EpiPLE E{P.pp, P.prss};
    PleOrder S{(int)blockIdx.x, (int)gridDim.x}; pg8::gemm_phase<EpiPLE, PleOrder>((PG8_LAS unsigned char*)smem, g, S, E, nullptr);
    __syncthreads();
}
struct EpiGateF {
    static constexpr bool PERM = true, AFTER_DRAIN = false;
    const bf16_t* h2; const bf16_t* pp; const float* prss; const float* ple_g; const float* b_pg; bf16_t* out;
    __device__ __forceinline__ void operator()(const f32x4 (&acc)[2][2][4][2], const pg8::Unit& u, int wr, int wc, int fr, int fq) const {
        const int row0 = u.pm * 256 + wr * 64 + fr;
#pragma unroll
        for (int ai = 0; ai < 2; ++ai)
#pragma unroll
            for (int m = 0; m < 4; ++m) { const int row = row0 + ai * 128 + m * 16; const float pr = rsqrtf(prss[row] * (1.f / DM) + EPS);
#pragma unroll
                for (int bj = 0; bj < 2; ++bj) { const int c = u.pn * 256 + bj * 128 + wc * 32 + 8 * fq; const size_t o = (size_t)row * DM + c;
                    const u32x4 pq = *(const u32x4*)(pp + o), hq = *(const u32x4*)(h2 + o); u32x4 ov;
#pragma unroll
                    for (int n = 0; n < 2; ++n) { const f32x4 z = acc[ai][bj][m][n] + *(const f32x4*)(b_pg + c + 4 * n);
                        const f32x4 pl = (f32x4){bflo(pq[2 * n]), bfhi(pq[2 * n]), bflo(pq[2 * n + 1]), bfhi(pq[2 * n + 1])} * pr * *(const f32x4*)(ple_g + c + 4 * n);
                        const f32x4 hv = (f32x4){bflo(hq[2 * n]), bfhi(hq[2 * n]), bflo(hq[2 * n + 1]), bfhi(hq[2 * n + 1])};
                        f32x4 r;
#pragma unroll
                        for (int j = 0; j < 4; ++j) r[j] = hv[j] + pl[j] * sigmf(z[j]);
                        ov[2 * n] = cvt_pk_bf16(r[0], r[1]); ov[2 * n + 1] = cvt_pk_bf16(r[2], r[3]); }
                    *(u32x4*)(out + o) = ov; } }
    }
};
__device__ __forceinline__ void ph_plegate(const Params& P, char* smem) {
    pg8::Gemm g{P.h2b, P.w_pg_t, T_TOK, DM, DM};
    pg8::StaticOrder S; S.init(T_TOK, DM, gridDim.x, blockIdx.x);
    EpiGateF E{P.h2b, P.pp, P.prss, P.ple_g, P.b_pg, P.h3b};
    pg8::gemm_phase<EpiGateF, pg8::StaticOrder>((PG8_LAS unsigned char*)smem, g, S, E, nullptr);
    __syncthreads();
}
__device__ __forceinline__ void ph_final(const Params& P) {
    const int lane = TIDX() & 63, w = TIDX() >> 6;
    for (int t = blockIdx.x * (NT / 64) + w; t < T_TOK; t += gridDim.x * (NT / 64)) {
        f32x4 v[8]; float ss = 0.f;
#pragma unroll
        for (int i = 0; i < 4; ++i) { const u32x4 q = *(const u32x4*)(P.h3b + (size_t)t * DM + (i * 64 + lane) * 8);
            v[2 * i] = (f32x4){bflo(q[0]), bfhi(q[0]), bflo(q[1]), bfhi(q[1])}; v[2 * i + 1] = (f32x4){bflo(q[2]), bfhi(q[2]), bflo(q[3]), bfhi(q[3])};
            ss += v[2 * i][0] * v[2 * i][0] + v[2 * i][1] * v[2 * i][1] + v[2 * i][2] * v[2 * i][2] + v[2 * i][3] * v[2 * i][3] + v[2 * i + 1][0] * v[2 * i + 1][0] + v[2 * i + 1][1] * v[2 * i + 1][1] + v[2 * i + 1][2] * v[2 * i + 1][2] + v[2 * i + 1][3] * v[2 * i + 1][3]; }
        const float rr = rsqrtf(wave_sum(ss) * (1.f / DM) + EPS);
        float* r = P.out + (size_t)t * DM;
#pragma unroll
        for (int i = 0; i < 4; ++i) { const int c = (i * 64 + lane) * 8; const f32x4 g0 = *(const f32x4*)(P.final_g + c), g1 = *(const f32x4*)(P.final_g + c + 4);
            *(f32x4*)(r + c) = v[2 * i] * rr * g0; *(f32x4*)(r + c + 4) = v[2 * i + 1] * rr * g1; }
    }
}

#define LDS_BYTES 148736
#define PARAM_OFF 144000
#define NPW ((int)(sizeof(Params) / 4))
typedef __attribute__((address_space(1))) char gchar_t;
__device__ __forceinline__ Params params_from_lds(const LAS unsigned* src) {
    Params P; void** a = (void**)&P;
#pragma unroll
    for (int i = 0; i < NPW / 2; ++i) { const unsigned lo = (unsigned)__builtin_amdgcn_readfirstlane((int)src[2 * i]), hi = (unsigned)__builtin_amdgcn_readfirstlane((int)src[2 * i + 1]);
        a[i] = (void*)(gchar_t*)(((unsigned long long)hi << 32) | lo); }
    return P;
}
#define GRID_SYNC() do { xcd_barrier(bar); asm volatile("" ::: "memory"); } while (0)
__global__ void __launch_bounds__(NT, 2) hymba_fwd(Params Pk) {
    extern __shared__ __attribute__((aligned(16))) char smem_raw[];
    char* smem = smem_raw + 16;
    LAS unsigned* pl = (LAS unsigned*)(smem_raw + PARAM_OFF);
    if (TIDX() == 0) { *(uint4*)smem_raw = make_uint4(0u, 0u, 0u, 0u);
        const unsigned* s = (const unsigned*)&Pk;
#pragma unroll
        for (int i = 0; i < NPW; ++i) pl[i] = s[i]; }
    __syncthreads();
    XcdBarrier bar = xcd_barrier_post(Pk.bar, (volatile LAS unsigned*)smem_raw);
    {
        const Params P = params_from_lds(pl);
        ph_wt(smem, P.w_in, P.w_in_t, DM, INW, INW_PAD);
        ph_wt(smem, P.w_out, P.w_out_t, DM, DM, DM);
        ph_wt(smem, P.w_pg, P.w_pg_t, DM, DM, DM);
        ph_wt(smem, P.w_pp, P.w_pp_t, 256, DM, DM);
        ph_norm_x(P);
        ph_wcat(P);
        for (int i = blockIdx.x * NT + TIDX(); i < T_TOK * 256 / 8; i += gridDim.x * NT) {
            const f32x4 a0 = *(const f32x4*)(P.p + (size_t)i * 8), a1 = *(const f32x4*)(P.p + (size_t)i * 8 + 4);
            u32x4 o; o[0] = cvt_pk_bf16(a0[0], a0[1]); o[1] = cvt_pk_bf16(a0[2], a0[3]); o[2] = cvt_pk_bf16(a1[0], a1[1]); o[3] = cvt_pk_bf16(a1[2], a1[3]);
            *(u32x4*)(P.h3b + (size_t)i * 8) = o; }
        ph_rope_table(P);
        for (int i = blockIdx.x * NT + TIDX(); i < MAXROWS; i += gridDim.x * NT) { P.row_tok[i] = -1; P.row_slot[i] = 0; P.row_w[i] = 0.f; }
        for (int i = blockIdx.x * NT + TIDX(); i < T_TOK; i += gridDim.x * NT) P.prss[i] = 0.f;
        if (blockIdx.x == 0) for (int i = TIDX(); i < DM / 2; i += NT) ((unsigned*)(P.hn + (size_t)T_TOK * DM))[i] = 0u;
    }
    GRID_SYNC();
    { const Params P = params_from_lds(pl); ph_inproj(P, smem); }
    { const Params P = params_from_lds(pl); ph_pleproj(P, smem); }
    GRID_SYNC();
    { const Params P = params_from_lds(pl); ph_conv(P); }
    GRID_SYNC();
    { const Params P = params_from_lds(pl); ph_ssd(P, smem); }
    { const Params P = params_from_lds(pl); ph_attn(P, smem); }
    GRID_SYNC();
    { const Params P = params_from_lds(pl); ph_ssd_gate(P); }
    GRID_SYNC();
    { const Params P = params_from_lds(pl); ph_outproj(P, smem); }
    GRID_SYNC();
    { const Params P = params_from_lds(pl); ph_router(P, smem); }
    GRID_SYNC();
    { const Params P = params_from_lds(pl); ph_moe_scatter(P, smem); }
    GRID_SYNC();
    { const Params P = params_from_lds(pl); ph_moe_gu(P, smem); }
    GRID_SYNC();
    { const Params P = params_from_lds(pl); ph_moe_down(P, smem); }
    GRID_SYNC();
    { const Params P = params_from_lds(pl); ph_combine(P); }
    GRID_SYNC();
    { const Params P = params_from_lds(pl); ph_plegate(P, smem); }
    GRID_SYNC();
    { const Params P = params_from_lds(pl); ph_final(P); }
}

static inline size_t al256(size_t x) { return (x + 255) & ~(size_t)255; }

extern "C" void kernel_launch(void* const* d_in, const int* in_sizes, int n_in, void* d_out, int out_size, void* d_ws, size_t ws_size, hipStream_t stream) {
    Params P{};
    P.x = (const float*)d_in[0]; P.p = (const float*)d_in[1]; P.pos = (const int*)d_in[2]; P.norm_mix_g = (const float*)d_in[3]; P.w_in = (const float*)d_in[4];
    P.conv_w = (const float*)d_in[5]; P.conv_b = (const float*)d_in[6]; P.dt_bias_f = (const float*)d_in[7]; P.dt_bias_b = (const float*)d_in[8];
    P.a_log_f = (const float*)d_in[9]; P.a_log_b = (const float*)d_in[10]; P.d_skip = (const float*)d_in[11]; P.ssd_norm_g = (const float*)d_in[12];
    P.lam_q1 = (const float*)d_in[13]; P.lam_k1 = (const float*)d_in[14]; P.lam_q2 = (const float*)d_in[15]; P.lam_k2 = (const float*)d_in[16];
    P.subln_g = (const float*)d_in[17]; P.w_out = (const float*)d_in[18]; P.norm_ffn_g = (const float*)d_in[19]; P.w_rg = (const float*)d_in[20];
    P.b_rg = (const float*)d_in[21]; P.w_re = (const float*)d_in[22]; P.b_re = (const float*)d_in[23]; P.w_eg = (const float*)d_in[24];
    P.w_eu = (const float*)d_in[25]; P.w_ed = (const float*)d_in[26]; P.w_pp = (const float*)d_in[27]; P.ple_g = (const float*)d_in[28];
    P.w_pg = (const float*)d_in[29]; P.b_pg = (const float*)d_in[30]; P.final_g = (const float*)d_in[31];
    P.out = (float*)d_out;
    char* ws = (char*)d_ws; size_t o = 0;
    auto take = [&](size_t bytes) { char* r = ws + o; o = al256(o + bytes); return r; };
    P.bar = (unsigned*)take(16384);
    P.counts = (int*)(P.bar + 3584); P.cursor = (int*)(P.bar + 3584 + 128);
    P.w_in_t = (bf16_t*)take((size_t)INW_PAD * DM * 2); P.w_out_t = (bf16_t*)take((size_t)DM * DM * 2); P.w_pg_t = (bf16_t*)take((size_t)DM * DM * 2); P.w_pp_t = (bf16_t*)take((size_t)DM * 256 * 2);
    P.nbf = (bf16_t*)take((size_t)T_TOK * DM * 2); P.proj = (bf16_t*)take((size_t)T_TOK * INW * 2); P.dtv = (float*)take((size_t)T_TOK * 32 * 4);
    P.xbc = (bf16_t*)take((size_t)T_TOK * XBCW * 2); P.yf = (float*)take((size_t)T_TOK * SSDW * 4); P.yb = (float*)take((size_t)T_TOK * SSDW * 4);
    P.mix = (bf16_t*)take((size_t)T_TOK * DM * 2); P.h1 = (float*)take((size_t)T_TOK * DM * 4); P.hn = (bf16_t*)take((size_t)(T_TOK + 1) * DM * 2);
    P.tok_e = (int*)take((size_t)T_TOK * 2 * 4); P.tok_w = (float*)take((size_t)T_TOK * 2 * 4);
    P.row_tok = (int*)take((size_t)MAXROWS * 4); P.row_slot = (int*)take((size_t)MAXROWS * 4); P.row_w = (float*)take((size_t)MAXROWS * 4);
    P.act = (bf16_t*)take((size_t)MAXROWS * EFF * 2); P.ymoe = (bf16_t*)take((size_t)T_TOK * 2 * DM * 2); P.h2b = (bf16_t*)take((size_t)T_TOK * DM * 2);
    P.pp = (bf16_t*)take((size_t)T_TOK * DM * 2); P.prss = (float*)take((size_t)T_TOK * 4); P.wcat = (float*)take((size_t)DM * 96 * 4); P.rope = (float*)take((size_t)T_TOK * 16 * 4); P.h3b = (bf16_t*)take((size_t)T_TOK * DM * 2);
    (void)ws_size; (void)in_sizes; (void)n_in; (void)out_size;

    static int grid = 0;
    if (!grid) {
        int dev = 0, cus = 0, per_cu = 0;
        (void)hipGetDevice(&dev);
        (void)hipDeviceGetAttribute(&cus, hipDeviceAttributeMultiprocessorCount, dev);
        (void)hipFuncSetAttribute((const void*)hymba_fwd, hipFuncAttributeMaxDynamicSharedMemorySize, LDS_BYTES);
        (void)hipOccupancyMaxActiveBlocksPerMultiprocessor(&per_cu, hymba_fwd, NT, LDS_BYTES);
        if (cus <= 0) cus = 256;
        grid = cus * (per_cu < 1 ? 1 : 1);
    }
    (void)hipMemsetAsync(P.bar, 0, 16384, stream);
    hipLaunchKernelGGL(hymba_fwd, dim3(grid), dim3(NT), LDS_BYTES, stream, P);
}
```
